# Optimizing an MI355X kernel written in HIP

```python
import jax, jax.numpy as jnp
from jax import lax
import numpy as np

D_MODEL = 1024
BATCH = 8
SEQ = 4096
DEPTH = 1

CHUNK = 64
Q_BLOCK = 128

HEAD_DIM = 64
N_SB_HEADS = 8
D_SB = N_SB_HEADS * HEAD_DIM
N_MLA_HEADS = 8
QK_NOPE_DIM = 64
QK_ROPE_DIM = 32
V_HEAD_DIM = 64
Q_LORA_RANK = 256
KV_LORA_RANK = 128
D_MLA = N_MLA_HEADS * V_HEAD_DIM
D_MIX = D_SB + D_MLA
ROPE_THETA = 10000.0
PLE_DIM = 256
EPS = 1e-6

IN_SPLITS = (D_SB, D_SB, D_SB, D_SB, Q_LORA_RANK, KV_LORA_RANK, QK_ROPE_DIM, D_MLA)
D_IN = sum(IN_SPLITS)
IN_SPLIT_IDX = tuple(int(v) for v in np.cumsum(IN_SPLITS)[:-1])

kernel_name = "hybrid_stickbreak_mla_block"


def rms_norm(x, g):
    xf = x.astype(jnp.float32)
    y = xf * lax.rsqrt(jnp.mean(xf * xf, axis=-1, keepdims=True) + EPS)
    return (y * g.astype(jnp.float32)).astype(x.dtype)


def head_rms_norm(o, g):
    B, S, H, d = o.shape
    return rms_norm(o, g.reshape(H, d)).reshape(B, S, H * d)


def to_blocks(a):
    B, S = a.shape[:2]
    return a.reshape(B, S // Q_BLOCK, Q_BLOCK, *a.shape[2:]).swapaxes(0, 1)


def from_blocks(a):
    a = a.swapaxes(0, 1)
    return a.reshape(a.shape[0], a.shape[1] * a.shape[2], *a.shape[3:])


def apply_rope(x, positions):
    half = x.shape[-1] // 2
    freq = ROPE_THETA ** (-jnp.arange(half, dtype=jnp.float32) / half)
    ang = positions.astype(jnp.float32)[..., None] * freq
    ang = ang.reshape(ang.shape[:2] + (1,) * (x.ndim - 3) + (half,))
    cos, sin = jnp.cos(ang).astype(x.dtype), jnp.sin(ang).astype(x.dtype)
    x1, x2 = x[..., :half], x[..., half:]
    return jnp.concatenate([x1 * cos - x2 * sin, x2 * cos + x1 * sin], axis=-1)


def stick_breaking_attention(q, k, v):
    S = k.shape[1]
    scale = HEAD_DIM ** -0.5
    key_idx = jnp.arange(S)

    def block(args):
        b_idx, q_blk = args
        z = jnp.einsum('bqhd,bkhd->bhqk', q_blk, k).astype(jnp.float32) * scale
        t_idx = b_idx * Q_BLOCK + jnp.arange(Q_BLOCK)
        past = key_idx[None, :] < t_idx[:, None]
        log_fail = jnp.where(past, jax.nn.log_sigmoid(-z), 0.0)
        suffix = lax.cumsum(log_fail, axis=3, reverse=True) - log_fail
        w = jnp.where(past, jnp.exp(jax.nn.log_sigmoid(z) + suffix), 0.0)
        return jnp.einsum('bhqk,bkhd->bqhd', w.astype(v.dtype), v)

    out = lax.map(block, (jnp.arange(S // Q_BLOCK), to_blocks(q)))
    return from_blocks(out)


def latent_attention(q_nope, q_rope, k_nope, k_rope, v):
    S = k_nope.shape[1]
    scale = (QK_NOPE_DIM + QK_ROPE_DIM) ** -0.5
    key_chunk = jnp.arange(S) // CHUNK

    def block(args):
        b_idx, qn, qr = args
        z = (jnp.einsum('bqhd,bkhd->bhqk', qn, k_nope)
             + jnp.einsum('bqhr,bkr->bhqk', qr, k_rope)).astype(jnp.float32) * scale
        q_chunk = (b_idx * Q_BLOCK + jnp.arange(Q_BLOCK)) // CHUNK
        visible = key_chunk[None, :] <= q_chunk[:, None]
        z = jnp.where(visible, z, -jnp.inf)
        w = jax.nn.softmax(z, axis=-1)
        return jnp.einsum('bhqk,bkhd->bqhd', w.astype(v.dtype), v)

    out = lax.map(block, (jnp.arange(S // Q_BLOCK), to_blocks(q_nope), to_blocks(q_rope)))
    return from_blocks(out)


def setup_inputs(seed: int = 0) -> dict:
    key = jax.random.key(seed)
    ks = jax.random.split(key, 20)

    def w(k, shape, fan_in):
        return jax.random.normal(k, shape, jnp.float32) * fan_in ** -0.5

    def gain(k, n):
        return 1.0 + 0.05 * jax.random.normal(k, (DEPTH, n), jnp.float32)

    x = jax.random.normal(ks[0], (BATCH, SEQ, D_MODEL), jnp.float32)
    p = jax.random.normal(ks[1], (DEPTH, BATCH, SEQ, PLE_DIM), jnp.float32)
    start = jax.random.randint(ks[2], (BATCH, 1), 0, 4096, dtype=jnp.int32)
    positions = start + jnp.arange(SEQ, dtype=jnp.int32)[None, :]
    return {
        'x': x,
        'p': p,
        'positions': positions,
        'norm_pre_g': gain(ks[3], D_MODEL),
        'w_in': w(ks[4], (DEPTH, D_MODEL, D_IN), D_MODEL),
        'q_norm_g': gain(ks[5], Q_LORA_RANK),
        'w_uq': w(ks[6], (DEPTH, Q_LORA_RANK, N_MLA_HEADS * (QK_NOPE_DIM + QK_ROPE_DIM)), Q_LORA_RANK),
        'kv_norm_g': gain(ks[7], KV_LORA_RANK),
        'w_ukv': w(ks[8], (DEPTH, KV_LORA_RANK, N_MLA_HEADS * (QK_NOPE_DIM + V_HEAD_DIM)), KV_LORA_RANK),
        'sb_out_norm_g': gain(ks[9], D_SB),
        'mla_out_norm_g': gain(ks[10], D_MLA),
        'w_out': w(ks[11], (DEPTH, D_MIX, D_MODEL), D_MIX),
        'norm_post_g': gain(ks[12], D_MODEL),
        'w_ple': w(ks[13], (DEPTH, PLE_DIM, D_MODEL), PLE_DIM),
        'ple_norm_g': gain(ks[14], D_MODEL),
        'w_ple_gate': w(ks[15], (DEPTH, D_MODEL, D_MODEL), D_MODEL),
        'b_ple_gate': 0.02 * jax.random.normal(ks[16], (DEPTH, D_MODEL), jnp.float32),
    }


def reference(x, p, positions, norm_pre_g, w_in, q_norm_g, w_uq, kv_norm_g, w_ukv,
              sb_out_norm_g, mla_out_norm_g, w_out, norm_post_g, w_ple, ple_norm_g,
              w_ple_gate, b_ple_gate):
    B, S, _ = x.shape
    for i in range(DEPTH):
        h = rms_norm(x, norm_pre_g[i])
        proj = h @ w_in[i]
        sb_q, sb_k, sb_v, sb_g, c_q, c_kv, k_rope, mla_g = jnp.split(proj, IN_SPLIT_IDX, axis=-1)

        sb_o = stick_breaking_attention(sb_q.reshape(B, S, N_SB_HEADS, HEAD_DIM),
                                        sb_k.reshape(B, S, N_SB_HEADS, HEAD_DIM),
                                        sb_v.reshape(B, S, N_SB_HEADS, HEAD_DIM))
        sb_y = head_rms_norm(sb_o, sb_out_norm_g[i]) * jax.nn.silu(sb_g)

        q = (rms_norm(c_q, q_norm_g[i]) @ w_uq[i]).reshape(B, S, N_MLA_HEADS, QK_NOPE_DIM + QK_ROPE_DIM)
        q_nope, q_rope = q[..., :QK_NOPE_DIM], apply_rope(q[..., QK_NOPE_DIM:], positions)
        kv = (rms_norm(c_kv, kv_norm_g[i]) @ w_ukv[i]).reshape(B, S, N_MLA_HEADS, QK_NOPE_DIM + V_HEAD_DIM)
        k_nope, v = kv[..., :QK_NOPE_DIM], kv[..., QK_NOPE_DIM:]
        k_rope = apply_rope(k_rope, positions)
        mla_o = latent_attention(q_nope, q_rope, k_nope, k_rope, v)
        mla_y = head_rms_norm(mla_o, mla_out_norm_g[i]) * jax.nn.silu(mla_g)

        y = jnp.concatenate([sb_y, mla_y], axis=-1) @ w_out[i]
        x = x + rms_norm(y, norm_post_g[i])

        ple = rms_norm(p[i] @ w_ple[i], ple_norm_g[i])
        x = x + ple * jax.nn.sigmoid(x @ w_ple_gate[i] + b_ple_gate[i])
    return x
```

```cpp
#include <hip/hip_runtime.h>
#include <cstdio>
#include <cstdint>
#include <cmath>
namespace pg8 {
#define PG8_LAS __attribute__((address_space(3)))
typedef unsigned short bf16_t;
typedef short bf16x8 __attribute__((ext_vector_type(8)));
typedef float f32x4 __attribute__((ext_vector_type(4)));
typedef unsigned u32x4 __attribute__((ext_vector_type(4)));
constexpr int BM = 256, BK = 64, HALF = 128, HTB = HALF * BK * 2  , STAGE_BYTES = 8 * HTB, NXCD = 8, WGM = 8;

__host__ __device__ __forceinline__ int lds_byte(int r, int c) { const int st = (r >> 4) * 2 + (c >> 5), rr = r & 15, cc = c & 31, ob = rr * 64 + cc * 2; return st * 1024 + (ob ^ (((ob >> 9) & 1) << 5)); }
__host__ __device__ __forceinline__ void stage_rc(int b, int& R, int& C) { const int st = b / 1024, sb = b % 1024, swz = sb ^ (((sb >> 9) & 1) << 5); R = (st >> 1) * 16 + swz / 64; C = (st & 1) * 32 + (swz % 64) / 2; }
__host__ __device__ __forceinline__ int perm32(int rho) { const int n = rho >> 4, i = rho & 15; return 8 * (i >> 2) + 4 * n + (i & 3); }

struct Unit { int pm, pn; };
struct Gemm { const bf16_t* A; const bf16_t* Bt; int M, N, K; };

struct StaticOrder {
    int nM, nN, nwg, G, c;
    __host__ __device__ void init(int M, int N, int G_, int c_) { nM = M / BM; nN = N / BM; nwg = nM * nN; G = G_; c = c_; }
    __host__ __device__ bool next(int i, Unit& u) const {
        const long L = (long)i * G + c; if (L >= nwg) return false;
        int wgid = (int)L; { const int q = nwg / NXCD, r = nwg % NXCD, xcd = wgid % NXCD, off = wgid / NXCD; wgid = (xcd < r ? xcd * (q + 1) : r * (q + 1) + (xcd - r) * q) + off; }
        const int nig = WGM * nN, gid = wgid / nig, fm = gid * WGM, gsz = (nM - fm) < WGM ? (nM - fm) : WGM;
        u.pm = fm + ((wgid % nig) % gsz); u.pn = (wgid % nig) / gsz; return true;
    }
    __device__ __forceinline__ void a_ready(const Unit&) const {}
    __device__ __forceinline__ void done(const Unit&) const {}
};

__device__ __forceinline__ unsigned cvt_pk_bf16(float lo, float hi) { unsigned r; asm volatile("v_cvt_pk_bf16_f32 %0, %1, %2" : "=v"(r) : "v"(lo), "v"(hi)); return r; }
typedef float f32x2 __attribute__((ext_vector_type(2)));
typedef unsigned u32x2 __attribute__((ext_vector_type(2)));
constexpr float kLog2e = 1.4426950408889634f;
constexpr float kEps = 1e-6f;
constexpr float QS_SB = 0.125f * kLog2e;
constexpr float QS_MLA = 0.10206207261596577f * kLog2e;
__device__ __forceinline__ u32x2 pack4(f32x4 v) { u32x2 w; w.x = cvt_pk_bf16(v[0], v[1]); w.y = cvt_pk_bf16(v[2], v[3]); return w; }
__device__ __forceinline__ float sigmoid_f(float v) { return __builtin_amdgcn_rcpf(1.0f + __builtin_amdgcn_exp2f(-kLog2e * v)); }
__device__ __forceinline__ f32x4 silu4(f32x4 v) { f32x4 o; o[0] = v[0] * sigmoid_f(v[0]); o[1] = v[1] * sigmoid_f(v[1]); o[2] = v[2] * sigmoid_f(v[2]); o[3] = v[3] * sigmoid_f(v[3]); return o; }
__device__ __forceinline__ f32x4 unpack4(u32x2 w) { f32x4 o; o[0] = __uint_as_float(w.x << 16); o[1] = __uint_as_float(w.x & 0xffff0000u); o[2] = __uint_as_float(w.y << 16); o[3] = __uint_as_float(w.y & 0xffff0000u); return o; }
__device__ __forceinline__ float sumsq4(f32x4 v) { return (v[0] * v[0] + v[1] * v[1]) + (v[2] * v[2] + v[3] * v[3]); }
__device__ __forceinline__ void rope4(f32x4& x1, f32x4& x2, const float* cs, int fq) {
    const f32x4 c01 = *(const f32x4*)(cs + 8 * fq), c23 = *(const f32x4*)(cs + 8 * fq + 4);
    const f32x4 co = {c01[0], c01[2], c23[0], c23[2]}, si = {c01[1], c01[3], c23[1], c23[3]};
    const f32x4 a = x1 * co - x2 * si, b = x2 * co + x1 * si;
    x1 = a; x2 = b;
}

struct EpiProj {
    static constexpr bool PERM = false, AFTER_DRAIN = false;
    bf16_t *SBQ, *SBK, *SBV, *GATE, *CQ, *CKV, *MK; float *RQSS, *RKVSS; const float* rpre; const float* cs;
    __device__ __forceinline__ void operator()(const f32x4 (&acc)[2][2][4][2], const Unit& u, int wr, int wc, int fr, int fq) const {
        const int pn = u.pn;
#pragma unroll
        for (int ai = 0; ai < 2; ++ai)
#pragma unroll
            for (int m = 0; m < 4; ++m) {
                const int row = u.pm * BM + ai * HALF + wr * 64 + m * 16 + fr;
                const float rs = rpre[row];
                f32x4 v[2][2];
#pragma unroll
                for (int bj = 0; bj < 2; ++bj)
#pragma unroll
                    for (int n = 0; n < 2; ++n) v[bj][n] = acc[ai][bj][m][n] * rs;
                const int cw = wc * 32 + fq * 4;
                if (pn < 6) {
                    bf16_t* dst = SBQ + (size_t)(pn >> 1) * (size_t)(16u << 20) + (size_t)row * 512 + (pn & 1) * 256 + cw;
                    const float sc = pn < 2 ? QS_SB : 1.0f;
#pragma unroll
                    for (int bj = 0; bj < 2; ++bj)
#pragma unroll
                        for (int n = 0; n < 2; ++n) *(u32x2*)(dst + bj * HALF + n * 16) = pack4(v[bj][n] * sc);
                } else if (pn < 8) {
                    bf16_t* dst = GATE + (size_t)row * 1024 + (pn - 6) * 256 + cw;
#pragma unroll
                    for (int bj = 0; bj < 2; ++bj)
#pragma unroll
                        for (int n = 0; n < 2; ++n) *(u32x2*)(dst + bj * HALF + n * 16) = pack4(silu4(v[bj][n]));
                } else if (pn == 8) {
                    bf16_t* dst = CQ + (size_t)row * 256 + cw; float ss = 0.f;
#pragma unroll
                    for (int bj = 0; bj < 2; ++bj)
#pragma unroll
                        for (int n = 0; n < 2; ++n) { *(u32x2*)(dst + bj * HALF + n * 16) = pack4(v[bj][n]); ss += sumsq4(v[bj][n]); }
                    ss += __shfl_xor(ss, 16); ss += __shfl_xor(ss, 32);
                    if (fq == 0) RQSS[(size_t)row * 4 + wc] = ss;
                } else if (pn == 9) {
                    bf16_t* dst = CKV + (size_t)row * 256 + cw; float ss = 0.f;
#pragma unroll
                    for (int n = 0; n < 2; ++n) { *(u32x2*)(dst + n * 16) = pack4(v[0][n]); *(u32x2*)(dst + HALF + n * 16) = (u32x2){0u, 0u}; ss += sumsq4(v[0][n]); }
                    ss += __shfl_xor(ss, 16); ss += __shfl_xor(ss, 32);
                    if (fq == 0) RKVSS[(size_t)row * 4 + wc] = ss;
                    if (wc == 0) {
                        f32x4 x1 = v[1][0], x2 = v[1][1]; rope4(x1, x2, cs + (size_t)row * 32, fq);
                        const u32x2 w1 = pack4(x1), w2 = pack4(x2);
                        bf16_t* kd = MK + (size_t)row * 768 + 64 + fq * 4;
#pragma unroll
                        for (int h = 0; h < 8; ++h) { *(u32x2*)(kd + h * 96) = w1; *(u32x2*)(kd + h * 96 + 16) = w2; }
                    } else {
                        bf16_t* gd = GATE + (size_t)row * 1024 + 512 + (wc - 1) * 32 + fq * 4;
#pragma unroll
                        for (int n = 0; n < 2; ++n) *(u32x2*)(gd + n * 16) = pack4(silu4(v[1][n]));
                    }
                } else {
                    const int base = 96 + (pn - 10) * 256 + cw;
#pragma unroll
                    for (int bj = 0; bj < 2; ++bj)
#pragma unroll
                        for (int n = 0; n < 2; ++n) { const int idx = base + bj * HALF + n * 16; if (idx < 512) *(u32x2*)(GATE + (size_t)row * 1024 + 512 + idx) = pack4(silu4(v[bj][n])); }
                }
            }
    }
};
struct EpiQ {
    static constexpr bool PERM = false, AFTER_DRAIN = false;
    bf16_t* MQ; const float* RQSS; const float* cs;
    __device__ __forceinline__ void operator()(const f32x4 (&acc)[2][2][4][2], const Unit& u, int wr, int wc, int fr, int fq) const {
#pragma unroll
        for (int ai = 0; ai < 2; ++ai)
#pragma unroll
            for (int m = 0; m < 4; ++m) {
                const int row = u.pm * BM + ai * HALF + wr * 64 + m * 16 + fr;
                const f32x4 s4 = *(const f32x4*)(RQSS + (size_t)row * 4);
                const float rs = QS_MLA * __builtin_amdgcn_rsqf(((s4[0] + s4[1]) + (s4[2] + s4[3])) * (1.0f / 256.0f) + kEps);
#pragma unroll
                for (int bj = 0; bj < 2; ++bj) {
                    const int g = u.pn * 8 + bj * 4 + wc;
                    f32x4 x1 = acc[ai][bj][m][0] * rs, x2 = acc[ai][bj][m][1] * rs;
                    if (g % 3 == 2) rope4(x1, x2, cs + (size_t)row * 32, fq);
                    bf16_t* dst = MQ + (size_t)row * 768 + g * 32 + fq * 4;
                    *(u32x2*)dst = pack4(x1); *(u32x2*)(dst + 16) = pack4(x2);
                }
            }
    }
};
struct EpiKV {
    static constexpr bool PERM = false, AFTER_DRAIN = false;
    bf16_t *MK, *MV; const float* RKVSS;
    __device__ __forceinline__ void operator()(const f32x4 (&acc)[2][2][4][2], const Unit& u, int wr, int wc, int fr, int fq) const {
#pragma unroll
        for (int ai = 0; ai < 2; ++ai)
#pragma unroll
            for (int m = 0; m < 4; ++m) {
                const int row = u.pm * BM + ai * HALF + wr * 64 + m * 16 + fr;
                const f32x4 s4 = *(const f32x4*)(RKVSS + (size_t)row * 4);
                const float rs = __builtin_amdgcn_rsqf(((s4[0] + s4[1]) + (s4[2] + s4[3])) * (1.0f / 128.0f) + kEps);
#pragma unroll
                for (int bj = 0; bj < 2; ++bj) {
                    const int h = u.pn * 2 + bj;
                    bf16_t* dst = (wc < 2) ? (MK + (size_t)row * 768 + h * 96 + wc * 32 + fq * 4) : (MV + (size_t)row * 512 + h * 64 + (wc - 2) * 32 + fq * 4);
#pragma unroll
                    for (int n = 0; n < 2; ++n) *(u32x2*)(dst + n * 16) = pack4(acc[ai][bj][m][n] * rs);
                }
            }
    }
};
struct EpiStat {
    static constexpr bool PERM = false, AFTER_DRAIN = false;
    bf16_t* OUT; float* SS;
    __device__ __forceinline__ void operator()(const f32x4 (&acc)[2][2][4][2], const Unit& u, int wr, int wc, int fr, int fq) const {
#pragma unroll
        for (int ai = 0; ai < 2; ++ai)
#pragma unroll
            for (int m = 0; m < 4; ++m) {
                const int row = u.pm * BM + ai * HALF + wr * 64 + m * 16 + fr;
                bf16_t* dst = OUT + (size_t)row * 1024 + u.pn * BM + wc * 32 + fq * 4; float ss = 0.f;
#pragma unroll
                for (int bj = 0; bj < 2; ++bj)
#pragma unroll
                    for (int n = 0; n < 2; ++n) { *(u32x2*)(dst + bj * HALF + n * 16) = pack4(acc[ai][bj][m][n]); ss += sumsq4(acc[ai][bj][m][n]); }
                ss += __shfl_xor(ss, 16); ss += __shfl_xor(ss, 32);
                if (fq == 0) SS[(size_t)row * 16 + u.pn * 4 + wc] = ss;
            }
    }
};
struct EpiFinal {
    static constexpr bool PERM = false, AFTER_DRAIN = false;
    const float* x; const bf16_t* Y; const bf16_t* PLE; const float* RY; const float* RP; const float* gpost; const float* gple; const float* bias; float* out;
    __device__ __forceinline__ void operator()(const f32x4 (&acc)[2][2][4][2], const Unit& u, int wr, int wc, int fr, int fq) const {
#pragma unroll
        for (int ai = 0; ai < 2; ++ai)
#pragma unroll
            for (int m = 0; m < 4; ++m) {
                const int row = u.pm * BM + ai * HALF + wr * 64 + m * 16 + fr;
                const float ry = RY[row], rp = RP[row];
#pragma unroll
                for (int bj = 0; bj < 2; ++bj)
#pragma unroll
                    for (int n = 0; n < 2; ++n) {
                        const int col = u.pn * BM + bj * HALF + wc * 32 + n * 16 + fq * 4; const size_t off = (size_t)row * 1024 + col;
                        const f32x4 gp = *(const f32x4*)(gpost + col), gl = *(const f32x4*)(gple + col), bb = *(const f32x4*)(bias + col);
                        const f32x4 xv = *(const f32x4*)(x + off); const f32x4 yv = unpack4(*(const u32x2*)(Y + off)), pv = unpack4(*(const u32x2*)(PLE + off));
                        const f32x4 gt = acc[ai][bj][m][n] + bb; f32x4 o;
#pragma unroll
                        for (int e = 0; e < 4; ++e) o[e] = (xv[e] + yv[e] * ry * gp[e]) + pv[e] * rp * gl[e] * sigmoid_f(gt[e]);
                        *(f32x4*)(out + off) = o;
                    }
            }
    }
};
template <class Epi, class Sched, bool ALIGN_EPI = false, bool SP2 = false>
__device__ __forceinline__ void gemm_phase(PG8_LAS unsigned char* lds, const Gemm g, const Sched& S, const Epi& E) {
    const int tid = threadIdx.x, wid = __builtin_amdgcn_readfirstlane(tid >> 6), lane = tid & 63, wr = wid >> 2, wc = wid & 3, fr = lane & 15, fq = lane >> 4;
    const int K = g.K, nt = K / BK;
    unsigned voffA[2], voffB[2];
#pragma unroll
    for (int i = 0; i < 2; ++i) { int R, C; stage_rc(tid * 16 + i * 8192, R, C); const int Rb = Epi::PERM ? ((R & ~31) + perm32(R & 31)) : R;
        voffA[i] = (unsigned)(R * K + C) * 2u; voffB[i] = (unsigned)(Rb * K + C) * 2u; }
    const size_t kstep = (size_t)(BK * 2);
    const size_t hstep = (size_t)HALF * K * 2;
    const size_t tstep = 2 * hstep;
    const unsigned ldsw = (unsigned)wid * 1024u;
    const int aoff = lds_byte(wr * 64 + fr, fq * 8), boff = lds_byte(wc * 32 + fr, fq * 8);
#define PG8_SA(b, h) (((b) * 2 + (h)) * HTB)
#define PG8_SB(b, h) ((4 + (b) * 2 + (h)) * HTB)
#define PG8_STAGE(bufoff, gbase, voff) do { _Pragma("unroll") for (int _i = 0; _i < 2; ++_i) \
        __builtin_amdgcn_global_load_lds((const unsigned*)((const char*)(gbase) + (voff)[_i]), (PG8_LAS unsigned*)(lds + (bufoff) + ldsw + _i * 8192), 16, 0, 0); } while (0)
#define PG8_LDA(dst, b, h) do { _Pragma("unroll") for (int m = 0; m < 4; ++m) _Pragma("unroll") for (int k = 0; k < 2; ++k) dst[m][k] = *(const PG8_LAS bf16x8*)(lds + PG8_SA(b, h) + aoff + m * 2048 + k * 1024); } while (0)
#define PG8_LDB(dst, b, h) do { _Pragma("unroll") for (int n = 0; n < 2; ++n) _Pragma("unroll") for (int k = 0; k < 2; ++k) dst[n][k] = *(const PG8_LAS bf16x8*)(lds + PG8_SB(b, h) + boff + n * 2048 + k * 1024); } while (0)
#define PG8_MMA(ai, bj, At, Bt) do { __builtin_amdgcn_s_setprio(1); _Pragma("unroll") for (int m = 0; m < 4; ++m) _Pragma("unroll") for (int n = 0; n < 2; ++n) _Pragma("unroll") for (int k = 0; k < 2; ++k) \
        acc[ai][bj][m][n] = __builtin_amdgcn_mfma_f32_16x16x32_bf16(Bt[n][k], At[m][k], acc[ai][bj][m][n], 0, 0, 0); __builtin_amdgcn_s_setprio(0); } while (0)
#define PG8_WAIT_V(n) asm volatile("s_waitcnt vmcnt(" #n ")" ::: "memory")
#define PG8_WAIT_L(n) asm volatile("s_waitcnt lgkmcnt(" #n ")" ::: "memory")
#define PG8_BAR __builtin_amdgcn_s_barrier()
#define PG8_SCHED __builtin_amdgcn_sched_barrier(0)
    Unit cur, nxt; int ui = 0;
    if (!S.next(0, cur)) return;
    f32x4 acc[2][2][4][2];
#pragma unroll
    for (int a = 0; a < 2; ++a)
#pragma unroll
        for (int b = 0; b < 2; ++b)
#pragma unroll
            for (int m = 0; m < 4; ++m)
#pragma unroll
                for (int n = 0; n < 2; ++n) acc[a][b][m][n] = (f32x4){0.f, 0.f, 0.f, 0.f};
    bf16x8 At[4][2], B0[2][2], B1[2][2];
    const char* cA = (const char*)g.A + (size_t)cur.pm * tstep; const char* cB = (const char*)g.Bt + (size_t)cur.pn * tstep;
    S.a_ready(cur);
    if constexpr (SP2) {
        PG8_STAGE(PG8_SB(0, 0), cB, voffB); PG8_STAGE(PG8_SB(0, 1), cB + hstep, voffB); PG8_STAGE(PG8_SA(0, 0), cA, voffA); PG8_STAGE(PG8_SA(0, 1), cA + hstep, voffA);
        if (wr == 1) PG8_BAR;
        PG8_WAIT_V(2); PG8_BAR;
        PG8_STAGE(PG8_SB(1, 0), cB + kstep, voffB); PG8_STAGE(PG8_SA(1, 0), cA + kstep, voffA); PG8_STAGE(PG8_SB(1, 1), cB + hstep + kstep, voffB);
        PG8_WAIT_V(6); PG8_BAR;
    } else {
        PG8_STAGE(PG8_SB(0, 0), cB, voffB); PG8_STAGE(PG8_SA(0, 0), cA, voffA); PG8_STAGE(PG8_SB(0, 1), cB + hstep, voffB); PG8_STAGE(PG8_SA(0, 1), cA + hstep, voffA);
        if (wr == 1) PG8_BAR;
        PG8_WAIT_V(4); PG8_BAR;
        PG8_STAGE(PG8_SB(1, 0), cB + kstep, voffB); PG8_STAGE(PG8_SA(1, 0), cA + kstep, voffA); PG8_STAGE(PG8_SB(1, 1), cB + hstep + kstep, voffB);
        PG8_WAIT_V(6); PG8_BAR;
    }
    for (;;) {
        const bool has_next = S.next(ui + 1, nxt);
        const char* nA = has_next ? (const char*)g.A + (size_t)nxt.pm * tstep : cA; const char* nB = has_next ? (const char*)g.Bt + (size_t)nxt.pn * tstep : cB;
        for (int t = 0; t < nt; t += 2) {
            const bool last = (t == nt - 2);
            const char* a1 = cA + (size_t)(t + 1) * kstep;
            const char* a2 = last ? nA : cA + (size_t)(t + 2) * kstep; const char* b2 = last ? nB : cB + (size_t)(t + 2) * kstep;
            const char* a3 = a2 + kstep; const char* b3 = b2 + kstep;
            if (last && has_next) S.a_ready(nxt);
            if constexpr (SP2) {
            PG8_LDB(B0, 0, 0); PG8_LDB(B1, 0, 1); PG8_SCHED; PG8_LDA(At, 0, 0); PG8_STAGE(PG8_SA(1, 1), a1 + hstep, voffA);
            PG8_WAIT_V(8); PG8_WAIT_L(0); PG8_BAR; PG8_MMA(0, 0, At, B0); PG8_MMA(0, 1, At, B1); PG8_BAR; PG8_SCHED;
            PG8_LDA(At, 0, 1); PG8_STAGE(PG8_SB(0, 0), b2, voffB); PG8_STAGE(PG8_SB(0, 1), b2 + hstep, voffB); PG8_STAGE(PG8_SA(0, 0), a2, voffA);
            PG8_WAIT_V(8); PG8_WAIT_L(0); PG8_BAR; PG8_MMA(1, 0, At, B0); PG8_MMA(1, 1, At, B1); PG8_BAR; PG8_SCHED;
            PG8_LDB(B0, 1, 0); PG8_LDB(B1, 1, 1); PG8_SCHED; PG8_LDA(At, 1, 0); PG8_STAGE(PG8_SA(0, 1), a2 + hstep, voffA);
            PG8_WAIT_V(8); PG8_WAIT_L(0); PG8_BAR; PG8_MMA(0, 0, At, B0); PG8_MMA(0, 1, At, B1); PG8_BAR; PG8_SCHED;
            PG8_LDA(At, 1, 1); PG8_STAGE(PG8_SB(1, 0), b3, voffB); PG8_STAGE(PG8_SB(1, 1), b3 + hstep, voffB); PG8_STAGE(PG8_SA(1, 0), a3, voffA);
            PG8_WAIT_V(8); PG8_WAIT_L(0); PG8_BAR; PG8_MMA(1, 0, At, B0); PG8_MMA(1, 1, At, B1); PG8_BAR; PG8_SCHED;
            } else {
            PG8_LDB(B0, 0, 0); PG8_SCHED; PG8_LDA(At, 0, 0); PG8_STAGE(PG8_SA(1, 1), a1 + hstep, voffA);
            PG8_WAIT_L(8); PG8_BAR; PG8_WAIT_L(0); PG8_MMA(0, 0, At, B0); PG8_BAR; PG8_SCHED;
            PG8_LDB(B1, 0, 1); PG8_STAGE(PG8_SB(0, 0), b2, voffB);
            PG8_BAR; PG8_WAIT_L(0); PG8_MMA(0, 1, At, B1); PG8_BAR;
            PG8_LDA(At, 0, 1); PG8_STAGE(PG8_SA(0, 0), a2, voffA);
            PG8_BAR; PG8_WAIT_L(0); PG8_MMA(1, 0, At, B0); PG8_BAR; PG8_SCHED;
            PG8_STAGE(PG8_SB(0, 1), b2 + hstep, voffB);
            PG8_WAIT_V(6); PG8_BAR; PG8_MMA(1, 1, At, B1); PG8_BAR;
            PG8_LDB(B0, 1, 0); PG8_SCHED; PG8_LDA(At, 1, 0); PG8_STAGE(PG8_SA(0, 1), a2 + hstep, voffA);
            PG8_WAIT_L(8); PG8_BAR; PG8_WAIT_L(0); PG8_MMA(0, 0, At, B0); PG8_BAR; PG8_SCHED;
            PG8_LDB(B1, 1, 1); PG8_STAGE(PG8_SB(1, 0), b3, voffB);
            PG8_BAR; PG8_WAIT_L(0); PG8_MMA(0, 1, At, B1); PG8_BAR;
            PG8_LDA(At, 1, 1); PG8_STAGE(PG8_SA(1, 0), a3, voffA);
            PG8_BAR; PG8_WAIT_L(0); PG8_MMA(1, 0, At, B0); PG8_BAR; PG8_SCHED;
            PG8_STAGE(PG8_SB(1, 1), b3 + hstep, voffB);
            PG8_WAIT_V(6); PG8_BAR; PG8_MMA(1, 1, At, B1); PG8_BAR;
            }
        }
        if constexpr (ALIGN_EPI) { if (wr == 0) PG8_BAR; }
        if constexpr (!Epi::AFTER_DRAIN) { E(acc, cur, wr, wc, fr, fq); S.done(cur); }
        if (!has_next) break;
#pragma unroll
        for (int a = 0; a < 2; ++a)
#pragma unroll
            for (int b = 0; b < 2; ++b)
#pragma unroll
                for (int m = 0; m < 4; ++m)
#pragma unroll
                    for (int n = 0; n < 2; ++n) acc[a][b][m][n] = (f32x4){0.f, 0.f, 0.f, 0.f};
        cur = nxt; cA = nA; cB = nB; ++ui;
        if constexpr (ALIGN_EPI) { if (wr == 1) PG8_BAR; }
    }
    PG8_WAIT_V(0);
    if constexpr (!ALIGN_EPI) { if (wr == 0) PG8_BAR; }
    PG8_BAR;
    if constexpr (Epi::AFTER_DRAIN) { E.fused(acc, cur, wr, wc, fr, fq, lds, wid, lane); S.done(cur); }
#undef PG8_SA
#undef PG8_SB
#undef PG8_STAGE
#undef PG8_LDA
#undef PG8_LDB
#undef PG8_MMA
#undef PG8_WAIT_V
#undef PG8_WAIT_L
#undef PG8_BAR
#undef PG8_SCHED
}
}
namespace att {
using bf16x8 = __attribute__((ext_vector_type(8))) short;
using s16x4 = __attribute__((ext_vector_type(4))) short;
using f32x16 = __attribute__((ext_vector_type(16))) float;
using f32x4 = __attribute__((ext_vector_type(4))) float;
using u32x4 = __attribute__((ext_vector_type(4))) unsigned;
typedef unsigned short bf16_t;
#define ALAS __attribute__((address_space(3)))
constexpr int SEQ = 4096, KSLOT = 16384, VSLOT = 8192, NSLOT = 3;
constexpr int L_K = 0, L_V = NSLOT * KSLOT, L_WS = L_V + NSLOT * VSLOT, L_FLAG = L_WS + 8 * 64 * 4, L_OST = L_FLAG + 256, L_END = L_OST + 8 * 8192;
constexpr float kEps = 1e-6f;
constexpr float SB_DONE = 151.0f;
__device__ __forceinline__ int crow(int r, int hi) { return (r & 3) + 8 * (r >> 2) + 4 * hi; }
__device__ __forceinline__ void glds16(const void* gsrc, unsigned lds_dst) { unsigned keep;
    asm volatile("s_mov_b32 %0, m0\n\ts_mov_b32 m0, %2\n\ts_nop 0\n\tglobal_load_lds_dwordx4 %1, off\n\ts_mov_b32 m0, %0" : "=&s"(keep) : "v"(gsrc), "s"(lds_dst) : "memory"); }
typedef float f32x2_t __attribute__((ext_vector_type(2))); typedef __bf16 bf16x2_t __attribute__((ext_vector_type(2)));
__device__ __forceinline__ unsigned cvtpk(float lo, float hi) { f32x2_t v = {lo, hi}; bf16x2_t b = __builtin_convertvector(v, bf16x2_t); return __builtin_bit_cast(unsigned, b); }
#define A_WAIT_BAR(N) asm volatile("s_waitcnt vmcnt(" #N ") lgkmcnt(0)\n\ts_barrier" ::: "memory")

template <int ND0> __device__ __forceinline__ void qkt(f32x16& p0, f32x16& p1, const ALAS char* Kslot, const bf16x8* qr, int r32, int hi) {
    const ALAS char* kb = Kslot + hi * 1024 + r32 * 16;
    p0 = f32x16{}; p1 = f32x16{};
#pragma unroll
    for (int d0 = 0; d0 < ND0; ++d0) {
        const bf16x8 b0 = *(const ALAS bf16x8*)(kb + d0 * 2048);
        const bf16x8 b1 = *(const ALAS bf16x8*)(kb + d0 * 2048 + 512);
        p0 = __builtin_amdgcn_mfma_f32_32x32x16_bf16(b0, qr[d0], p0, 0, 0, 0);
        p1 = __builtin_amdgcn_mfma_f32_32x32x16_bf16(b1, qr[d0], p1, 0, 0, 0);
    }
}
__device__ __forceinline__ void pv(f32x16* o, int vb, bf16x8 pa0, bf16x8 pa1, bf16x8 pa2, bf16x8 pa3) {
#pragma unroll
    for (int d0 = 0; d0 < 2; ++d0) { s16x4 lo[4], hi[4];
#pragma unroll
        for (int ks = 0; ks < 4; ++ks) {
            asm volatile("ds_read_b64_tr_b16 %0,%1 offset:%c2" : "=&v"(lo[ks]) : "v"(vb), "i"(d0 * 4096 + ks * 1024) : "memory");
            asm volatile("ds_read_b64_tr_b16 %0,%1 offset:%c2" : "=&v"(hi[ks]) : "v"(vb), "i"(d0 * 4096 + ks * 1024 + 512) : "memory"); }
        asm volatile("s_waitcnt lgkmcnt(0)" ::: "memory"); __builtin_amdgcn_sched_barrier(0);
#define A_PK(k) (bf16x8){lo[k][0], lo[k][1], lo[k][2], lo[k][3], hi[k][0], hi[k][1], hi[k][2], hi[k][3]}
        o[d0] = __builtin_amdgcn_mfma_f32_32x32x16_bf16(pa0, A_PK(0), o[d0], 0, 0, 0);
        o[d0] = __builtin_amdgcn_mfma_f32_32x32x16_bf16(pa1, A_PK(1), o[d0], 0, 0, 0);
        o[d0] = __builtin_amdgcn_mfma_f32_32x32x16_bf16(pa2, A_PK(2), o[d0], 0, 0, 0);
        o[d0] = __builtin_amdgcn_mfma_f32_32x32x16_bf16(pa3, A_PK(3), o[d0], 0, 0, 0);
#undef A_PK
    }
}
__device__ __forceinline__ float xhalf_sum(float v) { auto rr = __builtin_amdgcn_permlane32_swap(__float_as_uint(v), __float_as_uint(v), false, false); return __uint_as_float(rr[0]) + __uint_as_float(rr[1]); }
__device__ __forceinline__ float xhalf_max(float v) { auto rr = __builtin_amdgcn_permlane32_swap(__float_as_uint(v), __float_as_uint(v), false, false); return fmaxf(__uint_as_float(rr[0]), __uint_as_float(rr[1])); }

template <bool SBK> __device__ __forceinline__ void attn_unit(int b, int h, int qb, const bf16_t* Q, const bf16_t* K, const bf16_t* V, const bf16_t* gate, const float* gnorm, bf16_t* out, int goff, ALAS char* shm) {
    constexpr int DQK = SBK ? 64 : 96, QP = SBK ? 512 : 768, ND0 = DQK / 16;
    const int tid = threadIdx.x, lane = tid & 63, r32 = lane & 31, hi = lane >> 5; const int wid = __builtin_amdgcn_readfirstlane(tid >> 6);
    const long rowbase = (long)b * SEQ; const int q0 = qb * 256;
    const bf16_t* Qw = Q + (rowbase + q0 + wid * 32) * QP + h * DQK;
    const bf16_t* Kh = K + rowbase * QP + h * DQK; const bf16_t* Vh = V + rowbase * 512 + h * 64;
    const unsigned lds0 = (unsigned)(uintptr_t)shm;
    ALAS float* wsf = (ALAS float*)(shm + L_WS) + wid * 64;
    ALAS unsigned* flags = (ALAS unsigned*)(shm + L_FLAG);
    const bf16_t* ksrc = Kh + (long)lane * QP + wid * 8;
    const bf16_t* ksrc2 = Kh + (long)lane * QP + (8 + (wid & 3)) * 8;
    const bf16_t* vsrc = Vh + (long)(16 * (wid & 3) + (lane >> 2)) * 512 + (wid >> 2) * 32 + (lane & 3) * 8;
    const unsigned kdst = lds0 + L_K + wid * 1024, vdst = lds0 + L_V + wid * 1024;
    const int NT = 4 * qb + 4;
    const int tw = 4 * qb + (wid >> 1);
#define A_TILE(i) (SBK ? (NT - 1 - (i)) : (i))
#define A_DMA(i, s) do { const int t_ = A_TILE(i); glds16(ksrc + (long)t_ * 64 * QP, (unsigned)__builtin_amdgcn_readfirstlane(kdst + (s) * KSLOT)); \
        if (!SBK) glds16(ksrc2 + (long)t_ * 64 * QP, (unsigned)__builtin_amdgcn_readfirstlane(kdst + 8192 + (s) * KSLOT)); \
        glds16(vsrc + (long)t_ * 64 * 512, (unsigned)__builtin_amdgcn_readfirstlane(vdst + (s) * VSLOT)); } while (0)
    A_DMA(0, 0); A_DMA(1, 1);
    bf16x8 qr[ND0];
#pragma unroll
    for (int d0 = 0; d0 < ND0; ++d0) qr[d0] = *(const bf16x8*)(Qw + (long)r32 * QP + d0 * 16 + hi * 8);
    f32x16 o[2]; o[0] = f32x16{}; o[1] = f32x16{};
    float m_run = -INFINITY, l_run = 0.f, carry = 0.f;
    const int vb0 = (int)(lds0 + L_V) + ((lane >> 4) & 1) * 32 + (lane & 3) * 8 + (4 * hi + ((lane & 15) >> 2)) * 64;
    int slot = 0;
    for (int i = 0; i < NT; ++i) {
        if (i + 1 < NT) { if (SBK) { A_WAIT_BAR(2); } else { A_WAIT_BAR(3); } } else { A_WAIT_BAR(0); }
        if (SBK && i > 0) {
            const ALAS unsigned* fl = flags + ((i - 1) & 1) * 8; unsigned all = 1u;
#pragma unroll
            for (int w = 0; w < 8; ++w) all &= fl[w];
            if (all) break;
        }
        if (i + 2 < NT) { const int s2 = (slot >= 1) ? slot - 1 : slot + 2; A_DMA(i + 2, s2); }
        const int t = A_TILE(i);
        if (t <= tw) {
            f32x16 p0, p1;
            qkt<ND0>(p0, p1, shm + L_K + slot * KSLOT, qr, r32, hi);
            if (SBK) {
                if (t == tw) { const int qrel = 32 * (wid & 1) + r32;
#pragma unroll
                    for (int r = 0; r < 16; ++r) { const int kv = crow(r, hi); if (kv >= qrel) p0[r] = -INFINITY; if (kv + 32 >= qrel) p1[r] = -INFINITY; } }
                f32x16 s0, s1;
#pragma unroll
                for (int r = 0; r < 16; ++r) {
                    s0[r] = fmaxf(p0[r], 0.f) + __builtin_amdgcn_logf(1.0f + __builtin_amdgcn_exp2f(-fabsf(p0[r])));
                    s1[r] = fmaxf(p1[r], 0.f) + __builtin_amdgcn_logf(1.0f + __builtin_amdgcn_exp2f(-fabsf(p1[r])));
                }
                float lo_[8], up_[8];
#pragma unroll
                for (int i4 = 0; i4 < 8; ++i4) {
                    const float bs = (i4 < 4) ? ((s0[4 * i4] + s0[4 * i4 + 1]) + (s0[4 * i4 + 2] + s0[4 * i4 + 3])) : ((s1[4 * i4 - 16] + s1[4 * i4 - 15]) + (s1[4 * i4 - 14] + s1[4 * i4 - 13]));
                    auto rr = __builtin_amdgcn_permlane32_swap(__float_as_uint(bs), __float_as_uint(bs), false, false);
                    lo_[i4] = __uint_as_float(rr[0]); up_[i4] = __uint_as_float(rr[1]);
                }
                float run = carry;
#pragma unroll
                for (int i4 = 7; i4 >= 0; --i4) {
                    float c = run + (hi == 0 ? up_[i4] : 0.f);
#pragma unroll
                    for (int e = 3; e >= 0; --e) {
                        if (i4 < 4) { c += s0[4 * i4 + e]; p0[4 * i4 + e] = __builtin_amdgcn_exp2f(p0[4 * i4 + e] - c); }
                        else { c += s1[4 * i4 - 16 + e]; p1[4 * i4 - 16 + e] = __builtin_amdgcn_exp2f(p1[4 * i4 - 16 + e] - c); }
                    }
                    run += lo_[i4] + up_[i4];
                }
                carry = run;
            } else {
                float rm = fmaxf(p0[0], p1[0]);
#pragma unroll
                for (int r = 1; r < 16; ++r) rm = fmaxf(rm, fmaxf(p0[r], p1[r]));
                rm = xhalf_max(rm);
                const float m_new = fmaxf(m_run, rm);
                const float alpha = __builtin_amdgcn_exp2f(m_run - m_new);
                float ls = 0.f;
#pragma unroll
                for (int r = 0; r < 16; ++r) { p0[r] = __builtin_amdgcn_exp2f(p0[r] - m_new); p1[r] = __builtin_amdgcn_exp2f(p1[r] - m_new); ls += p0[r] + p1[r]; }
                l_run = l_run * alpha + ls; m_run = m_new;
                if (!__all(alpha == 1.0f)) {
                    if (hi == 0) wsf[r32] = alpha;
#pragma unroll
                    for (int r = 0; r < 16; ++r) { const float f = wsf[crow(r, hi)]; o[0][r] *= f; o[1][r] *= f; }
                }
            }
            u32x4 pw0, pw1, pw2, pw3;
            pw0 = (u32x4){cvtpk(p0[0], p0[1]), cvtpk(p0[2], p0[3]), cvtpk(p0[4], p0[5]), cvtpk(p0[6], p0[7])};
            pw1 = (u32x4){cvtpk(p0[8], p0[9]), cvtpk(p0[10], p0[11]), cvtpk(p0[12], p0[13]), cvtpk(p0[14], p0[15])};
            pw2 = (u32x4){cvtpk(p1[0], p1[1]), cvtpk(p1[2], p1[3]), cvtpk(p1[4], p1[5]), cvtpk(p1[6], p1[7])};
            pw3 = (u32x4){cvtpk(p1[8], p1[9]), cvtpk(p1[10], p1[11]), cvtpk(p1[12], p1[13]), cvtpk(p1[14], p1[15])};
            pv(o, vb0 + slot * VSLOT, __builtin_bit_cast(bf16x8, pw0), __builtin_bit_cast(bf16x8, pw1), __builtin_bit_cast(bf16x8, pw2), __builtin_bit_cast(bf16x8, pw3));
        }
        if (SBK) { const bool done = (t <= tw) && __all(carry > SB_DONE); if (lane == 0) flags[(i & 1) * 8 + wid] = done ? 1u : 0u; }
        slot = (slot == NSLOT - 1) ? 0 : slot + 1;
    }
    A_WAIT_BAR(0);
    float rli[16];
    if (!SBK) {
        const float lt = xhalf_sum(l_run);
        if (hi == 0) wsf[32 + r32] = lt;
#pragma unroll
        for (int r = 0; r < 16; ++r) rli[r] = __builtin_amdgcn_rcpf(wsf[32 + crow(r, hi)]);
    } else {
#pragma unroll
        for (int r = 0; r < 16; ++r) rli[r] = 1.0f;
    }
    ALAS float* stg = (ALAS float*)(shm + L_OST) + wid * 2048;
#pragma unroll
    for (int r = 0; r < 16; ++r) { const int orow = crow(r, hi);
#pragma unroll
        for (int d0 = 0; d0 < 2; ++d0) stg[orow * 64 + d0 * 32 + r32] = o[d0][r] * rli[r]; }
    const long grow0 = rowbase + q0 + wid * 32;
#pragma unroll
    for (int i = 0; i < 4; ++i) {
        const int row = i * 8 + (lane >> 3), ch = lane & 7;
        const f32x4 a = *(const ALAS f32x4*)(stg + row * 64 + ch * 8), c = *(const ALAS f32x4*)(stg + row * 64 + ch * 8 + 4);
        float ss = ((a[0] * a[0] + a[1] * a[1]) + (a[2] * a[2] + a[3] * a[3])) + ((c[0] * c[0] + c[1] * c[1]) + (c[2] * c[2] + c[3] * c[3]));
        ss += __shfl_xor(ss, 1); ss += __shfl_xor(ss, 2); ss += __shfl_xor(ss, 4);
        const float rn = 1.0f / sqrtf(ss * (1.0f / 64.0f) + kEps);
        const size_t off = (size_t)(grow0 + row) * 1024 + goff + h * 64 + ch * 8;
        const u32x4 gv = *(const u32x4*)(gate + off);
        const f32x4 g0 = *(const f32x4*)(gnorm + h * 64 + ch * 8), g1 = *(const f32x4*)(gnorm + h * 64 + ch * 8 + 4);
        float v[8];
#pragma unroll
        for (int e = 0; e < 4; ++e) { v[e] = a[e] * rn * g0[e]; v[4 + e] = c[e] * rn * g1[e]; }
        u32x4 w;
#pragma unroll
        for (int e = 0; e < 4; ++e) { const unsigned gw = gv[e]; w[e] = cvtpk(v[2 * e] * __uint_as_float(gw << 16), v[2 * e + 1] * __uint_as_float(gw & 0xffff0000u)); }
        *(u32x4*)(out + off) = w;
    }
    A_WAIT_BAR(0);
#undef A_TILE
#undef A_DMA
}
}
#include <hip/hip_cooperative_groups.h>
namespace cg = cooperative_groups;
#ifndef MK_N_LAUNCHES
#define MK_N_LAUNCHES 1
#endif
constexpr int NWAVES = 8;
constexpr int N_PHASES = 7;
constexpr int M = 32768, D = 1024, SEQ = 4096, NIN = 2976, NINP = 3072, PLE = 256;
constexpr size_t MiB = 1u << 20;
constexpr size_t WS_A = 0;
constexpr size_t WS_B = 64 * MiB;
constexpr size_t WS_PLE = 128 * MiB;
constexpr size_t WS_SBQ = 192 * MiB, WS_SBK = 224 * MiB, WS_SBV = 256 * MiB;
constexpr size_t WS_MQ = 288 * MiB, WS_MK = 336 * MiB, WS_MV = 384 * MiB;
constexpr size_t WS_PB = 416 * MiB, WS_CQ = 432 * MiB, WS_CKV = 448 * MiB;
constexpr size_t WS_WIN = 464 * MiB;
constexpr size_t WS_WUQ = 470 * MiB;
constexpr size_t WS_WUKV = 471 * MiB;
constexpr size_t WS_WOUT = 472 * MiB;
constexpr size_t WS_WPLE = 474 * MiB;
constexpr size_t WS_WPG = 475 * MiB;
constexpr size_t WS_CS = 477 * MiB;
constexpr size_t WS_RPRE = 481 * MiB;
constexpr size_t WS_RQSS = 482 * MiB;
constexpr size_t WS_RKVSS = 483 * MiB;
constexpr size_t WS_YSS = 484 * MiB;
constexpr size_t WS_PSS = 486 * MiB;
constexpr size_t WS_RY = 488 * MiB, WS_RP = 489 * MiB;
constexpr size_t WS_END = 490 * MiB;
constexpr int LDS_BYTES = 147456;
static_assert(WS_SBK - WS_SBQ == 32 * MiB && WS_SBV - WS_SBK == 32 * MiB, "EpiProj addresses SBK/SBV relative to SBQ");
static_assert(att::L_END <= LDS_BYTES && pg8::STAGE_BYTES <= LDS_BYTES, "LDS map");

typedef unsigned short bf16;
typedef unsigned v4u __attribute__((ext_vector_type(4)));
typedef unsigned v2u __attribute__((ext_vector_type(2)));
typedef float f32x4 __attribute__((ext_vector_type(4)));
#define LAS __attribute__((address_space(3)))
__device__ __forceinline__ unsigned f2bf(float f) { unsigned u = __builtin_bit_cast(unsigned, f); return (u + 0x7fffu + ((u >> 16) & 1u)) >> 16; }
__device__ __forceinline__ unsigned pk2(float lo, float hi) { return f2bf(lo) | (f2bf(hi) << 16); }
__device__ __forceinline__ float wave_sum(float v) {
#pragma unroll
    for (int o = 1; o < 64; o <<= 1) v += __shfl_xor(v, o);
    return v;
}
__device__ __forceinline__ void transpose_item(const float* W, int K, int N, bf16* WT, int ldk, const float* gain, LAS float* scr, int item, int lane) {
    const int nblk = N / 32, kb = item / nblk, nb = item % nblk, k0 = 64 * kb, n0 = 32 * nb;
#pragma unroll 8
    for (int i = 0; i < 32; ++i) { const int kk = 2 * i + (lane >> 5); const float gk = gain ? gain[k0 + kk] : 1.0f; scr[kk * 33 + (lane & 31)] = W[(size_t)(k0 + kk) * N + n0 + (lane & 31)] * gk; }
    asm volatile("s_waitcnt lgkmcnt(0)" ::: "memory");
    const int c = lane & 7;
#pragma unroll
    for (int j = 0; j < 4; ++j) { const int n = (lane >> 3) + 8 * j; const LAS float* s = scr + (8 * c) * 33 + n;
        v4u o; o.x = pk2(s[0 * 33], s[1 * 33]); o.y = pk2(s[2 * 33], s[3 * 33]); o.z = pk2(s[4 * 33], s[5 * 33]); o.w = pk2(s[6 * 33], s[7 * 33]);
        *(v4u*)(WT + (size_t)(n0 + n) * ldk + k0 + 8 * c) = o; }
    asm volatile("s_waitcnt lgkmcnt(0)" ::: "memory");
}

__device__ __forceinline__ int opq(int v) { asm volatile("" : "+s"(v)); return v; }
struct Args { const float* in[17]; const int* pos; float* out; unsigned char* ws; int ph_lo, ph_hi; };

__global__ void __launch_bounds__(NWAVES * 64, 2) fwd_kernel(Args args) {
    extern __shared__ __attribute__((aligned(16))) unsigned char lds[];
    const int tid = threadIdx.x, lane = tid & 63, wave = __builtin_amdgcn_readfirstlane(tid >> 6);
    const int G = gridDim.x; const int bx = blockIdx.x; const int vcu = (G % 8 == 0) ? (bx % 8) * (G / 8) + bx / 8 : bx;
    unsigned char* ws = args.ws;
    const float* x = args.in[0]; const float* pin = args.in[1];
    const float* g_pre = args.in[3]; const float* w_in = args.in[4]; const float* g_q = args.in[5]; const float* w_uq = args.in[6]; const float* g_kv = args.in[7]; const float* w_ukv = args.in[8];
    const float* g_sb = args.in[9]; const float* g_mla = args.in[10]; const float* w_out = args.in[11]; const float* g_post = args.in[12]; const float* w_ple = args.in[13]; const float* g_ple = args.in[14];
    const float* w_pg = args.in[15]; const float* b_pg = args.in[16];
    bf16* XB = (bf16*)(ws + WS_A); bf16* MIX = (bf16*)(ws + WS_A); bf16* X1B = (bf16*)(ws + WS_A);
    bf16* GATE = (bf16*)(ws + WS_B); bf16* YB = (bf16*)(ws + WS_B); bf16* PLEB = (bf16*)(ws + WS_PLE);
    bf16* SBQ = (bf16*)(ws + WS_SBQ); bf16* SBK = (bf16*)(ws + WS_SBK); bf16* SBV = (bf16*)(ws + WS_SBV);
    bf16* MQ = (bf16*)(ws + WS_MQ); bf16* MK = (bf16*)(ws + WS_MK); bf16* MV = (bf16*)(ws + WS_MV);
    bf16* PB = (bf16*)(ws + WS_PB); bf16* CQ = (bf16*)(ws + WS_CQ); bf16* CKV = (bf16*)(ws + WS_CKV);
    bf16* WIN = (bf16*)(ws + WS_WIN); bf16* WUQ = (bf16*)(ws + WS_WUQ); bf16* WUKV = (bf16*)(ws + WS_WUKV); bf16* WOUT = (bf16*)(ws + WS_WOUT); bf16* WPLE = (bf16*)(ws + WS_WPLE); bf16* WPG = (bf16*)(ws + WS_WPG);
    float* CS = (float*)(ws + WS_CS); float* RPRE = (float*)(ws + WS_RPRE); float* RQSS = (float*)(ws + WS_RQSS); float* RKVSS = (float*)(ws + WS_RKVSS);
    float* YSS = (float*)(ws + WS_YSS); float* PSS = (float*)(ws + WS_PSS); float* RY = (float*)(ws + WS_RY); float* RP = (float*)(ws + WS_RP);
    const int lo = args.ph_lo, hi = args.ph_hi;
#define IN(k) (lo <= (k) && (k) < hi)
#define SEAM(k) do { if (IN(k) && IN((k) + 1)) { cg::this_grid().sync(); } } while (0)
    const int gw = vcu * NWAVES + wave, NGW = G * NWAVES;

    if (IN(0)) {
        LAS float* scr = (LAS float*)((LAS unsigned char*)lds + wave * 16384);
        constexpr int I_IN = 16 * 93, I_UQ = 4 * 24, I_UKV = 2 * 32, I_OUT = 16 * 32, I_PLE = 4 * 32, I_PG = 16 * 32;
        constexpr int NITEMS = I_IN + I_UQ + I_UKV + I_OUT + I_PLE + I_PG;
        for (int it = gw; it < NITEMS; it += NGW) {
            int r = it;
            if (r < I_IN) { transpose_item(w_in, 1024, NIN, WIN, 1024, g_pre, scr, r, lane); continue; } r -= I_IN;
            if (r < I_UQ) { transpose_item(w_uq, 256, 768, WUQ, 256, g_q, scr, r, lane); continue; } r -= I_UQ;
            if (r < I_UKV) { transpose_item(w_ukv, 128, 1024, WUKV, 256, g_kv, scr, r, lane); continue; } r -= I_UKV;
            if (r < I_OUT) { transpose_item(w_out, 1024, 1024, WOUT, 1024, nullptr, scr, r, lane); continue; } r -= I_OUT;
            if (r < I_PLE) { transpose_item(w_ple, 256, 1024, WPLE, 256, nullptr, scr, r, lane); continue; } r -= I_PLE;
            transpose_item(w_pg, 1024, 1024, WPG, 1024, nullptr, scr, r, lane);
        }
        const int gt = vcu * (NWAVES * 64) + tid, NGT = G * NWAVES * 64;
        for (int i = gt; i < (NINP - NIN) * 1024 / 8; i += NGT) *(v4u*)(WIN + (size_t)NIN * 1024 + (size_t)i * 8) = (v4u){0u, 0u, 0u, 0u};
        for (int i = gt; i < 1024 * 128 / 8; i += NGT) { const int n = i / 16, c = i % 16; *(v4u*)(WUKV + (size_t)n * 256 + 128 + c * 8) = (v4u){0u, 0u, 0u, 0u}; }
        for (int i = gt; i < M * 16; i += NGT) {
            const int row = i >> 4, k = i & 15;
            const float freq = exp2f(-(float)k * 0.8304820237218407f);
            const float ang = (float)args.pos[row] * freq;
            double tt = (double)ang * 0.15915494309189535; tt -= __builtin_rint(tt);
            const float tf = (float)tt;
            CS[(size_t)i * 2] = __builtin_amdgcn_cosf(tf); CS[(size_t)i * 2 + 1] = __builtin_amdgcn_sinf(tf);
        }
        for (int m = gw; m < M; m += NGW) {
            const f32x4* xr = (const f32x4*)(x + (size_t)m * D) + lane; f32x4 v[4]; float s = 0.f;
#pragma unroll
            for (int j = 0; j < 4; ++j) { v[j] = xr[64 * j]; s += (v[j][0] * v[j][0] + v[j][1] * v[j][1]) + (v[j][2] * v[j][2] + v[j][3] * v[j][3]); }
            s = wave_sum(s);
            if (lane == 0) RPRE[m] = 1.0f / sqrtf(s * (1.0f / D) + 1e-6f);
            v2u* o8 = (v2u*)(XB + (size_t)m * D) + lane;
#pragma unroll
            for (int j = 0; j < 4; ++j) o8[64 * j] = (v2u){pk2(v[j][0], v[j][1]), pk2(v[j][2], v[j][3])};
        }
        for (int i = gt; i < M * PLE / 4; i += NGT) { const f32x4 v = *((const f32x4*)pin + i); *((v2u*)PB + i) = (v2u){pk2(v[0], v[1]), pk2(v[2], v[3])}; }
    }
    SEAM(0);

    if (IN(1)) {
        { pg8::Gemm g{XB, WIN, M, NINP, 1024}; pg8::StaticOrder S; S.init(M, NINP, G, bx);
          pg8::EpiProj E{SBQ, SBK, SBV, GATE, CQ, CKV, MK, RQSS, RKVSS, RPRE, CS};
          pg8::gemm_phase<pg8::EpiProj, pg8::StaticOrder, true, true>((PG8_LAS unsigned char*)lds, g, S, E); }
        { pg8::Gemm g{PB, WPLE, M, 1024, opq(256)}; pg8::StaticOrder S; S.init(M, 1024, G, bx);
          pg8::EpiStat E{PLEB, PSS};
          pg8::gemm_phase<pg8::EpiStat, pg8::StaticOrder, true, true>((PG8_LAS unsigned char*)lds, g, S, E); }
    }
    SEAM(1);

    if (IN(2)) {
        { pg8::Gemm g{CQ, WUQ, M, 768, opq(256)}; pg8::StaticOrder S; S.init(M, 768, G, bx);
          pg8::EpiQ E{MQ, RQSS, CS};
          pg8::gemm_phase<pg8::EpiQ, pg8::StaticOrder, true, true>((PG8_LAS unsigned char*)lds, g, S, E); }
        { pg8::Gemm g{CKV, WUKV, M, 1024, opq(256)}; pg8::StaticOrder S; S.init(M, 1024, G, bx);
          pg8::EpiKV E{MK, MV, RKVSS};
          pg8::gemm_phase<pg8::EpiKV, pg8::StaticOrder, true, true>((PG8_LAS unsigned char*)lds, g, S, E); }
    }
    SEAM(2);

    if (IN(3)) {
        __attribute__((address_space(3))) char* shm = (__attribute__((address_space(3))) char*)lds;
        for (int idx = vcu; idx < 1024; idx += G) {
            const int j = idx >> 8, v = idx & 255, bh = v >> 2, s = v & 3;
            const int qb = (j == 0) ? 15 - s : (j == 1) ? s : (j == 2) ? 8 + s : 7 - s;
            att::attn_unit<false>(bh >> 3, bh & 7, qb, MQ, MK, MV, GATE, g_mla, MIX, 512, shm);
        }
        for (int idx = vcu; idx < 1024; idx += G) {
            const int bh = idx >> 4, qb = idx & 15;
            att::attn_unit<true>(bh >> 3, bh & 7, qb, SBQ, SBK, SBV, GATE, g_sb, MIX, 0, shm);
        }
    }
    SEAM(3);

    if (IN(4)) {
        pg8::Gemm g{MIX, WOUT, M, 1024, 1024}; pg8::StaticOrder S; S.init(M, 1024, G, bx);
        pg8::EpiStat E{YB, YSS};
        pg8::gemm_phase<pg8::EpiStat, pg8::StaticOrder, true, true>((PG8_LAS unsigned char*)lds, g, S, E);
    }
    SEAM(4);

    if (IN(5)) {
        for (int m = gw; m < M; m += NGW) {
            float sv = (lane < 16) ? YSS[(size_t)m * 16 + lane] : ((lane < 32) ? PSS[(size_t)m * 16 + lane - 16] : 0.f);
            sv += __shfl_xor(sv, 1); sv += __shfl_xor(sv, 2); sv += __shfl_xor(sv, 4); sv += __shfl_xor(sv, 8);
            const float sy = __shfl(sv, 0), sp = __shfl(sv, 16);
            const float ry = 1.0f / sqrtf(sy * (1.0f / 1024.0f) + 1e-6f), rp = 1.0f / sqrtf(sp * (1.0f / 1024.0f) + 1e-6f);
            if (lane == 0) { RY[m] = ry; RP[m] = rp; }
            const f32x4* xr = (const f32x4*)(x + (size_t)m * D) + lane; const v2u* yr = (const v2u*)(YB + (size_t)m * D) + lane; const f32x4* gr = (const f32x4*)g_post + lane;
            v2u* o8 = (v2u*)(X1B + (size_t)m * D) + lane;
#pragma unroll
            for (int j = 0; j < 4; ++j) { const f32x4 xv = xr[64 * j], gv = gr[64 * j]; const v2u yw = yr[64 * j];
                const float y0 = __uint_as_float(yw.x << 16), y1 = __uint_as_float(yw.x & 0xffff0000u), y2 = __uint_as_float(yw.y << 16), y3 = __uint_as_float(yw.y & 0xffff0000u);
                o8[64 * j] = (v2u){pk2(xv[0] + y0 * ry * gv[0], xv[1] + y1 * ry * gv[1]), pk2(xv[2] + y2 * ry * gv[2], xv[3] + y3 * ry * gv[3])}; }
        }
    }
    SEAM(5);

    if (IN(6)) {
        pg8::Gemm g{X1B, WPG, M, 1024, 1024}; pg8::StaticOrder S; S.init(M, 1024, G, bx);
        pg8::EpiFinal E{x, YB, PLEB, RY, RP, g_post, g_ple, b_pg, args.out};
        pg8::gemm_phase<pg8::EpiFinal, pg8::StaticOrder, true, true>((PG8_LAS unsigned char*)lds, g, S, E);
    }
#undef IN
#undef SEAM
}

extern "C" void kernel_launch(void* const* d_in, const int* in_sizes, int n_in, void* d_out, int out_size, void* d_ws, size_t ws_size, hipStream_t stream) {
    static int grid = 0;
    if (grid == 0) {
        if (n_in != 17 || out_size != M * D || ws_size < WS_END) { fprintf(stderr, "kernel_launch: unexpected shapes (n_in %d, out %d, ws %zu); nothing launched\n", n_in, out_size, ws_size); grid = -1; return; }
        int dev = 0, cus = 0, per_cu = 0;
        if (hipGetDevice(&dev) != hipSuccess || hipDeviceGetAttribute(&cus, hipDeviceAttributeMultiprocessorCount, dev) != hipSuccess) { grid = -1; return; }
        if (hipFuncSetAttribute((const void*)fwd_kernel, hipFuncAttributeMaxDynamicSharedMemorySize, LDS_BYTES) != hipSuccess) { fprintf(stderr, "kernel_launch: hipFuncSetAttribute failed\n"); grid = -1; return; }
        if (hipOccupancyMaxActiveBlocksPerMultiprocessor(&per_cu, (const void*)fwd_kernel, NWAVES * 64, LDS_BYTES) != hipSuccess || per_cu < 1) { fprintf(stderr, "kernel_launch: occupancy query says %d blocks per CU\n", per_cu); per_cu = 1; }
        (void)hipGetLastError();
        grid = cus * 1;
    }
    if (grid < 0) return;
    Args a{};
    for (int i = 0; i < 17; ++i) a.in[i] = (const float*)d_in[i];
    a.pos = (const int*)d_in[2]; a.out = (float*)d_out; a.ws = (unsigned char*)d_ws;
#if MK_N_LAUNCHES == 1
    a.ph_lo = 0; a.ph_hi = N_PHASES;
    void* kargs[] = {&a};
    hipError_t e = hipLaunchCooperativeKernel((const void*)fwd_kernel, dim3(grid), dim3(NWAVES * 64), kargs, LDS_BYTES, stream);
    if (e != hipSuccess) fprintf(stderr, "kernel_launch: cooperative launch failed: %s (grid %d)\n", hipGetErrorString(e), grid);
#else
    for (int li = 0; li < N_PHASES; ++li) { a.ph_lo = li; a.ph_hi = li + 1; hipLaunchKernelGGL(fwd_kernel, dim3(grid), dim3(NWAVES * 64), LDS_BYTES, stream, a); }
#endif
}
```

```cpp
#include <hip/hip_runtime.h>
#include <cstdio>
#include <cstdint>
#include <cmath>
namespace pg8 {
#define PG8_LAS __attribute__((address_space(3)))
typedef unsigned short bf16_t;
typedef short bf16x8 __attribute__((ext_vector_type(8)));
typedef float f32x4 __attribute__((ext_vector_type(4)));
typedef unsigned u32x4 __attribute__((ext_vector_type(4)));
constexpr int BM = 256, BK = 64, HALF = 128, HTB = HALF * BK * 2  , STAGE_BYTES = 8 * HTB, NXCD = 8, WGM = 8;

__host__ __device__ __forceinline__ int lds_byte(int r, int c) { const int st = (r >> 4) * 2 + (c >> 5), rr = r & 15, cc = c & 31, ob = rr * 64 + cc * 2; return st * 1024 + (ob ^ (((ob >> 9) & 1) << 5)); }
__host__ __device__ __forceinline__ void stage_rc(int b, int& R, int& C) { const int st = b / 1024, sb = b % 1024, swz = sb ^ (((sb >> 9) & 1) << 5); R = (st >> 1) * 16 + swz / 64; C = (st & 1) * 32 + (swz % 64) / 2; }
__host__ __device__ __forceinline__ int perm32(int rho) { const int n = rho >> 4, i = rho & 15; return 8 * (i >> 2) + 4 * n + (i & 3); }

struct Unit { int pm, pn; };
struct Gemm { const bf16_t* A; const bf16_t* Bt; int M, N, K; };

struct StaticOrder {
    int nM, nN, nwg, G, c;
    __host__ __device__ void init(int M, int N, int G_, int c_) { nM = M / BM; nN = N / BM; nwg = nM * nN; G = G_; c = c_; }
    __host__ __device__ bool next(int i, Unit& u) const {
        const long L = (long)i * G + c; if (L >= nwg) return false;
        int wgid = (int)L; { const int q = nwg / NXCD, r = nwg % NXCD, xcd = wgid % NXCD, off = wgid / NXCD; wgid = (xcd < r ? xcd * (q + 1) : r * (q + 1) + (xcd - r) * q) + off; }
        const int nig = WGM * nN, gid = wgid / nig, fm = gid * WGM, gsz = (nM - fm) < WGM ? (nM - fm) : WGM;
        u.pm = fm + ((wgid % nig) % gsz); u.pn = (wgid % nig) / gsz; return true;
    }
    __device__ __forceinline__ void a_ready(const Unit&) const {}
    __device__ __forceinline__ void done(const Unit&) const {}
};

__device__ __forceinline__ unsigned cvt_pk_bf16(float lo, float hi) { unsigned r; asm volatile("v_cvt_pk_bf16_f32 %0, %1, %2" : "=v"(r) : "v"(lo), "v"(hi)); return r; }
typedef float f32x2 __attribute__((ext_vector_type(2)));
typedef unsigned u32x2 __attribute__((ext_vector_type(2)));
constexpr float kLog2e = 1.4426950408889634f;
constexpr float kEps = 1e-6f;
constexpr float QS_SB = 0.125f * kLog2e;
constexpr float QS_MLA = 0.10206207261596577f * kLog2e;
__device__ __forceinline__ u32x2 pack4(f32x4 v) { u32x2 w; w.x = cvt_pk_bf16(v[0], v[1]); w.y = cvt_pk_bf16(v[2], v[3]); return w; }
__device__ __forceinline__ float sigmoid_f(float v) { return __builtin_amdgcn_rcpf(1.0f + __builtin_amdgcn_exp2f(-kLog2e * v)); }
__device__ __forceinline__ f32x4 silu4(f32x4 v) { f32x4 o; o[0] = v[0] * sigmoid_f(v[0]); o[1] = v[1] * sigmoid_f(v[1]); o[2] = v[2] * sigmoid_f(v[2]); o[3] = v[3] * sigmoid_f(v[3]); return o; }
__device__ __forceinline__ f32x4 unpack4(u32x2 w) { f32x4 o; o[0] = __uint_as_float(w.x << 16); o[1] = __uint_as_float(w.x & 0xffff0000u); o[2] = __uint_as_float(w.y << 16); o[3] = __uint_as_float(w.y & 0xffff0000u); return o; }
__device__ __forceinline__ float sumsq4(f32x4 v) { return (v[0] * v[0] + v[1] * v[1]) + (v[2] * v[2] + v[3] * v[3]); }
__device__ __forceinline__ void rope4(f32x4& x1, f32x4& x2, const float* cs, int fq) {
    const f32x4 c01 = *(const f32x4*)(cs + 8 * fq), c23 = *(const f32x4*)(cs + 8 * fq + 4);
    const f32x4 co = {c01[0], c01[2], c23[0], c23[2]}, si = {c01[1], c01[3], c23[1], c23[3]};
    const f32x4 a = x1 * co - x2 * si, b = x2 * co + x1 * si;
    x1 = a; x2 = b;
}

struct EpiProj {
    static constexpr bool PERM = false, AFTER_DRAIN = false;
    bf16_t *SBQ, *SBK, *SBV, *GATE, *CQ, *CKV, *MK; float *RQSS, *RKVSS; const float* rpre; const float* cs;
    __device__ __forceinline__ void operator()(const f32x4 (&acc)[2][2][4][2], const Unit& u, int wr, int wc, int fr, int fq) const {
        const int pn = u.pn;
#pragma unroll
        for (int ai = 0; ai < 2; ++ai)
#pragma unroll
            for (int m = 0; m < 4; ++m) {
                const int row = u.pm * BM + ai * HALF + wr * 64 + m * 16 + fr;
                const float rs = rpre[row];
                f32x4 v[2][2];
#pragma unroll
                for (int bj = 0; bj < 2; ++bj)
#pragma unroll
                    for (int n = 0; n < 2; ++n) v[bj][n] = acc[ai][bj][m][n] * rs;
                const int cw = wc * 32 + fq * 4;
                if (pn < 6) {
                    bf16_t* dst = SBQ + (size_t)(pn >> 1) * (size_t)(16u << 20) + (size_t)row * 512 + (pn & 1) * 256 + cw;
                    const float sc = pn < 2 ? QS_SB : 1.0f;
#pragma unroll
                    for (int bj = 0; bj < 2; ++bj)
#pragma unroll
                        for (int n = 0; n < 2; ++n) *(u32x2*)(dst + bj * HALF + n * 16) = pack4(v[bj][n] * sc);
                } else if (pn < 8) {
                    bf16_t* dst = GATE + (size_t)row * 1024 + (pn - 6) * 256 + cw;
#pragma unroll
                    for (int bj = 0; bj < 2; ++bj)
#pragma unroll
                        for (int n = 0; n < 2; ++n) *(u32x2*)(dst + bj * HALF + n * 16) = pack4(silu4(v[bj][n]));
                } else if (pn == 8) {
                    bf16_t* dst = CQ + (size_t)row * 256 + cw; float ss = 0.f;
#pragma unroll
                    for (int bj = 0; bj < 2; ++bj)
#pragma unroll
                        for (int n = 0; n < 2; ++n) { *(u32x2*)(dst + bj * HALF + n * 16) = pack4(v[bj][n]); ss += sumsq4(v[bj][n]); }
                    ss += __shfl_xor(ss, 16); ss += __shfl_xor(ss, 32);
                    if (fq == 0) RQSS[(size_t)row * 4 + wc] = ss;
                } else if (pn == 9) {
                    bf16_t* dst = CKV + (size_t)row * 256 + cw; float ss = 0.f;
#pragma unroll
                    for (int n = 0; n < 2; ++n) { *(u32x2*)(dst + n * 16) = pack4(v[0][n]); *(u32x2*)(dst + HALF + n * 16) = (u32x2){0u, 0u}; ss += sumsq4(v[0][n]); }
                    ss += __shfl_xor(ss, 16); ss += __shfl_xor(ss, 32);
                    if (fq == 0) RKVSS[(size_t)row * 4 + wc] = ss;
                    if (wc == 0) {
                        f32x4 x1 = v[1][0], x2 = v[1][1]; rope4(x1, x2, cs + (size_t)row * 32, fq);
                        const u32x2 w1 = pack4(x1), w2 = pack4(x2);
                        bf16_t* kd = MK + (size_t)row * 768 + 64 + fq * 4;
#pragma unroll
                        for (int h = 0; h < 8; ++h) { *(u32x2*)(kd + h * 96) = w1; *(u32x2*)(kd + h * 96 + 16) = w2; }
                    } else {
                        bf16_t* gd = GATE + (size_t)row * 1024 + 512 + (wc - 1) * 32 + fq * 4;
#pragma unroll
                        for (int n = 0; n < 2; ++n) *(u32x2*)(gd + n * 16) = pack4(silu4(v[1][n]));
                    }
                } else {
                    const int base = 96 + (pn - 10) * 256 + cw;
#pragma unroll
                    for (int bj = 0; bj < 2; ++bj)
#pragma unroll
                        for (int n = 0; n < 2; ++n) { const int idx = base + bj * HALF + n * 16; if (idx < 512) *(u32x2*)(GATE + (size_t)row * 1024 + 512 + idx) = pack4(silu4(v[bj][n])); }
                }
            }
    }
};
struct EpiQ {
    static constexpr bool PERM = false, AFTER_DRAIN = false;
    bf16_t* MQ; const float* RQSS; const float* cs;
    __device__ __forceinline__ void operator()(const f32x4 (&acc)[2][2][4][2], const Unit& u, int wr, int wc, int fr, int fq) const {
#pragma unroll
        for (int ai = 0; ai < 2; ++ai)
#pragma unroll
            for (int m = 0; m < 4; ++m) {
                const int row = u.pm * BM + ai * HALF + wr * 64 + m * 16 + fr;
                const f32x4 s4 = *(const f32x4*)(RQSS + (size_t)row * 4);
                const float rs = QS_MLA * __builtin_amdgcn_rsqf(((s4[0] + s4[1]) + (s4[2] + s4[3])) * (1.0f / 256.0f) + kEps);
#pragma unroll
                for (int bj = 0; bj < 2; ++bj) {
                    const int g = u.pn * 8 + bj * 4 + wc;
                    f32x4 x1 = acc[ai][bj][m][0] * rs, x2 = acc[ai][bj][m][1] * rs;
                    if (g % 3 == 2) rope4(x1, x2, cs + (size_t)row * 32, fq);
                    bf16_t* dst = MQ + (size_t)row * 768 + g * 32 + fq * 4;
                    *(u32x2*)dst = pack4(x1); *(u32x2*)(dst + 16) = pack4(x2);
                }
            }
    }
};
struct EpiKV {
    static constexpr bool PERM = false, AFTER_DRAIN = false;
    bf16_t *MK, *MV; const float* RKVSS;
    __device__ __forceinline__ void operator()(const f32x4 (&acc)[2][2][4][2], const Unit& u, int wr, int wc, int fr, int fq) const {
#pragma unroll
        for (int ai = 0; ai < 2; ++ai)
#pragma unroll
            for (int m = 0; m < 4; ++m) {
                const int row = u.pm * BM + ai * HALF + wr * 64 + m * 16 + fr;
                const f32x4 s4 = *(const f32x4*)(RKVSS + (size_t)row * 4);
                const float rs = __builtin_amdgcn_rsqf(((s4[0] + s4[1]) + (s4[2] + s4[3])) * (1.0f / 128.0f) + kEps);
#pragma unroll
                for (int bj = 0; bj < 2; ++bj) {
                    const int h = u.pn * 2 + bj;
                    bf16_t* dst = (wc < 2) ? (MK + (size_t)row * 768 + h * 96 + wc * 32 + fq * 4) : (MV + (size_t)row * 512 + h * 64 + (wc - 2) * 32 + fq * 4);
#pragma unroll
                    for (int n = 0; n < 2; ++n) *(u32x2*)(dst + n * 16) = pack4(acc[ai][bj][m][n] * rs);
                }
            }
    }
};
struct EpiStat {
    static constexpr bool PERM = false, AFTER_DRAIN = false;
    bf16_t* OUT; float* SS;
    __device__ __forceinline__ void operator()(const f32x4 (&acc)[2][2][4][2], const Unit& u, int wr, int wc, int fr, int fq) const {
#pragma unroll
        for (int ai = 0; ai < 2; ++ai)
#pragma unroll
            for (int m = 0; m < 4; ++m) {
                const int row = u.pm * BM + ai * HALF + wr * 64 + m * 16 + fr;
                bf16_t* dst = OUT + (size_t)row * 1024 + u.pn * BM + wc * 32 + fq * 4; float ss = 0.f;
#pragma unroll
                for (int bj = 0; bj < 2; ++bj)
#pragma unroll
                    for (int n = 0; n < 2; ++n) { *(u32x2*)(dst + bj * HALF + n * 16) = pack4(acc[ai][bj][m][n]); ss += sumsq4(acc[ai][bj][m][n]); }
                ss += __shfl_xor(ss, 16); ss += __shfl_xor(ss, 32);
                if (fq == 0) SS[(size_t)row * 16 + u.pn * 4 + wc] = ss;
            }
    }
};
struct EpiFinal {
    static constexpr bool PERM = false, AFTER_DRAIN = false;
    const float* x; const bf16_t* Y; const bf16_t* PLE; const float* RY; const float* RP; const float* gpost; const float* gple; const float* bias; float* out;
    __device__ __forceinline__ void operator()(const f32x4 (&acc)[2][2][4][2], const Unit& u, int wr, int wc, int fr, int fq) const {
#pragma unroll
        for (int ai = 0; ai < 2; ++ai)
#pragma unroll
            for (int m = 0; m < 4; ++m) {
                const int row = u.pm * BM + ai * HALF + wr * 64 + m * 16 + fr;
                const float ry = RY[row], rp = RP[row];
#pragma unroll
                for (int bj = 0; bj < 2; ++bj)
#pragma unroll
                    for (int n = 0; n < 2; ++n) {
                        const int col = u.pn * BM + bj * HALF + wc * 32 + n * 16 + fq * 4; const size_t off = (size_t)row * 1024 + col;
                        const f32x4 gp = *(const f32x4*)(gpost + col), gl = *(const f32x4*)(gple + col), bb = *(const f32x4*)(bias + col);
                        const f32x4 xv = *(const f32x4*)(x + off); const f32x4 yv = unpack4(*(const u32x2*)(Y + off)), pv = unpack4(*(const u32x2*)(PLE + off));
                        const f32x4 gt = acc[ai][bj][m][n] + bb; f32x4 o;
#pragma unroll
                        for (int e = 0; e < 4; ++e) o[e] = (xv[e] + yv[e] * ry * gp[e]) + pv[e] * rp * gl[e] * sigmoid_f(gt[e]);
                        *(f32x4*)(out + off) = o;
                    }
            }
    }
};
template <class Epi, class Sched, bool ALIGN_EPI = false, bool SP2 = false>
__device__ __forceinline__ void gemm_phase(PG8_LAS unsigned char* lds, const Gemm g, const Sched& S, const Epi& E) {
    const int tid = threadIdx.x, wid = __builtin_amdgcn_readfirstlane(tid >> 6), lane = tid & 63, wr = wid >> 2, wc = wid & 3, fr = lane & 15, fq = lane >> 4;
    const int K = g.K, nt = K / BK;
    unsigned voffA[2], voffB[2];
#pragma unroll
    for (int i = 0; i < 2; ++i) { int R, C; stage_rc(tid * 16 + i * 8192, R, C); const int Rb = Epi::PERM ? ((R & ~31) + perm32(R & 31)) : R;
        voffA[i] = (unsigned)(R * K + C) * 2u; voffB[i] = (unsigned)(Rb * K + C) * 2u; }
    const size_t kstep = (size_t)(BK * 2);
    const size_t hstep = (size_t)HALF * K * 2;
    const size_t tstep = 2 * hstep;
    const unsigned ldsw = (unsigned)wid * 1024u;
    const int aoff = lds_byte(wr * 64 + fr, fq * 8), boff = lds_byte(wc * 32 + fr, fq * 8);
#define PG8_SA(b, h) (((b) * 2 + (h)) * HTB)
#define PG8_SB(b, h) ((4 + (b) * 2 + (h)) * HTB)
#define PG8_STAGE(bufoff, gbase, voff) do { _Pragma("unroll") for (int _i = 0; _i < 2; ++_i) \
        __builtin_amdgcn_global_load_lds((const unsigned*)((const char*)(gbase) + (voff)[_i]), (PG8_LAS unsigned*)(lds + (bufoff) + ldsw + _i * 8192), 16, 0, 0); } while (0)
#define PG8_LDA(dst, b, h) do { _Pragma("unroll") for (int m = 0; m < 4; ++m) _Pragma("unroll") for (int k = 0; k < 2; ++k) dst[m][k] = *(const PG8_LAS bf16x8*)(lds + PG8_SA(b, h) + aoff + m * 2048 + k * 1024); } while (0)
#define PG8_LDB(dst, b, h) do { _Pragma("unroll") for (int n = 0; n < 2; ++n) _Pragma("unroll") for (int k = 0; k < 2; ++k) dst[n][k] = *(const PG8_LAS bf16x8*)(lds + PG8_SB(b, h) + boff + n * 2048 + k * 1024); } while (0)
#define PG8_MMA(ai, bj, At, Bt) do { __builtin_amdgcn_s_setprio(1); _Pragma("unroll") for (int m = 0; m < 4; ++m) _Pragma("unroll") for (int n = 0; n < 2; ++n) _Pragma("unroll") for (int k = 0; k < 2; ++k) \
        acc[ai][bj][m][n] = __builtin_amdgcn_mfma_f32_16x16x32_bf16(Bt[n][k], At[m][k], acc[ai][bj][m][n], 0, 0, 0); __builtin_amdgcn_s_setprio(0); } while (0)
#define PG8_WAIT_V(n) asm volatile("s_waitcnt vmcnt(" #n ")" ::: "memory")
#define PG8_WAIT_L(n) asm volatile("s_waitcnt lgkmcnt(" #n ")" ::: "memory")
#define PG8_BAR __builtin_amdgcn_s_barrier()
#define PG8_SCHED __builtin_amdgcn_sched_barrier(0)
    Unit cur, nxt; int ui = 0;
    if (!S.next(0, cur)) return;
    f32x4 acc[2][2][4][2];
#pragma unroll
    for (int a = 0; a < 2; ++a)
#pragma unroll
        for (int b = 0; b < 2; ++b)
#pragma unroll
            for (int m = 0; m < 4; ++m)
#pragma unroll
                for (int n = 0; n < 2; ++n) acc[a][b][m][n] = (f32x4){0.f, 0.f, 0.f, 0.f};
    bf16x8 At[4][2], B0[2][2], B1[2][2];
    const char* cA = (const char*)g.A + (size_t)cur.pm * tstep; const char* cB = (const char*)g.Bt + (size_t)cur.pn * tstep;
    S.a_ready(cur);
    if constexpr (SP2) {
        PG8_STAGE(PG8_SB(0, 0), cB, voffB); PG8_STAGE(PG8_SB(0, 1), cB + hstep, voffB); PG8_STAGE(PG8_SA(0, 0), cA, voffA); PG8_STAGE(PG8_SA(0, 1), cA + hstep, voffA);
        if (wr == 1) PG8_BAR;
        PG8_WAIT_V(2); PG8_BAR;
        PG8_STAGE(PG8_SB(1, 0), cB + kstep, voffB); PG8_STAGE(PG8_SA(1, 0), cA + kstep, voffA); PG8_STAGE(PG8_SB(1, 1), cB + hstep + kstep, voffB);
        PG8_WAIT_V(6); PG8_BAR;
    } else {
        PG8_STAGE(PG8_SB(0, 0), cB, voffB); PG8_STAGE(PG8_SA(0, 0), cA, voffA); PG8_STAGE(PG8_SB(0, 1), cB + hstep, voffB); PG8_STAGE(PG8_SA(0, 1), cA + hstep, voffA);
        if (wr == 1) PG8_BAR;
        PG8_WAIT_V(4); PG8_BAR;
        PG8_STAGE(PG8_SB(1, 0), cB + kstep, voffB); PG8_STAGE(PG8_SA(1, 0), cA + kstep, voffA); PG8_STAGE(PG8_SB(1, 1), cB + hstep + kstep, voffB);
        PG8_WAIT_V(6); PG8_BAR;
    }
    for (;;) {
        const bool has_next = S.next(ui + 1, nxt);
        const char* nA = has_next ? (const char*)g.A + (size_t)nxt.pm * tstep : cA; const char* nB = has_next ? (const char*)g.Bt + (size_t)nxt.pn * tstep : cB;
        for (int t = 0; t < nt; t += 2) {
            const bool last = (t == nt - 2);
            const char* a1 = cA + (size_t)(t + 1) * kstep;
            const char* a2 = last ? nA : cA + (size_t)(t + 2) * kstep; const char* b2 = last ? nB : cB + (size_t)(t + 2) * kstep;
            const char* a3 = a2 + kstep; const char* b3 = b2 + kstep;
            if (last && has_next) S.a_ready(nxt);
            if constexpr (SP2) {
            PG8_LDB(B0, 0, 0); PG8_LDB(B1, 0, 1); PG8_SCHED; PG8_LDA(At, 0, 0); PG8_STAGE(PG8_SA(1, 1), a1 + hstep, voffA);
            PG8_WAIT_V(8); PG8_WAIT_L(0); PG8_BAR; PG8_MMA(0, 0, At, B0); PG8_MMA(0, 1, At, B1); PG8_BAR; PG8_SCHED;
            PG8_LDA(At, 0, 1); PG8_STAGE(PG8_SB(0, 0), b2, voffB); PG8_STAGE(PG8_SB(0, 1), b2 + hstep, voffB); PG8_STAGE(PG8_SA(0, 0), a2, voffA);
            PG8_WAIT_V(8); PG8_WAIT_L(0); PG8_BAR; PG8_MMA(1, 0, At, B0); PG8_MMA(1, 1, At, B1); PG8_BAR; PG8_SCHED;
            PG8_LDB(B0, 1, 0); PG8_LDB(B1, 1, 1); PG8_SCHED; PG8_LDA(At, 1, 0); PG8_STAGE(PG8_SA(0, 1), a2 + hstep, voffA);
            PG8_WAIT_V(8); PG8_WAIT_L(0); PG8_BAR; PG8_MMA(0, 0, At, B0); PG8_MMA(0, 1, At, B1); PG8_BAR; PG8_SCHED;
            PG8_LDA(At, 1, 1); PG8_STAGE(PG8_SB(1, 0), b3, voffB); PG8_STAGE(PG8_SB(1, 1), b3 + hstep, voffB); PG8_STAGE(PG8_SA(1, 0), a3, voffA);
            PG8_WAIT_V(8); PG8_WAIT_L(0); PG8_BAR; PG8_MMA(1, 0, At, B0); PG8_MMA(1, 1, At, B1); PG8_BAR; PG8_SCHED;
            } else {
            PG8_LDB(B0, 0, 0); PG8_SCHED; PG8_LDA(At, 0, 0); PG8_STAGE(PG8_SA(1, 1), a1 + hstep, voffA);
            PG8_WAIT_L(8); PG8_BAR; PG8_WAIT_L(0); PG8_MMA(0, 0, At, B0); PG8_BAR; PG8_SCHED;
            PG8_LDB(B1, 0, 1); PG8_STAGE(PG8_SB(0, 0), b2, voffB);
            PG8_BAR; PG8_WAIT_L(0); PG8_MMA(0, 1, At, B1); PG8_BAR;
            PG8_LDA(At, 0, 1); PG8_STAGE(PG8_SA(0, 0), a2, voffA);
            PG8_BAR; PG8_WAIT_L(0); PG8_MMA(1, 0, At, B0); PG8_BAR; PG8_SCHED;
            PG8_STAGE(PG8_SB(0, 1), b2 + hstep, voffB);
            PG8_WAIT_V(6); PG8_BAR; PG8_MMA(1, 1, At, B1); PG8_BAR;
            PG8_LDB(B0, 1, 0); PG8_SCHED; PG8_LDA(At, 1, 0); PG8_STAGE(PG8_SA(0, 1), a2 + hstep, voffA);
            PG8_WAIT_L(8); PG8_BAR; PG8_WAIT_L(0); PG8_MMA(0, 0, At, B0); PG8_BAR; PG8_SCHED;
            PG8_LDB(B1, 1, 1); PG8_STAGE(PG8_SB(1, 0), b3, voffB);
            PG8_BAR; PG8_WAIT_L(0); PG8_MMA(0, 1, At, B1); PG8_BAR;
            PG8_LDA(At, 1, 1); PG8_STAGE(PG8_SA(1, 0), a3, voffA);
            PG8_BAR; PG8_WAIT_L(0); PG8_MMA(1, 0, At, B0); PG8_BAR; PG8_SCHED;
            PG8_STAGE(PG8_SB(1, 1), b3 + hstep, voffB);
            PG8_WAIT_V(6); PG8_BAR; PG8_MMA(1, 1, At, B1); PG8_BAR;
            }
        }
        if constexpr (ALIGN_EPI) { if (wr == 0) PG8_BAR; }
        if constexpr (!Epi::AFTER_DRAIN) { E(acc, cur, wr, wc, fr, fq); S.done(cur); }
        if (!has_next) break;
#pragma unroll
        for (int a = 0; a < 2; ++a)
#pragma unroll
            for (int b = 0; b < 2; ++b)
#pragma unroll
                for (int m = 0; m < 4; ++m)
#pragma unroll
                    for (int n = 0; n < 2; ++n) acc[a][b][m][n] = (f32x4){0.f, 0.f, 0.f, 0.f};
        cur = nxt; cA = nA; cB = nB; ++ui;
        if constexpr (ALIGN_EPI) { if (wr == 1) PG8_BAR; }
    }
    PG8_WAIT_V(0);
    if constexpr (!ALIGN_EPI) { if (wr == 0) PG8_BAR; }
    PG8_BAR;
    if constexpr (Epi::AFTER_DRAIN) { E.fused(acc, cur, wr, wc, fr, fq, lds, wid, lane); S.done(cur); }
#undef PG8_SA
#undef PG8_SB
#undef PG8_STAGE
#undef PG8_LDA
#undef PG8_LDB
#undef PG8_MMA
#undef PG8_WAIT_V
#undef PG8_WAIT_L
#undef PG8_BAR
#undef PG8_SCHED
}
}
namespace att {
using bf16x8 = __attribute__((ext_vector_type(8))) short;
using s16x4 = __attribute__((ext_vector_type(4))) short;
using f32x16 = __attribute__((ext_vector_type(16))) float;
using f32x4 = __attribute__((ext_vector_type(4))) float;
using u32x4 = __attribute__((ext_vector_type(4))) unsigned;
typedef unsigned short bf16_t;
#define ALAS __attribute__((address_space(3)))
constexpr int SEQ = 4096, KSLOT = 16384, VSLOT = 8192, NSLOT = 3;
constexpr int L_K = 0, L_V = NSLOT * KSLOT, L_WS = L_V + NSLOT * VSLOT, L_FLAG = L_WS + 8 * 64 * 4, L_OST = L_FLAG + 256, L_END = L_OST + 8 * 8192;
constexpr float kEps = 1e-6f;
constexpr float SB_DONE = 151.0f;
__device__ __forceinline__ int crow(int r, int hi) { return (r & 3) + 8 * (r >> 2) + 4 * hi; }
__device__ __forceinline__ void glds16(const void* gsrc, unsigned lds_dst) { unsigned keep;
    asm volatile("s_mov_b32 %0, m0\n\ts_mov_b32 m0, %2\n\ts_nop 0\n\tglobal_load_lds_dwordx4 %1, off\n\ts_mov_b32 m0, %0" : "=&s"(keep) : "v"(gsrc), "s"(lds_dst) : "memory"); }
typedef float f32x2_t __attribute__((ext_vector_type(2))); typedef __bf16 bf16x2_t __attribute__((ext_vector_type(2)));
__device__ __forceinline__ unsigned cvtpk(float lo, float hi) { f32x2_t v = {lo, hi}; bf16x2_t b = __builtin_convertvector(v, bf16x2_t); return __builtin_bit_cast(unsigned, b); }
#define A_WAIT_BAR(N) asm volatile("s_waitcnt vmcnt(" #N ") lgkmcnt(0)\n\ts_barrier" ::: "memory")

template <int ND0> __device__ __forceinline__ void qkt(f32x16& p0, f32x16& p1, const ALAS char* Kslot, const bf16x8* qr, int r32, int hi) {
    const ALAS char* kb = Kslot + hi * 1024 + r32 * 16;
    p0 = f32x16{}; p1 = f32x16{};
#pragma unroll
    for (int d0 = 0; d0 < ND0; ++d0) {
        const bf16x8 b0 = *(const ALAS bf16x8*)(kb + d0 * 2048);
        const bf16x8 b1 = *(const ALAS bf16x8*)(kb + d0 * 2048 + 512);
        p0 = __builtin_amdgcn_mfma_f32_32x32x16_bf16(b0, qr[d0], p0, 0, 0, 0);
        p1 = __builtin_amdgcn_mfma_f32_32x32x16_bf16(b1, qr[d0], p1, 0, 0, 0);
    }
}
__device__ __forceinline__ void pv(f32x16* o, int vb, bf16x8 pa0, bf16x8 pa1, bf16x8 pa2, bf16x8 pa3) {
#pragma unroll
    for (int d0 = 0; d0 < 2; ++d0) { s16x4 lo[4], hi[4];
#pragma unroll
        for (int ks = 0; ks < 4; ++ks) {
            asm volatile("ds_read_b64_tr_b16 %0,%1 offset:%c2" : "=&v"(lo[ks]) : "v"(vb), "i"(d0 * 4096 + ks * 1024) : "memory");
            asm volatile("ds_read_b64_tr_b16 %0,%1 offset:%c2" : "=&v"(hi[ks]) : "v"(vb), "i"(d0 * 4096 + ks * 1024 + 512) : "memory"); }
        asm volatile("s_waitcnt lgkmcnt(0)" ::: "memory"); __builtin_amdgcn_sched_barrier(0);
#define A_PK(k) (bf16x8){lo[k][0], lo[k][1], lo[k][2], lo[k][3], hi[k][0], hi[k][1], hi[k][2], hi[k][3]}
        o[d0] = __builtin_amdgcn_mfma_f32_32x32x16_bf16(pa0, A_PK(0), o[d0], 0, 0, 0);
        o[d0] = __builtin_amdgcn_mfma_f32_32x32x16_bf16(pa1, A_PK(1), o[d0], 0, 0, 0);
        o[d0] = __builtin_amdgcn_mfma_f32_32x32x16_bf16(pa2, A_PK(2), o[d0], 0, 0, 0);
        o[d0] = __builtin_amdgcn_mfma_f32_32x32x16_bf16(pa3, A_PK(3), o[d0], 0, 0, 0);
#undef A_PK
    }
}
__device__ __forceinline__ float xhalf_sum(float v) { auto rr = __builtin_amdgcn_permlane32_swap(__float_as_uint(v), __float_as_uint(v), false, false); return __uint_as_float(rr[0]) + __uint_as_float(rr[1]); }
__device__ __forceinline__ float xhalf_max(float v) { auto rr = __builtin_amdgcn_permlane32_swap(__float_as_uint(v), __float_as_uint(v), false, false); return fmaxf(__uint_as_float(rr[0]), __uint_as_float(rr[1])); }

template <bool SBK> __device__ __forceinline__ void attn_unit(int b, int h, int qb, const bf16_t* Q, const bf16_t* K, const bf16_t* V, const bf16_t* gate, const float* gnorm, bf16_t* out, int goff, ALAS char* shm) {
    constexpr int DQK = SBK ? 64 : 96, QP = SBK ? 512 : 768, ND0 = DQK / 16;
    const int tid = threadIdx.x, lane = tid & 63, r32 = lane & 31, hi = lane >> 5; const int wid = __builtin_amdgcn_readfirstlane(tid >> 6);
    const long rowbase = (long)b * SEQ; const int q0 = qb * 256;
    const bf16_t* Qw = Q + (rowbase + q0 + wid * 32) * QP + h * DQK;
    const bf16_t* Kh = K + rowbase * QP + h * DQK; const bf16_t* Vh = V + rowbase * 512 + h * 64;
    const unsigned lds0 = (unsigned)(uintptr_t)shm;
    ALAS float* wsf = (ALAS float*)(shm + L_WS) + wid * 64;
    ALAS unsigned* flags = (ALAS unsigned*)(shm + L_FLAG);
    const bf16_t* ksrc = Kh + (long)lane * QP + wid * 8;
    const bf16_t* ksrc2 = Kh + (long)lane * QP + (8 + (wid & 3)) * 8;
    const bf16_t* vsrc = Vh + (long)(16 * (wid & 3) + (lane >> 2)) * 512 + (wid >> 2) * 32 + (lane & 3) * 8;
    const unsigned kdst = lds0 + L_K + wid * 1024, vdst = lds0 + L_V + wid * 1024;
    const int NT = 4 * qb + 4;
    const int tw = 4 * qb + (wid >> 1);
#define A_TILE(i) (SBK ? (NT - 1 - (i)) : (i))
#define A_DMA(i, s) do { const int t_ = A_TILE(i); glds16(ksrc + (long)t_ * 64 * QP, (unsigned)__builtin_amdgcn_readfirstlane(kdst + (s) * KSLOT)); \
        if (!SBK) glds16(ksrc2 + (long)t_ * 64 * QP, (unsigned)__builtin_amdgcn_readfirstlane(kdst + 8192 + (s) * KSLOT)); \
        glds16(vsrc + (long)t_ * 64 * 512, (unsigned)__builtin_amdgcn_readfirstlane(vdst + (s) * VSLOT)); } while (0)
    A_DMA(0, 0); A_DMA(1, 1);
    bf16x8 qr[ND0];
#pragma unroll
    for (int d0 = 0; d0 < ND0; ++d0) qr[d0] = *(const bf16x8*)(Qw + (long)r32 * QP + d0 * 16 + hi * 8);
    f32x16 o[2]; o[0] = f32x16{}; o[1] = f32x16{};
    float m_run = -INFINITY, l_run = 0.f, carry = 0.f;
    const int vb0 = (int)(lds0 + L_V) + ((lane >> 4) & 1) * 32 + (lane & 3) * 8 + (4 * hi + ((lane & 15) >> 2)) * 64;
    int slot = 0;
    for (int i = 0; i < NT; ++i) {
        if (i + 1 < NT) { if (SBK) { A_WAIT_BAR(2); } else { A_WAIT_BAR(3); } } else { A_WAIT_BAR(0); }
        if (SBK && i > 0) {
            const ALAS unsigned* fl = flags + ((i - 1) & 1) * 8; unsigned all = 1u;
#pragma unroll
            for (int w = 0; w < 8; ++w) all &= fl[w];
            if (all) break;
        }
        if (i + 2 < NT) { const int s2 = (slot >= 1) ? slot - 1 : slot + 2; A_DMA(i + 2, s2); }
        const int t = A_TILE(i);
        if (t <= tw) {
            f32x16 p0, p1;
            qkt<ND0>(p0, p1, shm + L_K + slot * KSLOT, qr, r32, hi);
            if (SBK) {
                if (t == tw) { const int qrel = 32 * (wid & 1) + r32;
#pragma unroll
                    for (int r = 0; r < 16; ++r) { const int kv = crow(r, hi); if (kv >= qrel) p0[r] = -INFINITY; if (kv + 32 >= qrel) p1[r] = -INFINITY; } }
                f32x16 s0, s1;
#pragma unroll
                for (int r = 0; r < 16; ++r) {
                    s0[r] = fmaxf(p0[r], 0.f) + __builtin_amdgcn_logf(1.0f + __builtin_amdgcn_exp2f(-fabsf(p0[r])));
                    s1[r] = fmaxf(p1[r], 0.f) + __builtin_amdgcn_logf(1.0f + __builtin_amdgcn_exp2f(-fabsf(p1[r])));
                }
                float lo_[8], up_[8];
#pragma unroll
                for (int i4 = 0; i4 < 8; ++i4) {
                    const float bs = (i4 < 4) ? ((s0[4 * i4] + s0[4 * i4 + 1]) + (s0[4 * i4 + 2] + s0[4 * i4 + 3])) : ((s1[4 * i4 - 16] + s1[4 * i4 - 15]) + (s1[4 * i4 - 14] + s1[4 * i4 - 13]));
                    auto rr = __builtin_amdgcn_permlane32_swap(__float_as_uint(bs), __float_as_uint(bs), false, false);
                    lo_[i4] = __uint_as_float(rr[0]); up_[i4] = __uint_as_float(rr[1]);
                }
                float run = carry;
#pragma unroll
                for (int i4 = 7; i4 >= 0; --i4) {
                    float c = run + (hi == 0 ? up_[i4] : 0.f);
#pragma unroll
                    for (int e = 3; e >= 0; --e) {
                        if (i4 < 4) { c += s0[4 * i4 + e]; p0[4 * i4 + e] = __builtin_amdgcn_exp2f(p0[4 * i4 + e] - c); }
                        else { c += s1[4 * i4 - 16 + e]; p1[4 * i4 - 16 + e] = __builtin_amdgcn_exp2f(p1[4 * i4 - 16 + e] - c); }
                    }
                    run += lo_[i4] + up_[i4];
                }
                carry = run;
            } else {
                float rm = fmaxf(p0[0], p1[0]);
#pragma unroll
                for (int r = 1; r < 16; ++r) rm = fmaxf(rm, fmaxf(p0[r], p1[r]));
                rm = xhalf_max(rm);
                const float m_new = fmaxf(m_run, rm);
                const float alpha = __builtin_amdgcn_exp2f(m_run - m_new);
                float ls = 0.f;
#pragma unroll
                for (int r = 0; r < 16; ++r) { p0[r] = __builtin_amdgcn_exp2f(p0[r] - m_new); p1[r] = __builtin_amdgcn_exp2f(p1[r] - m_new); ls += p0[r] + p1[r]; }
                l_run = l_run * alpha + ls; m_run = m_new;
                if (!__all(alpha == 1.0f)) {
                    if (hi == 0) wsf[r32] = alpha;
#pragma unroll
                    for (int r = 0; r < 16; ++r) { const float f = wsf[crow(r, hi)]; o[0][r] *= f; o[1][r] *= f; }
                }
            }
            u32x4 pw0, pw1, pw2, pw3;
            pw0 = (u32x4){cvtpk(p0[0], p0[1]), cvtpk(p0[2], p0[3]), cvtpk(p0[4], p0[5]), cvtpk(p0[6], p0[7])};
            pw1 = (u32x4){cvtpk(p0[8], p0[9]), cvtpk(p0[10], p0[11]), cvtpk(p0[12], p0[13]), cvtpk(p0[14], p0[15])};
            pw2 = (u32x4){cvtpk(p1[0], p1[1]), cvtpk(p1[2], p1[3]), cvtpk(p1[4], p1[5]), cvtpk(p1[6], p1[7])};
            pw3 = (u32x4){cvtpk(p1[8], p1[9]), cvtpk(p1[10], p1[11]), cvtpk(p1[12], p1[13]), cvtpk(p1[14], p1[15])};
            pv(o, vb0 + slot * VSLOT, __builtin_bit_cast(bf16x8, pw0), __builtin_bit_cast(bf16x8, pw1), __builtin_bit_cast(bf16x8, pw2), __builtin_bit_cast(bf16x8, pw3));
        }
        if (SBK) { const bool done = (t <= tw) && __all(carry > SB_DONE); if (lane == 0) flags[(i & 1) * 8 + wid] = done ? 1u : 0u; }
        slot = (slot == NSLOT - 1) ? 0 : slot + 1;
    }
    A_WAIT_BAR(0);
    float rli[16];
    if (!SBK) {
        const float lt = xhalf_sum(l_run);
        if (hi == 0) wsf[32 + r32] = lt;
#pragma unroll
        for (int r = 0; r < 16; ++r) rli[r] = __builtin_amdgcn_rcpf(wsf[32 + crow(r, hi)]);
    } else {
#pragma unroll
        for (int r = 0; r < 16; ++r) rli[r] = 1.0f;
    }
    ALAS float* stg = (ALAS float*)(shm + L_OST) + wid * 2048;
#pragma unroll
    for (int r = 0; r < 16; ++r) { const int orow = crow(r, hi);
#pragma unroll
        for (int d0 = 0; d0 < 2; ++d0) stg[orow * 64 + d0 * 32 + r32] = o[d0][r] * rli[r]; }
    const long grow0 = rowbase + q0 + wid * 32;
#pragma unroll
    for (int i = 0; i < 4; ++i) {
        const int row = i * 8 + (lane >> 3), ch = lane & 7;
        const f32x4 a = *(const ALAS f32x4*)(stg + row * 64 + ch * 8), c = *(const ALAS f32x4*)(stg + row * 64 + ch * 8 + 4);
        float ss = ((a[0] * a[0] + a[1] * a[1]) + (a[2] * a[2] + a[3] * a[3])) + ((c[0] * c[0] + c[1] * c[1]) + (c[2] * c[2] + c[3] * c[3]));
        ss += __shfl_xor(ss, 1); ss += __shfl_xor(ss, 2); ss += __shfl_xor(ss, 4);
        const float rn = 1.0f / sqrtf(ss * (1.0f / 64.0f) + kEps);
        const size_t off = (size_t)(grow0 + row) * 1024 + goff + h * 64 + ch * 8;
        const u32x4 gv = *(const u32x4*)(gate + off);
        const f32x4 g0 = *(const f32x4*)(gnorm + h * 64 + ch * 8), g1 = *(const f32x4*)(gnorm + h * 64 + ch * 8 + 4);
        float v[8];
#pragma unroll
        for (int e = 0; e < 4; ++e) { v[e] = a[e] * rn * g0[e]; v[4 + e] = c[e] * rn * g1[e]; }
        u32x4 w;
#pragma unroll
        for (int e = 0; e < 4; ++e) { const unsigned gw = gv[e]; w[e] = cvtpk(v[2 * e] * __uint_as_float(gw << 16), v[2 * e + 1] * __uint_as_float(gw & 0xffff0000u)); }
        *(u32x4*)(out + off) = w;
    }
    A_WAIT_BAR(0);
#undef A_TILE
#undef A_DMA
}
}
#include <hip/hip_cooperative_groups.h>
namespace cg = cooperative_groups;
#ifndef MK_N_LAUNCHES
#define MK_N_LAUNCHES 1
#endif
#ifndef REP_MLA
#define REP_MLA 1
#endif
#ifndef REP_SB
#define REP_SB 1
#endif
#ifndef REP_P1
#define REP_P1 1
#endif
#ifndef REP_MISC
#define REP_MISC 1
#endif
#ifndef REP_SYNC
#define REP_SYNC 0
#endif
#ifndef REP_TAIL
#define REP_TAIL 1
#endif
constexpr int NWAVES = 8;
constexpr int N_PHASES = 7;
constexpr int M = 32768, D = 1024, SEQ = 4096, NIN = 2976, NINP = 3072, PLE = 256;
constexpr size_t MiB = 1u << 20;
constexpr size_t WS_A = 0;
constexpr size_t WS_B = 64 * MiB;
constexpr size_t WS_PLE = 128 * MiB;
constexpr size_t WS_SBQ = 192 * MiB, WS_SBK = 224 * MiB, WS_SBV = 256 * MiB;
constexpr size_t WS_MQ = 288 * MiB, WS_MK = 336 * MiB, WS_MV = 384 * MiB;
constexpr size_t WS_PB = 416 * MiB, WS_CQ = 432 * MiB, WS_CKV = 448 * MiB;
constexpr size_t WS_WIN = 464 * MiB;
constexpr size_t WS_WUQ = 470 * MiB;
constexpr size_t WS_WUKV = 471 * MiB;
constexpr size_t WS_WOUT = 472 * MiB;
constexpr size_t WS_WPLE = 474 * MiB;
constexpr size_t WS_WPG = 475 * MiB;
constexpr size_t WS_CS = 477 * MiB;
constexpr size_t WS_RPRE = 481 * MiB;
constexpr size_t WS_RQSS = 482 * MiB;
constexpr size_t WS_RKVSS = 483 * MiB;
constexpr size_t WS_YSS = 484 * MiB;
constexpr size_t WS_PSS = 486 * MiB;
constexpr size_t WS_RY = 488 * MiB, WS_RP = 489 * MiB;
constexpr size_t WS_CTL = 490 * MiB, CTL_ZERO_BYTES = 16384;
constexpr size_t WS_END = 491 * MiB;
constexpr int MISC_OFF = 147456 - 256;
constexpr int LDS_BYTES = 147456;
static_assert(WS_SBK - WS_SBQ == 32 * MiB && WS_SBV - WS_SBK == 32 * MiB, "EpiProj addresses SBK/SBV relative to SBQ");
static_assert(att::L_END <= MISC_OFF && pg8::STAGE_BYTES <= MISC_OFF, "control words");
static_assert(att::L_END <= LDS_BYTES && pg8::STAGE_BYTES <= LDS_BYTES, "LDS map");

typedef unsigned short bf16;
typedef unsigned v4u __attribute__((ext_vector_type(4)));
typedef unsigned v2u __attribute__((ext_vector_type(2)));
typedef float f32x4 __attribute__((ext_vector_type(4)));
#define LAS __attribute__((address_space(3)))
__device__ __forceinline__ unsigned f2bf(float f) { unsigned u = __builtin_bit_cast(unsigned, f); return (u + 0x7fffu + ((u >> 16) & 1u)) >> 16; }
__device__ __forceinline__ unsigned pk2(float lo, float hi) { return f2bf(lo) | (f2bf(hi) << 16); }
__device__ __forceinline__ float wave_sum(float v) {
#pragma unroll
    for (int o = 1; o < 64; o <<= 1) v += __shfl_xor(v, o);
    return v;
}
__device__ __forceinline__ void transpose_item(const float* W, int K, int N, bf16* WT, int ldk, const float* gain, LAS float* scr, int item, int lane) {
    const int nblk = N / 32, kb = item / nblk, nb = item % nblk, k0 = 64 * kb, n0 = 32 * nb;
#pragma unroll 8
    for (int i = 0; i < 32; ++i) { const int kk = 2 * i + (lane >> 5); const float gk = gain ? gain[k0 + kk] : 1.0f; scr[kk * 33 + (lane & 31)] = W[(size_t)(k0 + kk) * N + n0 + (lane & 31)] * gk; }
    asm volatile("s_waitcnt lgkmcnt(0)" ::: "memory");
    const int c = lane & 7;
#pragma unroll
    for (int j = 0; j < 4; ++j) { const int n = (lane >> 3) + 8 * j; const LAS float* s = scr + (8 * c) * 33 + n;
        v4u o; o.x = pk2(s[0 * 33], s[1 * 33]); o.y = pk2(s[2 * 33], s[3 * 33]); o.z = pk2(s[4 * 33], s[5 * 33]); o.w = pk2(s[6 * 33], s[7 * 33]);
        *(v4u*)(WT + (size_t)(n0 + n) * ldk + k0 + 8 * c) = o; }
    asm volatile("s_waitcnt lgkmcnt(0)" ::: "memory");
}

#define XB_TMO      128
#define XB_XCNT(j)  (256  + 64 * (j))
#define XB_XSUB(j)  (1280 + 64 * (j))
#define XB_XGEN(j)  (2304 + 64 * (j))
#define XB_TOP      3328
#define XB_TOPGEN   3392
#define XCD_BAR_WORDS 3456
#define XB_SPIN_CAP (1u << 18)

__device__ __forceinline__ unsigned xb_ld(unsigned* p)              { return __hip_atomic_load(p, __ATOMIC_RELAXED, __HIP_MEMORY_SCOPE_AGENT); }
__device__ __forceinline__ unsigned xb_add(unsigned* p, unsigned v) { return __hip_atomic_fetch_add(p, v, __ATOMIC_RELAXED, __HIP_MEMORY_SCOPE_AGENT); }
__device__ __forceinline__ unsigned xb_xcc_id() { return (unsigned)__builtin_amdgcn_s_getreg((3 << 11) | 20) & 0xFu; }
#define XB_SPIN(cond, bar) do { unsigned _sp = 0; while (cond) { __builtin_amdgcn_s_sleep(1); \
    if ((++_sp & 255u) == 0u) { if (xb_ld(&(bar)[XB_TMO])) break; if (_sp > XB_SPIN_CAP) { atomicAdd(&(bar)[XB_TMO], 1u); break; } } } } while (0)

struct XcdBarrier {
    unsigned* bar; unsigned x;
    volatile LAS unsigned* st;
};

__device__ __forceinline__ XcdBarrier xcd_barrier_post(unsigned* bar, volatile LAS unsigned* st) {
    XcdBarrier b; b.bar = bar; b.x = xb_xcc_id(); b.st = st;
    if (threadIdx.x == 0) (void)xb_add(&bar[XB_XCNT(b.x)], 1u);
    return b;
}
__device__ __forceinline__ void xcd_barrier_complete(unsigned* bar, unsigned x, unsigned& nloc, unsigned& nx) {
    const unsigned G = gridDim.x * gridDim.y * gridDim.z;
    unsigned sum, cnt, mine, sp = 0u;
    for (;;) {
        sum = 0u; cnt = 0u; mine = 0u;
#pragma unroll
        for (unsigned j = 0; j < 16; ++j) { const unsigned c = xb_ld(&bar[XB_XCNT(j)]); sum += c; cnt += (c > 0u) ? 1u : 0u; mine = (j == x) ? c : mine; }
        if (sum == G) break;
        __builtin_amdgcn_s_sleep(1);
        if ((++sp & 255u) == 0u) { if (xb_ld(&bar[XB_TMO])) break; if (sp > XB_SPIN_CAP) { atomicAdd(&bar[XB_TMO], 1u); break; } }
    }
    nloc = mine > 0u ? mine : 1u; nx = cnt > 0u ? cnt : 1u;
}

__device__ __forceinline__ void xcd_barrier(const XcdBarrier& b) {
    asm volatile("s_waitcnt vmcnt(0)" ::: "memory");
    __syncthreads();
    if (threadIdx.x == 0) {
        unsigned* bar = b.bar;
        __builtin_amdgcn_s_waitcnt(0);
        unsigned nloc = b.st[0], nx = b.st[1];
        if (nloc == 0u) { xcd_barrier_complete(bar, b.x, nloc, nx); b.st[0] = nloc; b.st[1] = nx; }
        const unsigned old = xb_add(&bar[XB_XSUB(b.x)], 1u);
        const unsigned gen = old / nloc;
        if (old + 1u == (gen + 1u) * nloc) {
            __builtin_amdgcn_fence(__ATOMIC_RELEASE, "agent");
            asm volatile("s_waitcnt vmcnt(0)" ::: "memory");
            const unsigned og = xb_add(&bar[XB_TOP], 1u);
            const unsigned tg = og / nx;
            if (og + 1u == (tg + 1u) * nx) xb_add(&bar[XB_TOPGEN], 1u);
            else XB_SPIN(xb_ld(&bar[XB_TOPGEN]) == tg, bar);
            __builtin_amdgcn_fence(__ATOMIC_ACQUIRE, "agent");
            xb_add(&bar[XB_XGEN(b.x)], 1u);
            asm volatile("s_waitcnt vmcnt(0)" ::: "memory");
        } else {
            XB_SPIN(xb_ld(&bar[XB_XGEN(b.x)]) == gen, bar);
            __builtin_amdgcn_fence(__ATOMIC_ACQUIRE, "agent");
            asm volatile("s_waitcnt vmcnt(0)" ::: "memory");
        }
    }
    __syncthreads();
}

static_assert(XCD_BAR_WORDS * 4 <= (int)CTL_ZERO_BYTES, "barrier words inside the memset");
__device__ __forceinline__ int opq(int v) { asm volatile("" : "+s"(v)); return v; }
struct Args { const float* in[17]; const int* pos; float* out; unsigned char* ws; int ph_lo, ph_hi; };

__global__ void __launch_bounds__(NWAVES * 64, 2) fwd_kernel(Args args) {
    extern __shared__ __attribute__((aligned(16))) unsigned char lds[];
    const int tid = threadIdx.x, lane = tid & 63, wave = __builtin_amdgcn_readfirstlane(tid >> 6);
    const int G = gridDim.x; const int bx = blockIdx.x; const int vcu = (G % 8 == 0) ? (bx % 8) * (G / 8) + bx / 8 : bx;
    unsigned char* ws = args.ws;
    const float* x = args.in[0]; const float* pin = args.in[1];
    const float* g_pre = args.in[3]; const float* w_in = args.in[4]; const float* g_q = args.in[5]; const float* w_uq = args.in[6]; const float* g_kv = args.in[7]; const float* w_ukv = args.in[8];
    const float* g_sb = args.in[9]; const float* g_mla = args.in[10]; const float* w_out = args.in[11]; const float* g_post = args.in[12]; const float* w_ple = args.in[13]; const float* g_ple = args.in[14];
    const float* w_pg = args.in[15]; const float* b_pg = args.in[16];
    bf16* XB = (bf16*)(ws + WS_A); bf16* MIX = (bf16*)(ws + WS_A); bf16* X1B = (bf16*)(ws + WS_A);
    bf16* GATE = (bf16*)(ws + WS_B); bf16* YB = (bf16*)(ws + WS_B); bf16* PLEB = (bf16*)(ws + WS_PLE);
    bf16* SBQ = (bf16*)(ws + WS_SBQ); bf16* SBK = (bf16*)(ws + WS_SBK); bf16* SBV = (bf16*)(ws + WS_SBV);
    bf16* MQ = (bf16*)(ws + WS_MQ); bf16* MK = (bf16*)(ws + WS_MK); bf16* MV = (bf16*)(ws + WS_MV);
    bf16* PB = (bf16*)(ws + WS_PB); bf16* CQ = (bf16*)(ws + WS_CQ); bf16* CKV = (bf16*)(ws + WS_CKV);
    bf16* WIN = (bf16*)(ws + WS_WIN); bf16* WUQ = (bf16*)(ws + WS_WUQ); bf16* WUKV = (bf16*)(ws + WS_WUKV); bf16* WOUT = (bf16*)(ws + WS_WOUT); bf16* WPLE = (bf16*)(ws + WS_WPLE); bf16* WPG = (bf16*)(ws + WS_WPG);
    float* CS = (float*)(ws + WS_CS); float* RPRE = (float*)(ws + WS_RPRE); float* RQSS = (float*)(ws + WS_RQSS); float* RKVSS = (float*)(ws + WS_RKVSS);
    float* YSS = (float*)(ws + WS_YSS); float* PSS = (float*)(ws + WS_PSS); float* RY = (float*)(ws + WS_RY); float* RP = (float*)(ws + WS_RP);
    const int lo = args.ph_lo, hi = args.ph_hi;
#define IN(k) (lo <= (k) && (k) < hi)
#define SEAM(k) do { if (IN(k) && IN((k) + 1)) { xcd_barrier(bar); } } while (0)
    if (lo < 0) cg::this_grid().sync();
    volatile LAS unsigned* MISC = (volatile LAS unsigned*)((LAS unsigned char*)lds + MISC_OFF);
    if (tid < 8) MISC[tid] = 0u;
    __syncthreads();
    XcdBarrier bar; bar.bar = (unsigned*)(ws + WS_CTL); bar.x = 0; bar.st = nullptr;
    if (hi - lo > 1) bar = xcd_barrier_post((unsigned*)(ws + WS_CTL), MISC);
    const int gw = vcu * NWAVES + wave, NGW = G * NWAVES;

    for (int rep0 = 0; rep0 < REP_MISC; ++rep0)
    if (IN(0)) {
        LAS float* scr = (LAS float*)((LAS unsigned char*)lds + wave * 16384);
        constexpr int I_IN = 16 * 93, I_UQ = 4 * 24, I_UKV = 2 * 32, I_OUT = 16 * 32, I_PLE = 4 * 32, I_PG = 16 * 32;
        constexpr int NITEMS = I_IN + I_UQ + I_UKV + I_OUT + I_PLE + I_PG;
        for (int it = gw; it < NITEMS; it += NGW) {
            int r = it;
            if (r < I_IN) { transpose_item(w_in, 1024, NIN, WIN, 1024, g_pre, scr, r, lane); continue; } r -= I_IN;
            if (r < I_UQ) { transpose_item(w_uq, 256, 768, WUQ, 256, g_q, scr, r, lane); continue; } r -= I_UQ;
            if (r < I_UKV) { transpose_item(w_ukv, 128, 1024, WUKV, 256, g_kv, scr, r, lane); continue; } r -= I_UKV;
            if (r < I_OUT) { transpose_item(w_out, 1024, 1024, WOUT, 1024, nullptr, scr, r, lane); continue; } r -= I_OUT;
            if (r < I_PLE) { transpose_item(w_ple, 256, 1024, WPLE, 256, nullptr, scr, r, lane); continue; } r -= I_PLE;
            transpose_item(w_pg, 1024, 1024, WPG, 1024, nullptr, scr, r, lane);
        }
        const int gt = vcu * (NWAVES * 64) + tid, NGT = G * NWAVES * 64;
        for (int i = gt; i < (NINP - NIN) * 1024 / 8; i += NGT) *(v4u*)(WIN + (size_t)NIN * 1024 + (size_t)i * 8) = (v4u){0u, 0u, 0u, 0u};
        for (int i = gt; i < 1024 * 128 / 8; i += NGT) { const int n = i / 16, c = i % 16; *(v4u*)(WUKV + (size_t)n * 256 + 128 + c * 8) = (v4u){0u, 0u, 0u, 0u}; }
        for (int i = gt; i < M * 16; i += NGT) {
            const int row = i >> 4, k = i & 15;
            const float freq = exp2f(-(float)k * 0.8304820237218407f);
            const float ang = (float)args.pos[row] * freq;
            double tt = (double)ang * 0.15915494309189535; tt -= __builtin_rint(tt);
            const float tf = (float)tt;
            CS[(size_t)i * 2] = __builtin_amdgcn_cosf(tf); CS[(size_t)i * 2 + 1] = __builtin_amdgcn_sinf(tf);
        }
        for (int m = gw; m < M; m += NGW) {
            const f32x4* xr = (const f32x4*)(x + (size_t)m * D) + lane; f32x4 v[4]; float s = 0.f;
#pragma unroll
            for (int j = 0; j < 4; ++j) { v[j] = xr[64 * j]; s += (v[j][0] * v[j][0] + v[j][1] * v[j][1]) + (v[j][2] * v[j][2] + v[j][3] * v[j][3]); }
            s = wave_sum(s);
            if (lane == 0) RPRE[m] = 1.0f / sqrtf(s * (1.0f / D) + 1e-6f);
            v2u* o8 = (v2u*)(XB + (size_t)m * D) + lane;
#pragma unroll
            for (int j = 0; j < 4; ++j) o8[64 * j] = (v2u){pk2(v[j][0], v[j][1]), pk2(v[j][2], v[j][3])};
        }
        for (int i = gt; i < M * PLE / 4; i += NGT) { const f32x4 v = *((const f32x4*)pin + i); *((v2u*)PB + i) = (v2u){pk2(v[0], v[1]), pk2(v[2], v[3])}; }
    }
    SEAM(0);

    if (IN(1)) {
        { pg8::Gemm g{XB, WIN, M, NINP, 1024}; pg8::StaticOrder S; S.init(M, NINP, G, bx);
          pg8::EpiProj E{SBQ, SBK, SBV, GATE, CQ, CKV, MK, RQSS, RKVSS, RPRE, CS};
          pg8::gemm_phase<pg8::EpiProj, pg8::StaticOrder, true, true>((PG8_LAS unsigned char*)lds, g, S, E); }
#if REP_P1 > 1
        { pg8::Gemm g{XB, WIN, M, NINP, 1024}; pg8::StaticOrder S; S.init(M, NINP, G, bx);
          pg8::EpiProj E{SBQ, SBK, SBV, GATE, CQ, CKV, MK, RQSS, RKVSS, RPRE, CS};
          pg8::gemm_phase<pg8::EpiProj, pg8::StaticOrder, true, true>((PG8_LAS unsigned char*)lds, g, S, E); }
#endif
        { pg8::Gemm g{PB, WPLE, M, 1024, opq(256)}; pg8::StaticOrder S; S.init(M, 1024, G, bx);
          pg8::EpiStat E{PLEB, PSS};
          pg8::gemm_phase<pg8::EpiStat, pg8::StaticOrder, true, true>((PG8_LAS unsigned char*)lds, g, S, E); }
#if REP_MISC > 1
        { pg8::Gemm g{PB, WPLE, M, 1024, opq(256)}; pg8::StaticOrder S; S.init(M, 1024, G, bx);
          pg8::EpiStat E{PLEB, PSS};
          pg8::gemm_phase<pg8::EpiStat, pg8::StaticOrder, true, true>((PG8_LAS unsigned char*)lds, g, S, E); }
#endif
    }
    SEAM(1);

    if (IN(2)) {
        { pg8::Gemm g{CQ, WUQ, M, 768, opq(256)}; pg8::StaticOrder S; S.init(M, 768, G, bx);
          pg8::EpiQ E{MQ, RQSS, CS};
          pg8::gemm_phase<pg8::EpiQ, pg8::StaticOrder, true, true>((PG8_LAS unsigned char*)lds, g, S, E); }
        { pg8::Gemm g{CKV, WUKV, M, 1024, opq(256)}; pg8::StaticOrder S; S.init(M, 1024, G, bx);
          pg8::EpiKV E{MK, MV, RKVSS};
          pg8::gemm_phase<pg8::EpiKV, pg8::StaticOrder, true, true>((PG8_LAS unsigned char*)lds, g, S, E); }
#if REP_MISC > 1
        { pg8::Gemm g{CQ, WUQ, M, 768, opq(256)}; pg8::StaticOrder S; S.init(M, 768, G, bx);
          pg8::EpiQ E{MQ, RQSS, CS};
          pg8::gemm_phase<pg8::EpiQ, pg8::StaticOrder, true, true>((PG8_LAS unsigned char*)lds, g, S, E); }
        { pg8::Gemm g{CKV, WUKV, M, 1024, opq(256)}; pg8::StaticOrder S; S.init(M, 1024, G, bx);
          pg8::EpiKV E{MK, MV, RKVSS};
          pg8::gemm_phase<pg8::EpiKV, pg8::StaticOrder, true, true>((PG8_LAS unsigned char*)lds, g, S, E); }
#endif
    }
    SEAM(2);

    if (IN(3)) {
        __attribute__((address_space(3))) char* shm = (__attribute__((address_space(3))) char*)lds;
        for (int rep = 0; rep < REP_MLA; ++rep)
        for (int idx = vcu; idx < 1024; idx += G) {
            const int j = idx >> 8, v = idx & 255, bh = v >> 2, s = v & 3;
            const int qb = (j == 0) ? 15 - s : (j == 1) ? s : (j == 2) ? 8 + s : 7 - s;
            att::attn_unit<false>(bh >> 3, bh & 7, qb, MQ, MK, MV, GATE, g_mla, MIX, 512, shm);
        }
        for (int rep = 0; rep < REP_SB; ++rep)
        for (int idx = vcu; idx < 1024; idx += G) {
            const int bh = idx >> 4, qb = idx & 15;
            att::attn_unit<true>(bh >> 3, bh & 7, qb, SBQ, SBK, SBV, GATE, g_sb, MIX, 0, shm);
        }
    }
    SEAM(3);
    for (int rs_ = 0; rs_ < REP_SYNC; ++rs_) xcd_barrier(bar);

    if (IN(4)) {
        {
        pg8::Gemm g{MIX, WOUT, M, 1024, 1024}; pg8::StaticOrder S; S.init(M, 1024, G, bx);
        pg8::EpiStat E{YB, YSS};
        pg8::gemm_phase<pg8::EpiStat, pg8::StaticOrder, true, true>((PG8_LAS unsigned char*)lds, g, S, E);
        }
#if REP_TAIL > 1
        {
        pg8::Gemm g{MIX, WOUT, M, 1024, 1024}; pg8::StaticOrder S; S.init(M, 1024, G, bx);
        pg8::EpiStat E{YB, YSS};
        pg8::gemm_phase<pg8::EpiStat, pg8::StaticOrder, true, true>((PG8_LAS unsigned char*)lds, g, S, E);
        }
#endif
    }
    SEAM(4);

    if (IN(5)) {
        for (int rep = 0; rep < REP_TAIL; ++rep)
        for (int m = gw; m < M; m += NGW) {
            float sv = (lane < 16) ? YSS[(size_t)m * 16 + lane] : ((lane < 32) ? PSS[(size_t)m * 16 + lane - 16] : 0.f);
            sv += __shfl_xor(sv, 1); sv += __shfl_xor(sv, 2); sv += __shfl_xor(sv, 4); sv += __shfl_xor(sv, 8);
            const float sy = __shfl(sv, 0), sp = __shfl(sv, 16);
            const float ry = 1.0f / sqrtf(sy * (1.0f / 1024.0f) + 1e-6f), rp = 1.0f / sqrtf(sp * (1.0f / 1024.0f) + 1e-6f);
            if (lane == 0) { RY[m] = ry; RP[m] = rp; }
            const f32x4* xr = (const f32x4*)(x + (size_t)m * D) + lane; const v2u* yr = (const v2u*)(YB + (size_t)m * D) + lane; const f32x4* gr = (const f32x4*)g_post + lane;
            v2u* o8 = (v2u*)(X1B + (size_t)m * D) + lane;
#pragma unroll
            for (int j = 0; j < 4; ++j) { const f32x4 xv = xr[64 * j], gv = gr[64 * j]; const v2u yw = yr[64 * j];
                const float y0 = __uint_as_float(yw.x << 16), y1 = __uint_as_float(yw.x & 0xffff0000u), y2 = __uint_as_float(yw.y << 16), y3 = __uint_as_float(yw.y & 0xffff0000u);
                o8[64 * j] = (v2u){pk2(xv[0] + y0 * ry * gv[0], xv[1] + y1 * ry * gv[1]), pk2(xv[2] + y2 * ry * gv[2], xv[3] + y3 * ry * gv[3])}; }
        }
    }
    SEAM(5);

    if (IN(6)) {
        {
        pg8::Gemm g{X1B, WPG, M, 1024, 1024}; pg8::StaticOrder S; S.init(M, 1024, G, bx);
        pg8::EpiFinal E{x, YB, PLEB, RY, RP, g_post, g_ple, b_pg, args.out};
        pg8::gemm_phase<pg8::EpiFinal, pg8::StaticOrder, true, true>((PG8_LAS unsigned char*)lds, g, S, E);
        }
#if REP_TAIL > 1
        {
        pg8::Gemm g{X1B, WPG, M, 1024, 1024}; pg8::StaticOrder S; S.init(M, 1024, G, bx);
        pg8::EpiFinal E{x, YB, PLEB, RY, RP, g_post, g_ple, b_pg, args.out};
        pg8::gemm_phase<pg8::EpiFinal, pg8::StaticOrder, true, true>((PG8_LAS unsigned char*)lds, g, S, E);
        }
#endif
    }
#undef IN
#undef SEAM
}

extern "C" void kernel_launch(void* const* d_in, const int* in_sizes, int n_in, void* d_out, int out_size, void* d_ws, size_t ws_size, hipStream_t stream) {
    static int grid = 0;
    if (grid == 0) {
        if (n_in != 17 || out_size != M * D || ws_size < WS_END) { fprintf(stderr, "kernel_launch: unexpected shapes (n_in %d, out %d, ws %zu); nothing launched\n", n_in, out_size, ws_size); grid = -1; return; }
        int dev = 0, cus = 0, per_cu = 0;
        if (hipGetDevice(&dev) != hipSuccess || hipDeviceGetAttribute(&cus, hipDeviceAttributeMultiprocessorCount, dev) != hipSuccess) { grid = -1; return; }
        if (hipFuncSetAttribute((const void*)fwd_kernel, hipFuncAttributeMaxDynamicSharedMemorySize, LDS_BYTES) != hipSuccess) { fprintf(stderr, "kernel_launch: hipFuncSetAttribute failed\n"); grid = -1; return; }
        if (hipOccupancyMaxActiveBlocksPerMultiprocessor(&per_cu, (const void*)fwd_kernel, NWAVES * 64, LDS_BYTES) != hipSuccess || per_cu < 1) { fprintf(stderr, "kernel_launch: occupancy query says %d blocks per CU\n", per_cu); per_cu = 1; }
        (void)hipGetLastError();
        grid = cus * 1;
    }
    if (grid < 0) return;
    if (hipMemsetAsync((char*)d_ws + WS_CTL, 0, CTL_ZERO_BYTES, stream) != hipSuccess) { fprintf(stderr, "kernel_launch: hipMemsetAsync failed\n"); return; }
    Args a{};
    for (int i = 0; i < 17; ++i) a.in[i] = (const float*)d_in[i];
    a.pos = (const int*)d_in[2]; a.out = (float*)d_out; a.ws = (unsigned char*)d_ws;
#if MK_N_LAUNCHES == 1
    a.ph_lo = 0; a.ph_hi = N_PHASES;
    void* kargs[] = {&a};
    hipError_t e = hipLaunchCooperativeKernel((const void*)fwd_kernel, dim3(grid), dim3(NWAVES * 64), kargs, LDS_BYTES, stream);
    if (e != hipSuccess) fprintf(stderr, "kernel_launch: cooperative launch failed: %s (grid %d)\n", hipGetErrorString(e), grid);
#else
    for (int li = 0; li < N_PHASES; ++li) { a.ph_lo = li; a.ph_hi = li + 1; hipLaunchKernelGGL(fwd_kernel, dim3(grid), dim3(NWAVES * 64), LDS_BYTES, stream, a); }
#endif
}
```

```cpp
#include <hip/hip_runtime.h>
#include <cstdio>
#include <cstdint>
#include <cmath>
namespace pg8 {
#define PG8_LAS __attribute__((address_space(3)))
typedef unsigned short bf16_t;
typedef short bf16x8 __attribute__((ext_vector_type(8)));
typedef float f32x4 __attribute__((ext_vector_type(4)));
typedef unsigned u32x4 __attribute__((ext_vector_type(4)));
constexpr int BM = 256, BK = 64, HALF = 128, HTB = HALF * BK * 2  , STAGE_BYTES = 8 * HTB, NXCD = 8, WGM = 8;

__host__ __device__ __forceinline__ int lds_byte(int r, int c) { const int st = (r >> 4) * 2 + (c >> 5), rr = r & 15, cc = c & 31, ob = rr * 64 + cc * 2; return st * 1024 + (ob ^ (((ob >> 9) & 1) << 5)); }
__host__ __device__ __forceinline__ void stage_rc(int b, int& R, int& C) { const int st = b / 1024, sb = b % 1024, swz = sb ^ (((sb >> 9) & 1) << 5); R = (st >> 1) * 16 + swz / 64; C = (st & 1) * 32 + (swz % 64) / 2; }
__host__ __device__ __forceinline__ int perm32(int rho) { const int n = rho >> 4, i = rho & 15; return 8 * (i >> 2) + 4 * n + (i & 3); }

struct Unit { int pm, pn; };
struct Gemm { const bf16_t* A; const bf16_t* Bt; int M, N, K; };

struct StaticOrder {
    int nM, nN, nwg, G, c;
    __host__ __device__ void init(int M, int N, int G_, int c_) { nM = M / BM; nN = N / BM; nwg = nM * nN; G = G_; c = c_; }
    __host__ __device__ bool next(int i, Unit& u) const {
        const long L = (long)i * G + c; if (L >= nwg) return false;
        int wgid = (int)L; { const int q = nwg / NXCD, r = nwg % NXCD, xcd = wgid % NXCD, off = wgid / NXCD; wgid = (xcd < r ? xcd * (q + 1) : r * (q + 1) + (xcd - r) * q) + off; }
        const int nig = WGM * nN, gid = wgid / nig, fm = gid * WGM, gsz = (nM - fm) < WGM ? (nM - fm) : WGM;
        u.pm = fm + ((wgid % nig) % gsz); u.pn = (wgid % nig) / gsz; return true;
    }
    __device__ __forceinline__ void a_ready(const Unit&) const {}
    __device__ __forceinline__ void done(const Unit&) const {}
};

__device__ __forceinline__ unsigned cvt_pk_bf16(float lo, float hi) { unsigned r; asm volatile("v_cvt_pk_bf16_f32 %0, %1, %2" : "=v"(r) : "v"(lo), "v"(hi)); return r; }
typedef float f32x2 __attribute__((ext_vector_type(2)));
typedef unsigned u32x2 __attribute__((ext_vector_type(2)));
constexpr float kLog2e = 1.4426950408889634f;
constexpr float kEps = 1e-6f;
constexpr float QS_SB = 0.125f * kLog2e;
constexpr float QS_MLA = 0.10206207261596577f * kLog2e;
__device__ __forceinline__ u32x2 pack4(f32x4 v) { u32x2 w; w.x = cvt_pk_bf16(v[0], v[1]); w.y = cvt_pk_bf16(v[2], v[3]); return w; }
__device__ __forceinline__ float sigmoid_f(float v) { return __builtin_amdgcn_rcpf(1.0f + __builtin_amdgcn_exp2f(-kLog2e * v)); }
__device__ __forceinline__ f32x4 silu4(f32x4 v) { f32x4 o; o[0] = v[0] * sigmoid_f(v[0]); o[1] = v[1] * sigmoid_f(v[1]); o[2] = v[2] * sigmoid_f(v[2]); o[3] = v[3] * sigmoid_f(v[3]); return o; }
__device__ __forceinline__ f32x4 unpack4(u32x2 w) { f32x4 o; o[0] = __uint_as_float(w.x << 16); o[1] = __uint_as_float(w.x & 0xffff0000u); o[2] = __uint_as_float(w.y << 16); o[3] = __uint_as_float(w.y & 0xffff0000u); return o; }
__device__ __forceinline__ float sumsq4(f32x4 v) { return (v[0] * v[0] + v[1] * v[1]) + (v[2] * v[2] + v[3] * v[3]); }
__device__ __forceinline__ void rope4(f32x4& x1, f32x4& x2, const float* cs, int fq) {
    const f32x4 c01 = *(const f32x4*)(cs + 8 * fq), c23 = *(const f32x4*)(cs + 8 * fq + 4);
    const f32x4 co = {c01[0], c01[2], c23[0], c23[2]}, si = {c01[1], c01[3], c23[1], c23[3]};
    const f32x4 a = x1 * co - x2 * si, b = x2 * co + x1 * si;
    x1 = a; x2 = b;
}

struct EpiProj {
    static constexpr bool PERM = false, AFTER_DRAIN = false;
    bf16_t *SBQ, *SBK, *SBV, *GATE, *CQ, *CKV, *MK; float *RQSS, *RKVSS; const float* rpre; const float* cs;
    __device__ __forceinline__ void operator()(const f32x4 (&acc)[2][2][4][2], const Unit& u, int wr, int wc, int fr, int fq) const {
        const int pn = u.pn;
#pragma unroll
        for (int ai = 0; ai < 2; ++ai)
#pragma unroll
            for (int m = 0; m < 4; ++m) {
                const int row = u.pm * BM + ai * HALF + wr * 64 + m * 16 + fr;
                const float rs = rpre[row];
                f32x4 v[2][2];
#pragma unroll
                for (int bj = 0; bj < 2; ++bj)
#pragma unroll
                    for (int n = 0; n < 2; ++n) v[bj][n] = acc[ai][bj][m][n] * rs;
                const int cw = wc * 32 + fq * 4;
                if (pn < 6) {
                    bf16_t* dst = SBQ + (size_t)(pn >> 1) * (size_t)(16u << 20) + (size_t)row * 512 + (pn & 1) * 256 + cw;
                    const float sc = pn < 2 ? QS_SB : 1.0f;
#pragma unroll
                    for (int bj = 0; bj < 2; ++bj)
#pragma unroll
                        for (int n = 0; n < 2; ++n) *(u32x2*)(dst + bj * HALF + n * 16) = pack4(v[bj][n] * sc);
                } else if (pn < 8) {
                    bf16_t* dst = GATE + (size_t)row * 1024 + (pn - 6) * 256 + cw;
#pragma unroll
                    for (int bj = 0; bj < 2; ++bj)
#pragma unroll
                        for (int n = 0; n < 2; ++n) *(u32x2*)(dst + bj * HALF + n * 16) = pack4(silu4(v[bj][n]));
                } else if (pn == 8) {
                    bf16_t* dst = CQ + (size_t)row * 256 + cw; float ss = 0.f;
#pragma unroll
                    for (int bj = 0; bj < 2; ++bj)
#pragma unroll
                        for (int n = 0; n < 2; ++n) { *(u32x2*)(dst + bj * HALF + n * 16) = pack4(v[bj][n]); ss += sumsq4(v[bj][n]); }
                    ss += __shfl_xor(ss, 16); ss += __shfl_xor(ss, 32);
                    if (fq == 0) RQSS[(size_t)row * 4 + wc] = ss;
                } else if (pn == 9) {
                    bf16_t* dst = CKV + (size_t)row * 256 + cw; float ss = 0.f;
#pragma unroll
                    for (int n = 0; n < 2; ++n) { *(u32x2*)(dst + n * 16) = pack4(v[0][n]); *(u32x2*)(dst + HALF + n * 16) = (u32x2){0u, 0u}; ss += sumsq4(v[0][n]); }
                    ss += __shfl_xor(ss, 16); ss += __shfl_xor(ss, 32);
                    if (fq == 0) RKVSS[(size_t)row * 4 + wc] = ss;
                    if (wc == 0) {
                        f32x4 x1 = v[1][0], x2 = v[1][1]; rope4(x1, x2, cs + (size_t)row * 32, fq);
                        const u32x2 w1 = pack4(x1), w2 = pack4(x2);
                        bf16_t* kd = MK + (size_t)row * 768 + 64 + fq * 4;
#pragma unroll
                        for (int h = 0; h < 8; ++h) { *(u32x2*)(kd + h * 96) = w1; *(u32x2*)(kd + h * 96 + 16) = w2; }
                    } else {
                        bf16_t* gd = GATE + (size_t)row * 1024 + 512 + (wc - 1) * 32 + fq * 4;
#pragma unroll
                        for (int n = 0; n < 2; ++n) *(u32x2*)(gd + n * 16) = pack4(silu4(v[1][n]));
                    }
                } else {
                    const int base = 96 + (pn - 10) * 256 + cw;
#pragma unroll
                    for (int bj = 0; bj < 2; ++bj)
#pragma unroll
                        for (int n = 0; n < 2; ++n) { const int idx = base + bj * HALF + n * 16; if (idx < 512) *(u32x2*)(GATE + (size_t)row * 1024 + 512 + idx) = pack4(silu4(v[bj][n])); }
                }
            }
    }
};
struct EpiQ {
    static constexpr bool PERM = false, AFTER_DRAIN = false;
    bf16_t* MQ; const float* RQSS; const float* cs;
    __device__ __forceinline__ void operator()(const f32x4 (&acc)[2][2][4][2], const Unit& u, int wr, int wc, int fr, int fq) const {
#pragma unroll
        for (int ai = 0; ai < 2; ++ai)
#pragma unroll
            for (int m = 0; m < 4; ++m) {
                const int row = u.pm * BM + ai * HALF + wr * 64 + m * 16 + fr;
                const f32x4 s4 = *(const f32x4*)(RQSS + (size_t)row * 4);
                const float rs = QS_MLA * __builtin_amdgcn_rsqf(((s4[0] + s4[1]) + (s4[2] + s4[3])) * (1.0f / 256.0f) + kEps);
#pragma unroll
                for (int bj = 0; bj < 2; ++bj) {
                    const int g = u.pn * 8 + bj * 4 + wc;
                    f32x4 x1 = acc[ai][bj][m][0] * rs, x2 = acc[ai][bj][m][1] * rs;
                    if (g % 3 == 2) rope4(x1, x2, cs + (size_t)row * 32, fq);
                    bf16_t* dst = MQ + (size_t)row * 768 + g * 32 + fq * 4;
                    *(u32x2*)dst = pack4(x1); *(u32x2*)(dst + 16) = pack4(x2);
                }
            }
    }
};
struct EpiKV {
    static constexpr bool PERM = false, AFTER_DRAIN = false;
    bf16_t *MK, *MV; const float* RKVSS;
    __device__ __forceinline__ void operator()(const f32x4 (&acc)[2][2][4][2], const Unit& u, int wr, int wc, int fr, int fq) const {
#pragma unroll
        for (int ai = 0; ai < 2; ++ai)
#pragma unroll
            for (int m = 0; m < 4; ++m) {
                const int row = u.pm * BM + ai * HALF + wr * 64 + m * 16 + fr;
                const f32x4 s4 = *(const f32x4*)(RKVSS + (size_t)row * 4);
                const float rs = __builtin_amdgcn_rsqf(((s4[0] + s4[1]) + (s4[2] + s4[3])) * (1.0f / 128.0f) + kEps);
#pragma unroll
                for (int bj = 0; bj < 2; ++bj) {
                    const int h = u.pn * 2 + bj;
                    bf16_t* dst = (wc < 2) ? (MK + (size_t)row * 768 + h * 96 + wc * 32 + fq * 4) : (MV + (size_t)row * 512 + h * 64 + (wc - 2) * 32 + fq * 4);
#pragma unroll
                    for (int n = 0; n < 2; ++n) *(u32x2*)(dst + n * 16) = pack4(acc[ai][bj][m][n] * rs);
                }
            }
    }
};
struct EpiStat {
    static constexpr bool PERM = false, AFTER_DRAIN = false;
    bf16_t* OUT; float* SS;
    __device__ __forceinline__ void operator()(const f32x4 (&acc)[2][2][4][2], const Unit& u, int wr, int wc, int fr, int fq) const {
#pragma unroll
        for (int ai = 0; ai < 2; ++ai)
#pragma unroll
            for (int m = 0; m < 4; ++m) {
                const int row = u.pm * BM + ai * HALF + wr * 64 + m * 16 + fr;
                bf16_t* dst = OUT + (size_t)row * 1024 + u.pn * BM + wc * 32 + fq * 4; float ss = 0.f;
#pragma unroll
                for (int bj = 0; bj < 2; ++bj)
#pragma unroll
                    for (int n = 0; n < 2; ++n) { *(u32x2*)(dst + bj * HALF + n * 16) = pack4(acc[ai][bj][m][n]); ss += sumsq4(acc[ai][bj][m][n]); }
                ss += __shfl_xor(ss, 16); ss += __shfl_xor(ss, 32);
                if (fq == 0) SS[(size_t)row * 16 + u.pn * 4 + wc] = ss;
            }
    }
};
struct EpiFinal {
    static constexpr bool PERM = false, AFTER_DRAIN = false;
    const float* x; const bf16_t* Y; const bf16_t* PLE; const float* RY; const float* RP; const float* gpost; const float* gple; const float* bias; float* out;
    __device__ __forceinline__ void operator()(const f32x4 (&acc)[2][2][4][2], const Unit& u, int wr, int wc, int fr, int fq) const {
#pragma unroll
        for (int ai = 0; ai < 2; ++ai)
#pragma unroll
            for (int m = 0; m < 4; ++m) {
                const int row = u.pm * BM + ai * HALF + wr * 64 + m * 16 + fr;
                const float ry = RY[row], rp = RP[row];
#pragma unroll
                for (int bj = 0; bj < 2; ++bj)
#pragma unroll
                    for (int n = 0; n < 2; ++n) {
                        const int col = u.pn * BM + bj * HALF + wc * 32 + n * 16 + fq * 4; const size_t off = (size_t)row * 1024 + col;
                        const f32x4 gp = *(const f32x4*)(gpost + col), gl = *(const f32x4*)(gple + col), bb = *(const f32x4*)(bias + col);
                        const f32x4 xv = *(const f32x4*)(x + off); const f32x4 yv = unpack4(*(const u32x2*)(Y + off)), pv = unpack4(*(const u32x2*)(PLE + off));
                        const f32x4 gt = acc[ai][bj][m][n] + bb; f32x4 o;
#pragma unroll
                        for (int e = 0; e < 4; ++e) o[e] = (xv[e] + yv[e] * ry * gp[e]) + pv[e] * rp * gl[e] * sigmoid_f(gt[e]);
                        *(f32x4*)(out + off) = o;
                    }
            }
    }
};
template <class Epi, class Sched, bool ALIGN_EPI = false, bool SP2 = false>
__device__ __forceinline__ void gemm_phase(PG8_LAS unsigned char* lds, const Gemm g, const Sched& S, const Epi& E) {
    const int tid = threadIdx.x, wid = __builtin_amdgcn_readfirstlane(tid >> 6), lane = tid & 63, wr = wid >> 2, wc = wid & 3, fr = lane & 15, fq = lane >> 4;
    const int K = g.K, nt = K / BK;
    unsigned voffA[2], voffB[2];
#pragma unroll
    for (int i = 0; i < 2; ++i) { int R, C; stage_rc(tid * 16 + i * 8192, R, C); const int Rb = Epi::PERM ? ((R & ~31) + perm32(R & 31)) : R;
        voffA[i] = (unsigned)(R * K + C) * 2u; voffB[i] = (unsigned)(Rb * K + C) * 2u; }
    const size_t kstep = (size_t)(BK * 2);
    const size_t hstep = (size_t)HALF * K * 2;
    const size_t tstep = 2 * hstep;
    const unsigned ldsw = (unsigned)wid * 1024u;
    const int aoff = lds_byte(wr * 64 + fr, fq * 8), boff = lds_byte(wc * 32 + fr, fq * 8);
#define PG8_SA(b, h) (((b) * 2 + (h)) * HTB)
#define PG8_SB(b, h) ((4 + (b) * 2 + (h)) * HTB)
#define PG8_STAGE(bufoff, gbase, voff) do { _Pragma("unroll") for (int _i = 0; _i < 2; ++_i) \
        __builtin_amdgcn_global_load_lds((const unsigned*)((const char*)(gbase) + (voff)[_i]), (PG8_LAS unsigned*)(lds + (bufoff) + ldsw + _i * 8192), 16, 0, 0); } while (0)
#define PG8_LDA(dst, b, h) do { _Pragma("unroll") for (int m = 0; m < 4; ++m) _Pragma("unroll") for (int k = 0; k < 2; ++k) dst[m][k] = *(const PG8_LAS bf16x8*)(lds + PG8_SA(b, h) + aoff + m * 2048 + k * 1024); } while (0)
#define PG8_LDB(dst, b, h) do { _Pragma("unroll") for (int n = 0; n < 2; ++n) _Pragma("unroll") for (int k = 0; k < 2; ++k) dst[n][k] = *(const PG8_LAS bf16x8*)(lds + PG8_SB(b, h) + boff + n * 2048 + k * 1024); } while (0)
#define PG8_MMA(ai, bj, At, Bt) do { __builtin_amdgcn_s_setprio(1); _Pragma("unroll") for (int m = 0; m < 4; ++m) _Pragma("unroll") for (int n = 0; n < 2; ++n) _Pragma("unroll") for (int k = 0; k < 2; ++k) \
        acc[ai][bj][m][n] = __builtin_amdgcn_mfma_f32_16x16x32_bf16(Bt[n][k], At[m][k], acc[ai][bj][m][n], 0, 0, 0); __builtin_amdgcn_s_setprio(0); } while (0)
#define PG8_WAIT_V(n) asm volatile("s_waitcnt vmcnt(" #n ")" ::: "memory")
#define PG8_WAIT_L(n) asm volatile("s_waitcnt lgkmcnt(" #n ")" ::: "memory")
#define PG8_BAR __builtin_amdgcn_s_barrier()
#define PG8_SCHED __builtin_amdgcn_sched_barrier(0)
    Unit cur, nxt; int ui = 0;
    if (!S.next(0, cur)) return;
    f32x4 acc[2][2][4][2];
#pragma unroll
    for (int a = 0; a < 2; ++a)
#pragma unroll
        for (int b = 0; b < 2; ++b)
#pragma unroll
            for (int m = 0; m < 4; ++m)
#pragma unroll
                for (int n = 0; n < 2; ++n) acc[a][b][m][n] = (f32x4){0.f, 0.f, 0.f, 0.f};
    bf16x8 At[4][2], B0[2][2], B1[2][2];
    const char* cA = (const char*)g.A + (size_t)cur.pm * tstep; const char* cB = (const char*)g.Bt + (size_t)cur.pn * tstep;
    S.a_ready(cur);
    if constexpr (SP2) {
        PG8_STAGE(PG8_SB(0, 0), cB, voffB); PG8_STAGE(PG8_SB(0, 1), cB + hstep, voffB); PG8_STAGE(PG8_SA(0, 0), cA, voffA); PG8_STAGE(PG8_SA(0, 1), cA + hstep, voffA);
        if (wr == 1) PG8_BAR;
        PG8_WAIT_V(2); PG8_BAR;
        PG8_STAGE(PG8_SB(1, 0), cB + kstep, voffB); PG8_STAGE(PG8_SA(1, 0), cA + kstep, voffA); PG8_STAGE(PG8_SB(1, 1), cB + hstep + kstep, voffB);
        PG8_WAIT_V(6); PG8_BAR;
    } else {
        PG8_STAGE(PG8_SB(0, 0), cB, voffB); PG8_STAGE(PG8_SA(0, 0), cA, voffA); PG8_STAGE(PG8_SB(0, 1), cB + hstep, voffB); PG8_STAGE(PG8_SA(0, 1), cA + hstep, voffA);
        if (wr == 1) PG8_BAR;
        PG8_WAIT_V(4); PG8_BAR;
        PG8_STAGE(PG8_SB(1, 0), cB + kstep, voffB); PG8_STAGE(PG8_SA(1, 0), cA + kstep, voffA); PG8_STAGE(PG8_SB(1, 1), cB + hstep + kstep, voffB);
        PG8_WAIT_V(6); PG8_BAR;
    }
    for (;;) {
        const bool has_next = S.next(ui + 1, nxt);
        const char* nA = has_next ? (const char*)g.A + (size_t)nxt.pm * tstep : cA; const char* nB = has_next ? (const char*)g.Bt + (size_t)nxt.pn * tstep : cB;
        for (int t = 0; t < nt; t += 2) {
            const bool last = (t == nt - 2);
            const char* a1 = cA + (size_t)(t + 1) * kstep;
            const char* a2 = last ? nA : cA + (size_t)(t + 2) * kstep; const char* b2 = last ? nB : cB + (size_t)(t + 2) * kstep;
            const char* a3 = a2 + kstep; const char* b3 = b2 + kstep;
            if (last && has_next) S.a_ready(nxt);
            if constexpr (SP2) {
            PG8_LDB(B0, 0, 0); PG8_LDB(B1, 0, 1); PG8_SCHED; PG8_LDA(At, 0, 0); PG8_STAGE(PG8_SA(1, 1), a1 + hstep, voffA);
            PG8_WAIT_V(8); PG8_WAIT_L(0); PG8_BAR; PG8_MMA(0, 0, At, B0); PG8_MMA(0, 1, At, B1); PG8_BAR; PG8_SCHED;
            PG8_LDA(At, 0, 1); PG8_STAGE(PG8_SB(0, 0), b2, voffB); PG8_STAGE(PG8_SB(0, 1), b2 + hstep, voffB); PG8_STAGE(PG8_SA(0, 0), a2, voffA);
            PG8_WAIT_V(8); PG8_WAIT_L(0); PG8_BAR; PG8_MMA(1, 0, At, B0); PG8_MMA(1, 1, At, B1); PG8_BAR; PG8_SCHED;
            PG8_LDB(B0, 1, 0); PG8_LDB(B1, 1, 1); PG8_SCHED; PG8_LDA(At, 1, 0); PG8_STAGE(PG8_SA(0, 1), a2 + hstep, voffA);
            PG8_WAIT_V(8); PG8_WAIT_L(0); PG8_BAR; PG8_MMA(0, 0, At, B0); PG8_MMA(0, 1, At, B1); PG8_BAR; PG8_SCHED;
            PG8_LDA(At, 1, 1); PG8_STAGE(PG8_SB(1, 0), b3, voffB); PG8_STAGE(PG8_SB(1, 1), b3 + hstep, voffB); PG8_STAGE(PG8_SA(1, 0), a3, voffA);
            PG8_WAIT_V(8); PG8_WAIT_L(0); PG8_BAR; PG8_MMA(1, 0, At, B0); PG8_MMA(1, 1, At, B1); PG8_BAR; PG8_SCHED;
            } else {
            PG8_LDB(B0, 0, 0); PG8_SCHED; PG8_LDA(At, 0, 0); PG8_STAGE(PG8_SA(1, 1), a1 + hstep, voffA);
            PG8_WAIT_L(8); PG8_BAR; PG8_WAIT_L(0); PG8_MMA(0, 0, At, B0); PG8_BAR; PG8_SCHED;
            PG8_LDB(B1, 0, 1); PG8_STAGE(PG8_SB(0, 0), b2, voffB);
            PG8_BAR; PG8_WAIT_L(0); PG8_MMA(0, 1, At, B1); PG8_BAR;
            PG8_LDA(At, 0, 1); PG8_STAGE(PG8_SA(0, 0), a2, voffA);
            PG8_BAR; PG8_WAIT_L(0); PG8_MMA(1, 0, At, B0); PG8_BAR; PG8_SCHED;
            PG8_STAGE(PG8_SB(0, 1), b2 + hstep, voffB);
            PG8_WAIT_V(6); PG8_BAR; PG8_MMA(1, 1, At, B1); PG8_BAR;
            PG8_LDB(B0, 1, 0); PG8_SCHED; PG8_LDA(At, 1, 0); PG8_STAGE(PG8_SA(0, 1), a2 + hstep, voffA);
            PG8_WAIT_L(8); PG8_BAR; PG8_WAIT_L(0); PG8_MMA(0, 0, At, B0); PG8_BAR; PG8_SCHED;
            PG8_LDB(B1, 1, 1); PG8_STAGE(PG8_SB(1, 0), b3, voffB);
            PG8_BAR; PG8_WAIT_L(0); PG8_MMA(0, 1, At, B1); PG8_BAR;
            PG8_LDA(At, 1, 1); PG8_STAGE(PG8_SA(1, 0), a3, voffA);
            PG8_BAR; PG8_WAIT_L(0); PG8_MMA(1, 0, At, B0); PG8_BAR; PG8_SCHED;
            PG8_STAGE(PG8_SB(1, 1), b3 + hstep, voffB);
            PG8_WAIT_V(6); PG8_BAR; PG8_MMA(1, 1, At, B1); PG8_BAR;
            }
        }
        if constexpr (ALIGN_EPI) { if (wr == 0) PG8_BAR; }
        if constexpr (!Epi::AFTER_DRAIN) { E(acc, cur, wr, wc, fr, fq); S.done(cur); }
        if (!has_next) break;
#pragma unroll
        for (int a = 0; a < 2; ++a)
#pragma unroll
            for (int b = 0; b < 2; ++b)
#pragma unroll
                for (int m = 0; m < 4; ++m)
#pragma unroll
                    for (int n = 0; n < 2; ++n) acc[a][b][m][n] = (f32x4){0.f, 0.f, 0.f, 0.f};
        cur = nxt; cA = nA; cB = nB; ++ui;
        if constexpr (ALIGN_EPI) { if (wr == 1) PG8_BAR; }
    }
    PG8_WAIT_V(0);
    if constexpr (!ALIGN_EPI) { if (wr == 0) PG8_BAR; }
    PG8_BAR;
    if constexpr (Epi::AFTER_DRAIN) { E.fused(acc, cur, wr, wc, fr, fq, lds, wid, lane); S.done(cur); }
#undef PG8_SA
#undef PG8_SB
#undef PG8_STAGE
#undef PG8_LDA
#undef PG8_LDB
#undef PG8_MMA
#undef PG8_WAIT_V
#undef PG8_WAIT_L
#undef PG8_BAR
#undef PG8_SCHED
}
}
namespace att {
using bf16x8 = __attribute__((ext_vector_type(8))) short;
using s16x4 = __attribute__((ext_vector_type(4))) short;
using f32x16 = __attribute__((ext_vector_type(16))) float;
using f32x4 = __attribute__((ext_vector_type(4))) float;
using u32x4 = __attribute__((ext_vector_type(4))) unsigned;
typedef unsigned short bf16_t;
#define ALAS __attribute__((address_space(3)))
constexpr int SEQ = 4096, KSLOT = 16384, VSLOT = 8192, NSLOT = 3;
constexpr int L_K = 0, L_V = NSLOT * KSLOT, L_WS = L_V + NSLOT * VSLOT, L_FLAG = L_WS + 8 * 64 * 4, L_OST = L_FLAG + 256, L_END = L_OST + 8 * 8192;
constexpr float kEps = 1e-6f;
constexpr float SB_DONE = 151.0f;
__device__ __forceinline__ int crow(int r, int hi) { return (r & 3) + 8 * (r >> 2) + 4 * hi; }
__device__ __forceinline__ void glds16(const void* gsrc, unsigned lds_dst) { unsigned keep;
    asm volatile("s_mov_b32 %0, m0\n\ts_mov_b32 m0, %2\n\ts_nop 0\n\tglobal_load_lds_dwordx4 %1, off\n\ts_mov_b32 m0, %0" : "=&s"(keep) : "v"(gsrc), "s"(lds_dst) : "memory"); }
typedef float f32x2_t __attribute__((ext_vector_type(2))); typedef __bf16 bf16x2_t __attribute__((ext_vector_type(2)));
__device__ __forceinline__ unsigned cvtpk(float lo, float hi) { f32x2_t v = {lo, hi}; bf16x2_t b = __builtin_convertvector(v, bf16x2_t); return __builtin_bit_cast(unsigned, b); }
#define A_WAIT_BAR(N) asm volatile("s_waitcnt vmcnt(" #N ") lgkmcnt(0)\n\ts_barrier" ::: "memory")

template <int ND0> __device__ __forceinline__ void qkt(f32x16& p0, f32x16& p1, const ALAS char* Kslot, const bf16x8* qr, int r32, int hi) {
    const ALAS char* kb = Kslot + hi * 1024 + r32 * 16;
    p0 = f32x16{}; p1 = f32x16{};
#pragma unroll
    for (int d0 = 0; d0 < ND0; ++d0) {
        const bf16x8 b0 = *(const ALAS bf16x8*)(kb + d0 * 2048);
        const bf16x8 b1 = *(const ALAS bf16x8*)(kb + d0 * 2048 + 512);
        p0 = __builtin_amdgcn_mfma_f32_32x32x16_bf16(b0, qr[d0], p0, 0, 0, 0);
        p1 = __builtin_amdgcn_mfma_f32_32x32x16_bf16(b1, qr[d0], p1, 0, 0, 0);
    }
}
__device__ __forceinline__ void pv(f32x16* o, int vb, bf16x8 pa0, bf16x8 pa1, bf16x8 pa2, bf16x8 pa3) {
#pragma unroll
    for (int d0 = 0; d0 < 2; ++d0) { s16x4 lo[4], hi[4];
#pragma unroll
        for (int ks = 0; ks < 4; ++ks) {
            asm volatile("ds_read_b64_tr_b16 %0,%1 offset:%c2" : "=&v"(lo[ks]) : "v"(vb), "i"(d0 * 4096 + ks * 1024) : "memory");
            asm volatile("ds_read_b64_tr_b16 %0,%1 offset:%c2" : "=&v"(hi[ks]) : "v"(vb), "i"(d0 * 4096 + ks * 1024 + 512) : "memory"); }
        asm volatile("s_waitcnt lgkmcnt(0)" ::: "memory"); __builtin_amdgcn_sched_barrier(0);
#define A_PK(k) (bf16x8){lo[k][0], lo[k][1], lo[k][2], lo[k][3], hi[k][0], hi[k][1], hi[k][2], hi[k][3]}
        o[d0] = __builtin_amdgcn_mfma_f32_32x32x16_bf16(pa0, A_PK(0), o[d0], 0, 0, 0);
        o[d0] = __builtin_amdgcn_mfma_f32_32x32x16_bf16(pa1, A_PK(1), o[d0], 0, 0, 0);
        o[d0] = __builtin_amdgcn_mfma_f32_32x32x16_bf16(pa2, A_PK(2), o[d0], 0, 0, 0);
        o[d0] = __builtin_amdgcn_mfma_f32_32x32x16_bf16(pa3, A_PK(3), o[d0], 0, 0, 0);
#undef A_PK
    }
}
__device__ __forceinline__ float xhalf_sum(float v) { auto rr = __builtin_amdgcn_permlane32_swap(__float_as_uint(v), __float_as_uint(v), false, false); return __uint_as_float(rr[0]) + __uint_as_float(rr[1]); }
__device__ __forceinline__ float xhalf_max(float v) { auto rr = __builtin_amdgcn_permlane32_swap(__float_as_uint(v), __float_as_uint(v), false, false); return fmaxf(__uint_as_float(rr[0]), __uint_as_float(rr[1])); }

template <bool SBK> __device__ __forceinline__ void attn_unit(int b, int h, int qb, const bf16_t* Q, const bf16_t* K, const bf16_t* V, const bf16_t* gate, const float* gnorm, bf16_t* out, int goff, ALAS char* shm) {
    constexpr int DQK = SBK ? 64 : 96, QP = SBK ? 512 : 768, ND0 = DQK / 16;
    const int tid = threadIdx.x, lane = tid & 63, r32 = lane & 31, hi = lane >> 5; const int wid = __builtin_amdgcn_readfirstlane(tid >> 6);
    const long rowbase = (long)b * SEQ; const int q0 = qb * 256;
    const bf16_t* Qw = Q + (rowbase + q0 + wid * 32) * QP + h * DQK;
    const bf16_t* Kh = K + rowbase * QP + h * DQK; const bf16_t* Vh = V + rowbase * 512 + h * 64;
    const unsigned lds0 = (unsigned)(uintptr_t)shm;
    ALAS float* wsf = (ALAS float*)(shm + L_WS) + wid * 64;
    ALAS unsigned* flags = (ALAS unsigned*)(shm + L_FLAG);
    const bf16_t* ksrc = Kh + (long)lane * QP + wid * 8;
    const bf16_t* ksrc2 = Kh + (long)lane * QP + (8 + (wid & 3)) * 8;
    const bf16_t* vsrc = Vh + (long)(16 * (wid & 3) + (lane >> 2)) * 512 + (wid >> 2) * 32 + (lane & 3) * 8;
    const unsigned kdst = lds0 + L_K + wid * 1024, vdst = lds0 + L_V + wid * 1024;
    const int NT = 4 * qb + 4;
    const int tw = 4 * qb + (wid >> 1);
#define A_TILE(i) (SBK ? (NT - 1 - (i)) : (i))
#define A_DMA(i, s) do { const int t_ = A_TILE(i); glds16(ksrc + (long)t_ * 64 * QP, (unsigned)__builtin_amdgcn_readfirstlane(kdst + (s) * KSLOT)); \
        if (!SBK) glds16(ksrc2 + (long)t_ * 64 * QP, (unsigned)__builtin_amdgcn_readfirstlane(kdst + 8192 + (s) * KSLOT)); \
        glds16(vsrc + (long)t_ * 64 * 512, (unsigned)__builtin_amdgcn_readfirstlane(vdst + (s) * VSLOT)); } while (0)
    A_DMA(0, 0); A_DMA(1, 1);
    bf16x8 qr[ND0];
#pragma unroll
    for (int d0 = 0; d0 < ND0; ++d0) qr[d0] = *(const bf16x8*)(Qw + (long)r32 * QP + d0 * 16 + hi * 8);
    f32x16 o[2]; o[0] = f32x16{}; o[1] = f32x16{};
    float m_run = -INFINITY, l_run = 0.f, carry = 0.f;
    const int vb0 = (int)(lds0 + L_V) + ((lane >> 4) & 1) * 32 + (lane & 3) * 8 + (4 * hi + ((lane & 15) >> 2)) * 64;
    int slot = 0;
    for (int i = 0; i < NT; ++i) {
        if (i + 1 < NT) { if (SBK) { A_WAIT_BAR(2); } else { A_WAIT_BAR(3); } } else { A_WAIT_BAR(0); }
        if (SBK && i > 0) {
            const ALAS unsigned* fl = flags + ((i - 1) & 1) * 8; unsigned all = 1u;
#pragma unroll
            for (int w = 0; w < 8; ++w) all &= fl[w];
            if (all) break;
        }
        if (i + 2 < NT) { const int s2 = (slot >= 1) ? slot - 1 : slot + 2; A_DMA(i + 2, s2); }
        const int t = A_TILE(i);
        if (t <= tw) {
            f32x16 p0, p1;
            qkt<ND0>(p0, p1, shm + L_K + slot * KSLOT, qr, r32, hi);
            if (SBK) {
                if (t == tw) { const int qrel = 32 * (wid & 1) + r32;
#pragma unroll
                    for (int r = 0; r < 16; ++r) { const int kv = crow(r, hi); if (kv >= qrel) p0[r] = -INFINITY; if (kv + 32 >= qrel) p1[r] = -INFINITY; } }
                f32x16 s0, s1;
#pragma unroll
                for (int r = 0; r < 16; ++r) {
                    s0[r] = fmaxf(p0[r], 0.f) + __builtin_amdgcn_logf(1.0f + __builtin_amdgcn_exp2f(-fabsf(p0[r])));
                    s1[r] = fmaxf(p1[r], 0.f) + __builtin_amdgcn_logf(1.0f + __builtin_amdgcn_exp2f(-fabsf(p1[r])));
                }
                float lo_[8], up_[8];
#pragma unroll
                for (int i4 = 0; i4 < 8; ++i4) {
                    const float bs = (i4 < 4) ? ((s0[4 * i4] + s0[4 * i4 + 1]) + (s0[4 * i4 + 2] + s0[4 * i4 + 3])) : ((s1[4 * i4 - 16] + s1[4 * i4 - 15]) + (s1[4 * i4 - 14] + s1[4 * i4 - 13]));
                    auto rr = __builtin_amdgcn_permlane32_swap(__float_as_uint(bs), __float_as_uint(bs), false, false);
                    lo_[i4] = __uint_as_float(rr[0]); up_[i4] = __uint_as_float(rr[1]);
                }
                float run = carry;
#pragma unroll
                for (int i4 = 7; i4 >= 0; --i4) {
                    float c = run + (hi == 0 ? up_[i4] : 0.f);
#pragma unroll
                    for (int e = 3; e >= 0; --e) {
                        if (i4 < 4) { c += s0[4 * i4 + e]; p0[4 * i4 + e] = __builtin_amdgcn_exp2f(p0[4 * i4 + e] - c); }
                        else { c += s1[4 * i4 - 16 + e]; p1[4 * i4 - 16 + e] = __builtin_amdgcn_exp2f(p1[4 * i4 - 16 + e] - c); }
                    }
                    run += lo_[i4] + up_[i4];
                }
                carry = run;
            } else {
                float rm = fmaxf(p0[0], p1[0]);
#pragma unroll
                for (int r = 1; r < 16; ++r) rm = fmaxf(rm, fmaxf(p0[r], p1[r]));
                rm = xhalf_max(rm);
                const float m_new = fmaxf(m_run, rm);
                const float alpha = __builtin_amdgcn_exp2f(m_run - m_new);
                float ls = 0.f;
#pragma unroll
                for (int r = 0; r < 16; ++r) { p0[r] = __builtin_amdgcn_exp2f(p0[r] - m_new); p1[r] = __builtin_amdgcn_exp2f(p1[r] - m_new); ls += p0[r] + p1[r]; }
                l_run = l_run * alpha + ls; m_run = m_new;
                if (!__all(alpha == 1.0f)) {
                    if (hi == 0) wsf[r32] = alpha;
#pragma unroll
                    for (int r = 0; r < 16; ++r) { const float f = wsf[crow(r, hi)]; o[0][r] *= f; o[1][r] *= f; }
                }
            }
            u32x4 pw0, pw1, pw2, pw3;
            pw0 = (u32x4){cvtpk(p0[0], p0[1]), cvtpk(p0[2], p0[3]), cvtpk(p0[4], p0[5]), cvtpk(p0[6], p0[7])};
            pw1 = (u32x4){cvtpk(p0[8], p0[9]), cvtpk(p0[10], p0[11]), cvtpk(p0[12], p0[13]), cvtpk(p0[14], p0[15])};
            pw2 = (u32x4){cvtpk(p1[0], p1[1]), cvtpk(p1[2], p1[3]), cvtpk(p1[4], p1[5]), cvtpk(p1[6], p1[7])};
            pw3 = (u32x4){cvtpk(p1[8], p1[9]), cvtpk(p1[10], p1[11]), cvtpk(p1[12], p1[13]), cvtpk(p1[14], p1[15])};
            pv(o, vb0 + slot * VSLOT, __builtin_bit_cast(bf16x8, pw0), __builtin_bit_cast(bf16x8, pw1), __builtin_bit_cast(bf16x8, pw2), __builtin_bit_cast(bf16x8, pw3));
        }
        if (SBK) { const bool done = (t <= tw) && __all(carry > SB_DONE); if (lane == 0) flags[(i & 1) * 8 + wid] = done ? 1u : 0u; }
        slot = (slot == NSLOT - 1) ? 0 : slot + 1;
    }
    A_WAIT_BAR(0);
    float rli[16];
    if (!SBK) {
        const float lt = xhalf_sum(l_run);
        if (hi == 0) wsf[32 + r32] = lt;
#pragma unroll
        for (int r = 0; r < 16; ++r) rli[r] = __builtin_amdgcn_rcpf(wsf[32 + crow(r, hi)]);
    } else {
#pragma unroll
        for (int r = 0; r < 16; ++r) rli[r] = 1.0f;
    }
    ALAS float* stg = (ALAS float*)(shm + L_OST) + wid * 2048;
#pragma unroll
    for (int r = 0; r < 16; ++r) { const int orow = crow(r, hi);
#pragma unroll
        for (int d0 = 0; d0 < 2; ++d0) stg[orow * 64 + d0 * 32 + r32] = o[d0][r] * rli[r]; }
    const long grow0 = rowbase + q0 + wid * 32;
#pragma unroll
    for (int i = 0; i < 4; ++i) {
        const int row = i * 8 + (lane >> 3), ch = lane & 7;
        const f32x4 a = *(const ALAS f32x4*)(stg + row * 64 + ch * 8), c = *(const ALAS f32x4*)(stg + row * 64 + ch * 8 + 4);
        float ss = ((a[0] * a[0] + a[1] * a[1]) + (a[2] * a[2] + a[3] * a[3])) + ((c[0] * c[0] + c[1] * c[1]) + (c[2] * c[2] + c[3] * c[3]));
        ss += __shfl_xor(ss, 1); ss += __shfl_xor(ss, 2); ss += __shfl_xor(ss, 4);
        const float rn = 1.0f / sqrtf(ss * (1.0f / 64.0f) + kEps);
        const size_t off = (size_t)(grow0 + row) * 1024 + goff + h * 64 + ch * 8;
        const u32x4 gv = *(const u32x4*)(gate + off);
        const f32x4 g0 = *(const f32x4*)(gnorm + h * 64 + ch * 8), g1 = *(const f32x4*)(gnorm + h * 64 + ch * 8 + 4);
        float v[8];
#pragma unroll
        for (int e = 0; e < 4; ++e) { v[e] = a[e] * rn * g0[e]; v[4 + e] = c[e] * rn * g1[e]; }
        u32x4 w;
#pragma unroll
        for (int e = 0; e < 4; ++e) { const unsigned gw = gv[e]; w[e] = cvtpk(v[2 * e] * __uint_as_float(gw << 16), v[2 * e + 1] * __uint_as_float(gw & 0xffff0000u)); }
        *(u32x4*)(out + off) = w;
    }
    A_WAIT_BAR(0);
#undef A_TILE
#undef A_DMA
}

constexpr int M_K = 0, M_V = NSLOT * KSLOT, M_WS = M_V + 4 * VSLOT, M_END = M_WS + 8 * 64 * 4;
constexpr float MLA_THR = 8.0f;
#define A_BAR_L() asm volatile("s_waitcnt lgkmcnt(0)\n\ts_barrier" ::: "memory")
__device__ __forceinline__ void mla_unit(int b, int h, int qb, const bf16_t* Q, const bf16_t* K, const bf16_t* V, const bf16_t* gate, const float* gnorm, bf16_t* out, int goff, ALAS char* shm) {
    constexpr int QP = 768, ND0 = 6;
    const int tid = threadIdx.x, lane = tid & 63, r32 = lane & 31, hi = lane >> 5; const int wid = __builtin_amdgcn_readfirstlane(tid >> 6);
    const int grp = wid >> 2;
    const long rowbase = (long)b * SEQ; const int q0 = qb * 256;
    const bf16_t* Qw = Q + (rowbase + q0 + wid * 32) * QP + h * 96;
    const bf16_t* Kh = K + rowbase * QP + h * 96; const bf16_t* Vh = V + rowbase * 512 + h * 64;
    const unsigned lds0 = (unsigned)(uintptr_t)shm;
    ALAS float* wsf = (ALAS float*)(shm + M_WS) + wid * 64;
    const bf16_t* ksrc = Kh + (long)lane * QP + wid * 8;
    const bf16_t* ksrc2 = Kh + (long)lane * QP + (8 + (wid & 3)) * 8;
    const bf16_t* vsrc = Vh + (long)(16 * (wid & 3) + (lane >> 2)) * 512 + (wid >> 2) * 32 + (lane & 3) * 8;
    const unsigned kdst = lds0 + M_K + wid * 1024, vdst = lds0 + M_V + wid * 1024;
    const int NT = 4 * qb + 4, tw = 4 * qb + (wid >> 1);
#define M_DMA(t_) do { const int tt_ = (t_); const int ks_ = tt_ % 3, vs_ = tt_ & 3; glds16(ksrc + (long)tt_ * 64 * QP, (unsigned)__builtin_amdgcn_readfirstlane(kdst + ks_ * KSLOT)); \
        glds16(ksrc2 + (long)tt_ * 64 * QP, (unsigned)__builtin_amdgcn_readfirstlane(kdst + 8192 + ks_ * KSLOT)); \
        glds16(vsrc + (long)tt_ * 64 * 512, (unsigned)__builtin_amdgcn_readfirstlane(vdst + vs_ * VSLOT)); } while (0)
    M_DMA(0); M_DMA(1);
    bf16x8 qr[ND0];
#pragma unroll
    for (int d0 = 0; d0 < ND0; ++d0) qr[d0] = *(const bf16x8*)(Qw + (long)r32 * QP + d0 * 16 + hi * 8);
    f32x16 o[2]; o[0] = f32x16{}; o[1] = f32x16{};
    f32x16 negm = f32x16{}; f32x16 p0 = f32x16{}, p1 = f32x16{};
    u32x4 pw0 = {0u, 0u, 0u, 0u}, pw1 = pw0, pw2 = pw0, pw3 = pw0;
    float m_hat = 0.f, l_run = 0.f; bool need = false;
    const int vb0 = (int)(lds0 + M_V) + ((lane >> 4) & 1) * 32 + (lane & 3) * 8 + (4 * hi + ((lane & 15) >> 2)) * 64;
#define M_BAR_EVEN(t_) do { if ((t_) + 1 < NT) { A_WAIT_BAR(3); } else { A_WAIT_BAR(0); } if ((t_) + 2 < NT) M_DMA((t_) + 2); } while (0)
#define M_STAGE_A(t_, PVON, QKON) do { const int ta_ = (t_); \
        if (PVON) { \
            if (need) { _Pragma("unroll") for (int r = 0; r < 16; ++r) { const float f = wsf[crow(r, hi)]; o[0][r] *= f; o[1][r] *= f; } } \
            pv(o, vb0 + ((ta_ - 1) & 3) * VSLOT, __builtin_bit_cast(bf16x8, pw0), __builtin_bit_cast(bf16x8, pw1), __builtin_bit_cast(bf16x8, pw2), __builtin_bit_cast(bf16x8, pw3)); } \
        if (QKON) { const ALAS char* kb = shm + M_K + (ta_ % 3) * KSLOT + hi * 1024 + r32 * 16; \
            _Pragma("unroll") for (int d0 = 0; d0 < ND0; ++d0) { \
                const bf16x8 b0 = *(const ALAS bf16x8*)(kb + d0 * 2048); const bf16x8 b1 = *(const ALAS bf16x8*)(kb + d0 * 2048 + 512); \
                p0 = __builtin_amdgcn_mfma_f32_32x32x16_bf16(b0, qr[d0], d0 == 0 ? negm : p0, 0, 0, 0); \
                p1 = __builtin_amdgcn_mfma_f32_32x32x16_bf16(b1, qr[d0], d0 == 0 ? negm : p1, 0, 0, 0); } } } while (0)
#define M_STAGE_B(t_, ON) do { const int tb_ = (t_); if (ON) { \
        float a0 = fmaxf(fmaxf(p0[0], p0[1]), p1[0]), a1 = fmaxf(fmaxf(p0[2], p0[3]), p1[1]); a0 = fmaxf(fmaxf(a0, p1[2]), p1[3]); \
        _Pragma("unroll") for (int r = 4; r < 16; r += 4) { a0 = fmaxf(fmaxf(a0, p0[r]), p0[r + 1]); a1 = fmaxf(fmaxf(a1, p0[r + 2]), p0[r + 3]); a0 = fmaxf(fmaxf(a0, p1[r]), p1[r + 1]); a1 = fmaxf(fmaxf(a1, p1[r + 2]), p1[r + 3]); } \
        const float rm = xhalf_max(fmaxf(a0, a1)); \
        need = false; \
        if (tb_ == 0 || __any(rm > MLA_THR)) { \
            const float dl = (tb_ == 0) ? rm : fmaxf(rm, 0.f); \
            m_hat += dl; \
            _Pragma("unroll") for (int r = 0; r < 16; ++r) { p0[r] -= dl; p1[r] -= dl; } \
            _Pragma("unroll") for (int r = 0; r < 16; ++r) negm[r] = -m_hat; \
            if (tb_ > 0) { const float f = __builtin_amdgcn_exp2f(-dl); l_run *= f; if (hi == 0) wsf[r32] = f; need = true; } } \
        float ls0 = 0.f, ls1 = 0.f; \
        _Pragma("unroll") for (int r = 0; r < 16; ++r) { p0[r] = __builtin_amdgcn_exp2f(p0[r]); p1[r] = __builtin_amdgcn_exp2f(p1[r]); ls0 += p0[r]; ls1 += p1[r]; } \
        l_run += ls0 + ls1; \
        pw0 = (u32x4){cvtpk(p0[0], p0[1]), cvtpk(p0[2], p0[3]), cvtpk(p0[4], p0[5]), cvtpk(p0[6], p0[7])}; \
        pw1 = (u32x4){cvtpk(p0[8], p0[9]), cvtpk(p0[10], p0[11]), cvtpk(p0[12], p0[13]), cvtpk(p0[14], p0[15])}; \
        pw2 = (u32x4){cvtpk(p1[0], p1[1]), cvtpk(p1[2], p1[3]), cvtpk(p1[4], p1[5]), cvtpk(p1[6], p1[7])}; \
        pw3 = (u32x4){cvtpk(p1[8], p1[9]), cvtpk(p1[10], p1[11]), cvtpk(p1[12], p1[13]), cvtpk(p1[14], p1[15])}; } } while (0)
    const int tmain = NT - 4;
    if (grp == 0) {
        M_BAR_EVEN(0); M_STAGE_A(0, false, (0 < tmain || 0 <= tw)); A_BAR_L(); M_STAGE_B(0, (0 < tmain || 0 <= tw));
        int t = 1;
        for (; t < tmain; ++t) { M_BAR_EVEN(t); M_STAGE_A(t, true, true); A_BAR_L(); M_STAGE_B(t, true); }
        for (; t <= NT; ++t) { M_BAR_EVEN(t); M_STAGE_A(t, (t - 1 <= tw), (t < NT && t <= tw)); A_BAR_L(); M_STAGE_B(t, (t < NT && t <= tw)); }
    } else {
        M_BAR_EVEN(0); A_BAR_L(); M_STAGE_A(0, false, (0 < tmain || 0 <= tw));
        M_BAR_EVEN(1); M_STAGE_B(0, (0 < tmain || 0 <= tw)); A_BAR_L(); M_STAGE_A(1, (0 <= tw), (1 < tmain || (1 < NT && 1 <= tw)));
        int t = 2;
        for (; t < tmain; ++t) { M_BAR_EVEN(t); M_STAGE_B(t - 1, true); A_BAR_L(); M_STAGE_A(t, true, true); }
        for (; t <= NT; ++t) { M_BAR_EVEN(t); M_STAGE_B(t - 1, (t - 1 <= tw)); A_BAR_L(); M_STAGE_A(t, (t - 1 <= tw), (t < NT && t <= tw)); }
    }
#undef M_BAR_EVEN
#undef M_STAGE_A
#undef M_STAGE_B
    A_WAIT_BAR(0);
    const float lt = xhalf_sum(l_run);
    if (hi == 0) wsf[32 + r32] = lt;
    float rli[16];
#pragma unroll
    for (int r = 0; r < 16; ++r) rli[r] = __builtin_amdgcn_rcpf(wsf[32 + crow(r, hi)]);
    ALAS float* stg = (ALAS float*)shm + wid * 2048;
#pragma unroll
    for (int r = 0; r < 16; ++r) { const int orow = crow(r, hi);
#pragma unroll
        for (int d0 = 0; d0 < 2; ++d0) stg[orow * 64 + d0 * 32 + r32] = o[d0][r] * rli[r]; }
    const long grow0 = rowbase + q0 + wid * 32;
#pragma unroll
    for (int i = 0; i < 4; ++i) {
        const int row = i * 8 + (lane >> 3), ch = lane & 7;
        const f32x4 a = *(const ALAS f32x4*)(stg + row * 64 + ch * 8), c = *(const ALAS f32x4*)(stg + row * 64 + ch * 8 + 4);
        float ss = ((a[0] * a[0] + a[1] * a[1]) + (a[2] * a[2] + a[3] * a[3])) + ((c[0] * c[0] + c[1] * c[1]) + (c[2] * c[2] + c[3] * c[3]));
        ss += __shfl_xor(ss, 1); ss += __shfl_xor(ss, 2); ss += __shfl_xor(ss, 4);
        const float rn = 1.0f / sqrtf(ss * (1.0f / 64.0f) + kEps);
        const size_t off = (size_t)(grow0 + row) * 1024 + goff + h * 64 + ch * 8;
        const u32x4 gv = *(const u32x4*)(gate + off);
        const f32x4 g0 = *(const f32x4*)(gnorm + h * 64 + ch * 8), g1 = *(const f32x4*)(gnorm + h * 64 + ch * 8 + 4);
        float v[8];
#pragma unroll
        for (int e = 0; e < 4; ++e) { v[e] = a[e] * rn * g0[e]; v[4 + e] = c[e] * rn * g1[e]; }
        u32x4 w;
#pragma unroll
        for (int e = 0; e < 4; ++e) { const unsigned gw = gv[e]; w[e] = cvtpk(v[2 * e] * __uint_as_float(gw << 16), v[2 * e + 1] * __uint_as_float(gw & 0xffff0000u)); }
        *(u32x4*)(out + off) = w;
    }
    A_WAIT_BAR(0);
#undef M_DMA
}
}
#include <hip/hip_cooperative_groups.h>
namespace cg = cooperative_groups;
#ifndef MK_N_LAUNCHES
#define MK_N_LAUNCHES 1
#endif
#ifndef REP_MLA
#define REP_MLA 1
#endif
#ifndef REP_SB
#define REP_SB 1
#endif
#ifndef REP_P1
#define REP_P1 1
#endif
#ifndef REP_MISC
#define REP_MISC 1
#endif
#ifndef REP_SYNC
#define REP_SYNC 0
#endif
#ifndef REP_TAIL
#define REP_TAIL 1
#endif
constexpr int NWAVES = 8;
constexpr int N_PHASES = 7;
constexpr int M = 32768, D = 1024, SEQ = 4096, NIN = 2976, NINP = 3072, PLE = 256;
constexpr size_t MiB = 1u << 20;
constexpr size_t WS_A = 0;
constexpr size_t WS_B = 64 * MiB;
constexpr size_t WS_PLE = 128 * MiB;
constexpr size_t WS_SBQ = 192 * MiB, WS_SBK = 224 * MiB, WS_SBV = 256 * MiB;
constexpr size_t WS_MQ = 288 * MiB, WS_MK = 336 * MiB, WS_MV = 384 * MiB;
constexpr size_t WS_PB = 416 * MiB, WS_CQ = 432 * MiB, WS_CKV = 448 * MiB;
constexpr size_t WS_WIN = 464 * MiB;
constexpr size_t WS_WUQ = 470 * MiB;
constexpr size_t WS_WUKV = 471 * MiB;
constexpr size_t WS_WOUT = 472 * MiB;
constexpr size_t WS_WPLE = 474 * MiB;
constexpr size_t WS_WPG = 475 * MiB;
constexpr size_t WS_CS = 477 * MiB;
constexpr size_t WS_RPRE = 481 * MiB;
constexpr size_t WS_RQSS = 482 * MiB;
constexpr size_t WS_RKVSS = 483 * MiB;
constexpr size_t WS_YSS = 484 * MiB;
constexpr size_t WS_PSS = 486 * MiB;
constexpr size_t WS_RY = 488 * MiB, WS_RP = 489 * MiB;
constexpr size_t WS_CTL = 490 * MiB, CTL_ZERO_BYTES = 16384;
constexpr size_t WS_END = 491 * MiB;
constexpr int MISC_OFF = 147456 - 256;
constexpr int LDS_BYTES = 147456;
static_assert(WS_SBK - WS_SBQ == 32 * MiB && WS_SBV - WS_SBK == 32 * MiB, "EpiProj addresses SBK/SBV relative to SBQ");
static_assert(att::L_END <= MISC_OFF && pg8::STAGE_BYTES <= MISC_OFF, "control words");
static_assert(att::M_END <= MISC_OFF, "LDS map");
static_assert(att::L_END <= LDS_BYTES && pg8::STAGE_BYTES <= LDS_BYTES, "LDS map");

typedef unsigned short bf16;
typedef unsigned v4u __attribute__((ext_vector_type(4)));
typedef unsigned v2u __attribute__((ext_vector_type(2)));
typedef float f32x4 __attribute__((ext_vector_type(4)));
#define LAS __attribute__((address_space(3)))
__device__ __forceinline__ unsigned f2bf(float f) { unsigned u = __builtin_bit_cast(unsigned, f); return (u + 0x7fffu + ((u >> 16) & 1u)) >> 16; }
__device__ __forceinline__ unsigned pk2(float lo, float hi) { return f2bf(lo) | (f2bf(hi) << 16); }
__device__ __forceinline__ float wave_sum(float v) {
#pragma unroll
    for (int o = 1; o < 64; o <<= 1) v += __shfl_xor(v, o);
    return v;
}
__device__ __forceinline__ void transpose_item(const float* W, int K, int N, bf16* WT, int ldk, const float* gain, LAS float* scr, int item, int lane) {
    const int nblk = N / 32, kb = item / nblk, nb = item % nblk, k0 = 64 * kb, n0 = 32 * nb;
#pragma unroll 8
    for (int i = 0; i < 32; ++i) { const int kk = 2 * i + (lane >> 5); const float gk = gain ? gain[k0 + kk] : 1.0f; scr[kk * 33 + (lane & 31)] = W[(size_t)(k0 + kk) * N + n0 + (lane & 31)] * gk; }
    asm volatile("s_waitcnt lgkmcnt(0)" ::: "memory");
    const int c = lane & 7;
#pragma unroll
    for (int j = 0; j < 4; ++j) { const int n = (lane >> 3) + 8 * j; const LAS float* s = scr + (8 * c) * 33 + n;
        v4u o; o.x = pk2(s[0 * 33], s[1 * 33]); o.y = pk2(s[2 * 33], s[3 * 33]); o.z = pk2(s[4 * 33], s[5 * 33]); o.w = pk2(s[6 * 33], s[7 * 33]);
        *(v4u*)(WT + (size_t)(n0 + n) * ldk + k0 + 8 * c) = o; }
    asm volatile("s_waitcnt lgkmcnt(0)" ::: "memory");
}

#define XB_TMO      128
#define XB_XCNT(j)  (256  + 64 * (j))
#define XB_XSUB(j)  (1280 + 64 * (j))
#define XB_XGEN(j)  (2304 + 64 * (j))
#define XB_TOP      3328
#define XB_TOPGEN   3392
#define XCD_BAR_WORDS 3456
#define XB_SPIN_CAP (1u << 18)

__device__ __forceinline__ unsigned xb_ld(unsigned* p)              { return __hip_atomic_load(p, __ATOMIC_RELAXED, __HIP_MEMORY_SCOPE_AGENT); }
__device__ __forceinline__ unsigned xb_add(unsigned* p, unsigned v) { return __hip_atomic_fetch_add(p, v, __ATOMIC_RELAXED, __HIP_MEMORY_SCOPE_AGENT); }
__device__ __forceinline__ unsigned xb_xcc_id() { return (unsigned)__builtin_amdgcn_s_getreg((3 << 11) | 20) & 0xFu; }
#define XB_SPIN(cond, bar) do { unsigned _sp = 0; while (cond) { __builtin_amdgcn_s_sleep(1); \
    if ((++_sp & 255u) == 0u) { if (xb_ld(&(bar)[XB_TMO])) break; if (_sp > XB_SPIN_CAP) { atomicAdd(&(bar)[XB_TMO], 1u); break; } } } } while (0)

struct XcdBarrier {
    unsigned* bar; unsigned x;
    volatile LAS unsigned* st;
};

__device__ __forceinline__ XcdBarrier xcd_barrier_post(unsigned* bar, volatile LAS unsigned* st) {
    XcdBarrier b; b.bar = bar; b.x = xb_xcc_id(); b.st = st;
    if (threadIdx.x == 0) (void)xb_add(&bar[XB_XCNT(b.x)], 1u);
    return b;
}
__device__ __forceinline__ void xcd_barrier_complete(unsigned* bar, unsigned x, unsigned& nloc, unsigned& nx) {
    const unsigned G = gridDim.x * gridDim.y * gridDim.z;
    unsigned sum, cnt, mine, sp = 0u;
    for (;;) {
        sum = 0u; cnt = 0u; mine = 0u;
#pragma unroll
        for (unsigned j = 0; j < 16; ++j) { const unsigned c = xb_ld(&bar[XB_XCNT(j)]); sum += c; cnt += (c > 0u) ? 1u : 0u; mine = (j == x) ? c : mine; }
        if (sum == G) break;
        __builtin_amdgcn_s_sleep(1);
        if ((++sp & 255u) == 0u) { if (xb_ld(&bar[XB_TMO])) break; if (sp > XB_SPIN_CAP) { atomicAdd(&bar[XB_TMO], 1u); break; } }
    }
    nloc = mine > 0u ? mine : 1u; nx = cnt > 0u ? cnt : 1u;
}

__device__ __forceinline__ void xcd_barrier(const XcdBarrier& b) {
    asm volatile("s_waitcnt vmcnt(0)" ::: "memory");
    __syncthreads();
    if (threadIdx.x == 0) {
        unsigned* bar = b.bar;
        __builtin_amdgcn_s_waitcnt(0);
        unsigned nloc = b.st[0], nx = b.st[1];
        if (nloc == 0u) { xcd_barrier_complete(bar, b.x, nloc, nx); b.st[0] = nloc; b.st[1] = nx; }
        const unsigned old = xb_add(&bar[XB_XSUB(b.x)], 1u);
        const unsigned gen = old / nloc;
        if (old + 1u == (gen + 1u) * nloc) {
            __builtin_amdgcn_fence(__ATOMIC_RELEASE, "agent");
            asm volatile("s_waitcnt vmcnt(0)" ::: "memory");
            const unsigned og = xb_add(&bar[XB_TOP], 1u);
            const unsigned tg = og / nx;
            if (og + 1u == (tg + 1u) * nx) xb_add(&bar[XB_TOPGEN], 1u);
            else XB_SPIN(xb_ld(&bar[XB_TOPGEN]) == tg, bar);
            __builtin_amdgcn_fence(__ATOMIC_ACQUIRE, "agent");
            xb_add(&bar[XB_XGEN(b.x)], 1u);
            asm volatile("s_waitcnt vmcnt(0)" ::: "memory");
        } else {
            XB_SPIN(xb_ld(&bar[XB_XGEN(b.x)]) == gen, bar);
            __builtin_amdgcn_fence(__ATOMIC_ACQUIRE, "agent");
            asm volatile("s_waitcnt vmcnt(0)" ::: "memory");
        }
    }
    __syncthreads();
}

static_assert(XCD_BAR_WORDS * 4 <= (int)CTL_ZERO_BYTES, "barrier words inside the memset");
__device__ __forceinline__ int opq(int v) { asm volatile("" : "+s"(v)); return v; }
struct Args { const float* in[17]; const int* pos; float* out; unsigned char* ws; int ph_lo, ph_hi; };

__global__ void __launch_bounds__(NWAVES * 64, 2) fwd_kernel(Args args) {
    extern __shared__ __attribute__((aligned(16))) unsigned char lds[];
    const int tid = threadIdx.x, lane = tid & 63, wave = __builtin_amdgcn_readfirstlane(tid >> 6);
    const int G = gridDim.x; const int bx = blockIdx.x; const int vcu = (G % 8 == 0) ? (bx % 8) * (G / 8) + bx / 8 : bx;
    unsigned char* ws = args.ws;
    const float* x = args.in[0]; const float* pin = args.in[1];
    const float* g_pre = args.in[3]; const float* w_in = args.in[4]; const float* g_q = args.in[5]; const float* w_uq = args.in[6]; const float* g_kv = args.in[7]; const float* w_ukv = args.in[8];
    const float* g_sb = args.in[9]; const float* g_mla = args.in[10]; const float* w_out = args.in[11]; const float* g_post = args.in[12]; const float* w_ple = args.in[13]; const float* g_ple = args.in[14];
    const float* w_pg = args.in[15]; const float* b_pg = args.in[16];
    bf16* XB = (bf16*)(ws + WS_A); bf16* MIX = (bf16*)(ws + WS_A); bf16* X1B = (bf16*)(ws + WS_A);
    bf16* GATE = (bf16*)(ws + WS_B); bf16* YB = (bf16*)(ws + WS_B); bf16* PLEB = (bf16*)(ws + WS_PLE);
    bf16* SBQ = (bf16*)(ws + WS_SBQ); bf16* SBK = (bf16*)(ws + WS_SBK); bf16* SBV = (bf16*)(ws + WS_SBV);
    bf16* MQ = (bf16*)(ws + WS_MQ); bf16* MK = (bf16*)(ws + WS_MK); bf16* MV = (bf16*)(ws + WS_MV);
    bf16* PB = (bf16*)(ws + WS_PB); bf16* CQ = (bf16*)(ws + WS_CQ); bf16* CKV = (bf16*)(ws + WS_CKV);
    bf16* WIN = (bf16*)(ws + WS_WIN); bf16* WUQ = (bf16*)(ws + WS_WUQ); bf16* WUKV = (bf16*)(ws + WS_WUKV); bf16* WOUT = (bf16*)(ws + WS_WOUT); bf16* WPLE = (bf16*)(ws + WS_WPLE); bf16* WPG = (bf16*)(ws + WS_WPG);
    float* CS = (float*)(ws + WS_CS); float* RPRE = (float*)(ws + WS_RPRE); float* RQSS = (float*)(ws + WS_RQSS); float* RKVSS = (float*)(ws + WS_RKVSS);
    float* YSS = (float*)(ws + WS_YSS); float* PSS = (float*)(ws + WS_PSS); float* RY = (float*)(ws + WS_RY); float* RP = (float*)(ws + WS_RP);
    const int lo = args.ph_lo, hi = args.ph_hi;
#define IN(k) (lo <= (k) && (k) < hi)
#define SEAM(k) do { if (IN(k) && IN((k) + 1)) { xcd_barrier(bar); } } while (0)
    if (lo < 0) cg::this_grid().sync();
    volatile LAS unsigned* MISC = (volatile LAS unsigned*)((LAS unsigned char*)lds + MISC_OFF);
    if (tid < 8) MISC[tid] = 0u;
    __syncthreads();
    XcdBarrier bar; bar.bar = (unsigned*)(ws + WS_CTL); bar.x = 0; bar.st = nullptr;
    if (hi - lo > 1) bar = xcd_barrier_post((unsigned*)(ws + WS_CTL), MISC);
    const int gw = vcu * NWAVES + wave, NGW = G * NWAVES;

    for (int rep0 = 0; rep0 < REP_MISC; ++rep0)
    if (IN(0)) {
        LAS float* scr = (LAS float*)((LAS unsigned char*)lds + wave * 16384);
        constexpr int I_IN = 16 * 93, I_UQ = 4 * 24, I_UKV = 2 * 32, I_OUT = 16 * 32, I_PLE = 4 * 32, I_PG = 16 * 32;
        constexpr int NITEMS = I_IN + I_UQ + I_UKV + I_OUT + I_PLE + I_PG;
        for (int it = gw; it < NITEMS; it += NGW) {
            int r = it;
            if (r < I_IN) { transpose_item(w_in, 1024, NIN, WIN, 1024, g_pre, scr, r, lane); continue; } r -= I_IN;
            if (r < I_UQ) { transpose_item(w_uq, 256, 768, WUQ, 256, g_q, scr, r, lane); continue; } r -= I_UQ;
            if (r < I_UKV) { transpose_item(w_ukv, 128, 1024, WUKV, 256, g_kv, scr, r, lane); continue; } r -= I_UKV;
            if (r < I_OUT) { transpose_item(w_out, 1024, 1024, WOUT, 1024, nullptr, scr, r, lane); continue; } r -= I_OUT;
            if (r < I_PLE) { transpose_item(w_ple, 256, 1024, WPLE, 256, nullptr, scr, r, lane); continue; } r -= I_PLE;
            transpose_item(w_pg, 1024, 1024, WPG, 1024, nullptr, scr, r, lane);
        }
        const int gt = vcu * (NWAVES * 64) + tid, NGT = G * NWAVES * 64;
        for (int i = gt; i < (NINP - NIN) * 1024 / 8; i += NGT) *(v4u*)(WIN + (size_t)NIN * 1024 + (size_t)i * 8) = (v4u){0u, 0u, 0u, 0u};
        for (int i = gt; i < 1024 * 128 / 8; i += NGT) { const int n = i / 16, c = i % 16; *(v4u*)(WUKV + (size_t)n * 256 + 128 + c * 8) = (v4u){0u, 0u, 0u, 0u}; }
        for (int i = gt; i < M * 16; i += NGT) {
            const int row = i >> 4, k = i & 15;
            const float freq = exp2f(-(float)k * 0.8304820237218407f);
            const float ang = (float)args.pos[row] * freq;
            double tt = (double)ang * 0.15915494309189535; tt -= __builtin_rint(tt);
            const float tf = (float)tt;
            CS[(size_t)i * 2] = __builtin_amdgcn_cosf(tf); CS[(size_t)i * 2 + 1] = __builtin_amdgcn_sinf(tf);
        }
        for (int m = gw; m < M; m += NGW) {
            const f32x4* xr = (const f32x4*)(x + (size_t)m * D) + lane; f32x4 v[4]; float s = 0.f;
#pragma unroll
            for (int j = 0; j < 4; ++j) { v[j] = xr[64 * j]; s += (v[j][0] * v[j][0] + v[j][1] * v[j][1]) + (v[j][2] * v[j][2] + v[j][3] * v[j][3]); }
            s = wave_sum(s);
            if (lane == 0) RPRE[m] = 1.0f / sqrtf(s * (1.0f / D) + 1e-6f);
            v2u* o8 = (v2u*)(XB + (size_t)m * D) + lane;
#pragma unroll
            for (int j = 0; j < 4; ++j) o8[64 * j] = (v2u){pk2(v[j][0], v[j][1]), pk2(v[j][2], v[j][3])};
        }
        for (int i = gt; i < M * PLE / 4; i += NGT) { const f32x4 v = *((const f32x4*)pin + i); *((v2u*)PB + i) = (v2u){pk2(v[0], v[1]), pk2(v[2], v[3])}; }
    }
    SEAM(0);

    if (IN(1)) {
        { pg8::Gemm g{XB, WIN, M, NINP, 1024}; pg8::StaticOrder S; S.init(M, NINP, G, bx);
          pg8::EpiProj E{SBQ, SBK, SBV, GATE, CQ, CKV, MK, RQSS, RKVSS, RPRE, CS};
          pg8::gemm_phase<pg8::EpiProj, pg8::StaticOrder, true, true>((PG8_LAS unsigned char*)lds, g, S, E); }
#if REP_P1 > 1
        { pg8::Gemm g{XB, WIN, M, NINP, 1024}; pg8::StaticOrder S; S.init(M, NINP, G, bx);
          pg8::EpiProj E{SBQ, SBK, SBV, GATE, CQ, CKV, MK, RQSS, RKVSS, RPRE, CS};
          pg8::gemm_phase<pg8::EpiProj, pg8::StaticOrder, true, true>((PG8_LAS unsigned char*)lds, g, S, E); }
#endif
        { pg8::Gemm g{PB, WPLE, M, 1024, opq(256)}; pg8::StaticOrder S; S.init(M, 1024, G, bx);
          pg8::EpiStat E{PLEB, PSS};
          pg8::gemm_phase<pg8::EpiStat, pg8::StaticOrder, true, true>((PG8_LAS unsigned char*)lds, g, S, E); }
#if REP_MISC > 1
        { pg8::Gemm g{PB, WPLE, M, 1024, opq(256)}; pg8::StaticOrder S; S.init(M, 1024, G, bx);
          pg8::EpiStat E{PLEB, PSS};
          pg8::gemm_phase<pg8::EpiStat, pg8::StaticOrder, true, true>((PG8_LAS unsigned char*)lds, g, S, E); }
#endif
    }
    SEAM(1);

    if (IN(2)) {
        { pg8::Gemm g{CQ, WUQ, M, 768, opq(256)}; pg8::StaticOrder S; S.init(M, 768, G, bx);
          pg8::EpiQ E{MQ, RQSS, CS};
          pg8::gemm_phase<pg8::EpiQ, pg8::StaticOrder, true, true>((PG8_LAS unsigned char*)lds, g, S, E); }
        { pg8::Gemm g{CKV, WUKV, M, 1024, opq(256)}; pg8::StaticOrder S; S.init(M, 1024, G, bx);
          pg8::EpiKV E{MK, MV, RKVSS};
          pg8::gemm_phase<pg8::EpiKV, pg8::StaticOrder, true, true>((PG8_LAS unsigned char*)lds, g, S, E); }
#if REP_MISC > 1
        { pg8::Gemm g{CQ, WUQ, M, 768, opq(256)}; pg8::StaticOrder S; S.init(M, 768, G, bx);
          pg8::EpiQ E{MQ, RQSS, CS};
          pg8::gemm_phase<pg8::EpiQ, pg8::StaticOrder, true, true>((PG8_LAS unsigned char*)lds, g, S, E); }
        { pg8::Gemm g{CKV, WUKV, M, 1024, opq(256)}; pg8::StaticOrder S; S.init(M, 1024, G, bx);
          pg8::EpiKV E{MK, MV, RKVSS};
          pg8::gemm_phase<pg8::EpiKV, pg8::StaticOrder, true, true>((PG8_LAS unsigned char*)lds, g, S, E); }
#endif
    }
    SEAM(2);

    if (IN(3)) {
        __attribute__((address_space(3))) char* shm = (__attribute__((address_space(3))) char*)lds;
        for (int rep = 0; rep < REP_MLA; ++rep)
        for (int idx = vcu; idx < 1024; idx += G) {
            const int j = idx >> 8, v = idx & 255, bh = v >> 2, s = v & 3;
            const int qb = (j == 0) ? 15 - s : (j == 1) ? s : (j == 2) ? 8 + s : 7 - s;
            att::mla_unit(bh >> 3, bh & 7, qb, MQ, MK, MV, GATE, g_mla, MIX, 512, shm);
        }
        for (int rep = 0; rep < REP_SB; ++rep)
        for (int idx = vcu; idx < 1024; idx += G) {
            const int bh = idx >> 4, qb = idx & 15;
            att::attn_unit<true>(bh >> 3, bh & 7, qb, SBQ, SBK, SBV, GATE, g_sb, MIX, 0, shm);
        }
    }
    SEAM(3);
    for (int rs_ = 0; rs_ < REP_SYNC; ++rs_) xcd_barrier(bar);

    if (IN(4)) {
        {
        pg8::Gemm g{MIX, WOUT, M, 1024, 1024}; pg8::StaticOrder S; S.init(M, 1024, G, bx);
        pg8::EpiStat E{YB, YSS};
        pg8::gemm_phase<pg8::EpiStat, pg8::StaticOrder, true, true>((PG8_LAS unsigned char*)lds, g, S, E);
        }
#if REP_TAIL > 1
        {
        pg8::Gemm g{MIX, WOUT, M, 1024, 1024}; pg8::StaticOrder S; S.init(M, 1024, G, bx);
        pg8::EpiStat E{YB, YSS};
        pg8::gemm_phase<pg8::EpiStat, pg8::StaticOrder, true, true>((PG8_LAS unsigned char*)lds, g, S, E);
        }
#endif
    }
    SEAM(4);

    if (IN(5)) {
        for (int rep = 0; rep < REP_TAIL; ++rep)
        for (int m = gw; m < M; m += NGW) {
            float sv = (lane < 16) ? YSS[(size_t)m * 16 + lane] : ((lane < 32) ? PSS[(size_t)m * 16 + lane - 16] : 0.f);
            sv += __shfl_xor(sv, 1); sv += __shfl_xor(sv, 2); sv += __shfl_xor(sv, 4); sv += __shfl_xor(sv, 8);
            const float sy = __shfl(sv, 0), sp = __shfl(sv, 16);
            const float ry = 1.0f / sqrtf(sy * (1.0f / 1024.0f) + 1e-6f), rp = 1.0f / sqrtf(sp * (1.0f / 1024.0f) + 1e-6f);
            if (lane == 0) { RY[m] = ry; RP[m] = rp; }
            const f32x4* xr = (const f32x4*)(x + (size_t)m * D) + lane; const v2u* yr = (const v2u*)(YB + (size_t)m * D) + lane; const f32x4* gr = (const f32x4*)g_post + lane;
            v2u* o8 = (v2u*)(X1B + (size_t)m * D) + lane;
#pragma unroll
            for (int j = 0; j < 4; ++j) { const f32x4 xv = xr[64 * j], gv = gr[64 * j]; const v2u yw = yr[64 * j];
                const float y0 = __uint_as_float(yw.x << 16), y1 = __uint_as_float(yw.x & 0xffff0000u), y2 = __uint_as_float(yw.y << 16), y3 = __uint_as_float(yw.y & 0xffff0000u);
                o8[64 * j] = (v2u){pk2(xv[0] + y0 * ry * gv[0], xv[1] + y1 * ry * gv[1]), pk2(xv[2] + y2 * ry * gv[2], xv[3] + y3 * ry * gv[3])}; }
        }
    }
    SEAM(5);

    if (IN(6)) {
        {
        pg8::Gemm g{X1B, WPG, M, 1024, 1024}; pg8::StaticOrder S; S.init(M, 1024, G, bx);
        pg8::EpiFinal E{x, YB, PLEB, RY, RP, g_post, g_ple, b_pg, args.out};
        pg8::gemm_phase<pg8::EpiFinal, pg8::StaticOrder, true, true>((PG8_LAS unsigned char*)lds, g, S, E);
        }
#if REP_TAIL > 1
        {
        pg8::Gemm g{X1B, WPG, M, 1024, 1024}; pg8::StaticOrder S; S.init(M, 1024, G, bx);
        pg8::EpiFinal E{x, YB, PLEB, RY, RP, g_post, g_ple, b_pg, args.out};
        pg8::gemm_phase<pg8::EpiFinal, pg8::StaticOrder, true, true>((PG8_LAS unsigned char*)lds, g, S, E);
        }
#endif
    }
#undef IN
#undef SEAM
}

extern "C" void kernel_launch(void* const* d_in, const int* in_sizes, int n_in, void* d_out, int out_size, void* d_ws, size_t ws_size, hipStream_t stream) {
    static int grid = 0;
    if (grid == 0) {
        if (n_in != 17 || out_size != M * D || ws_size < WS_END) { fprintf(stderr, "kernel_launch: unexpected shapes (n_in %d, out %d, ws %zu); nothing launched\n", n_in, out_size, ws_size); grid = -1; return; }
        int dev = 0, cus = 0, per_cu = 0;
        if (hipGetDevice(&dev) != hipSuccess || hipDeviceGetAttribute(&cus, hipDeviceAttributeMultiprocessorCount, dev) != hipSuccess) { grid = -1; return; }
        if (hipFuncSetAttribute((const void*)fwd_kernel, hipFuncAttributeMaxDynamicSharedMemorySize, LDS_BYTES) != hipSuccess) { fprintf(stderr, "kernel_launch: hipFuncSetAttribute failed\n"); grid = -1; return; }
        if (hipOccupancyMaxActiveBlocksPerMultiprocessor(&per_cu, (const void*)fwd_kernel, NWAVES * 64, LDS_BYTES) != hipSuccess || per_cu < 1) { fprintf(stderr, "kernel_launch: occupancy query says %d blocks per CU\n", per_cu); per_cu = 1; }
        (void)hipGetLastError();
        grid = cus * 1;
    }
    if (grid < 0) return;
    if (hipMemsetAsync((char*)d_ws + WS_CTL, 0, CTL_ZERO_BYTES, stream) != hipSuccess) { fprintf(stderr, "kernel_launch: hipMemsetAsync failed\n"); return; }
    Args a{};
    for (int i = 0; i < 17; ++i) a.in[i] = (const float*)d_in[i];
    a.pos = (const int*)d_in[2]; a.out = (float*)d_out; a.ws = (unsigned char*)d_ws;
#if MK_N_LAUNCHES == 1
    a.ph_lo = 0; a.ph_hi = N_PHASES;
    void* kargs[] = {&a};
    hipError_t e = hipLaunchCooperativeKernel((const void*)fwd_kernel, dim3(grid), dim3(NWAVES * 64), kargs, LDS_BYTES, stream);
    if (e != hipSuccess) fprintf(stderr, "kernel_launch: cooperative launch failed: %s (grid %d)\n", hipGetErrorString(e), grid);
#else
    for (int li = 0; li < N_PHASES; ++li) { a.ph_lo = li; a.ph_hi = li + 1; hipLaunchKernelGGL(fwd_kernel, dim3(grid), dim3(NWAVES * 64), LDS_BYTES, stream, a); }
#endif
}
```

```cpp
#include <hip/hip_runtime.h>
#include <cstdio>
#include <cstdint>
#include <cmath>
namespace pg8 {
#define PG8_LAS __attribute__((address_space(3)))
typedef unsigned short bf16_t;
typedef short bf16x8 __attribute__((ext_vector_type(8)));
typedef float f32x4 __attribute__((ext_vector_type(4)));
typedef unsigned u32x4 __attribute__((ext_vector_type(4)));
constexpr int BM = 256, BK = 64, HALF = 128, HTB = HALF * BK * 2  , STAGE_BYTES = 8 * HTB, NXCD = 8, WGM = 8;

__host__ __device__ __forceinline__ int lds_byte(int r, int c) { const int st = (r >> 4) * 2 + (c >> 5), rr = r & 15, cc = c & 31, ob = rr * 64 + cc * 2; return st * 1024 + (ob ^ (((ob >> 9) & 1) << 5)); }
__host__ __device__ __forceinline__ void stage_rc(int b, int& R, int& C) { const int st = b / 1024, sb = b % 1024, swz = sb ^ (((sb >> 9) & 1) << 5); R = (st >> 1) * 16 + swz / 64; C = (st & 1) * 32 + (swz % 64) / 2; }
__host__ __device__ __forceinline__ int perm32(int rho) { const int n = rho >> 4, i = rho & 15; return 8 * (i >> 2) + 4 * n + (i & 3); }

struct Unit { int pm, pn; };
struct Gemm { const bf16_t* A; const bf16_t* Bt; int M, N, K; };

struct StaticOrder {
    int nM, nN, nwg, G, c;
    __host__ __device__ void init(int M, int N, int G_, int c_) { nM = M / BM; nN = N / BM; nwg = nM * nN; G = G_; c = c_; }
    __host__ __device__ bool next(int i, Unit& u) const {
        const long L = (long)i * G + c; if (L >= nwg) return false;
        int wgid = (int)L; { const int q = nwg / NXCD, r = nwg % NXCD, xcd = wgid % NXCD, off = wgid / NXCD; wgid = (xcd < r ? xcd * (q + 1) : r * (q + 1) + (xcd - r) * q) + off; }
        const int nig = WGM * nN, gid = wgid / nig, fm = gid * WGM, gsz = (nM - fm) < WGM ? (nM - fm) : WGM;
        u.pm = fm + ((wgid % nig) % gsz); u.pn = (wgid % nig) / gsz; return true;
    }
    __device__ __forceinline__ void a_ready(const Unit&) const {}
    __device__ __forceinline__ void done(const Unit&) const {}
};

__device__ __forceinline__ unsigned cvt_pk_bf16(float lo, float hi) { unsigned r; asm volatile("v_cvt_pk_bf16_f32 %0, %1, %2" : "=v"(r) : "v"(lo), "v"(hi)); return r; }
typedef float f32x2 __attribute__((ext_vector_type(2)));
typedef unsigned u32x2 __attribute__((ext_vector_type(2)));
constexpr float kLog2e = 1.4426950408889634f;
constexpr float kEps = 1e-6f;
constexpr float QS_SB = 0.125f * kLog2e;
constexpr float QS_MLA = 0.10206207261596577f * kLog2e;
__device__ __forceinline__ u32x2 pack4(f32x4 v) { u32x2 w; w.x = cvt_pk_bf16(v[0], v[1]); w.y = cvt_pk_bf16(v[2], v[3]); return w; }
__device__ __forceinline__ float sigmoid_f(float v) { return __builtin_amdgcn_rcpf(1.0f + __builtin_amdgcn_exp2f(-kLog2e * v)); }
__device__ __forceinline__ f32x4 silu4(f32x4 v) { f32x4 o; o[0] = v[0] * sigmoid_f(v[0]); o[1] = v[1] * sigmoid_f(v[1]); o[2] = v[2] * sigmoid_f(v[2]); o[3] = v[3] * sigmoid_f(v[3]); return o; }
__device__ __forceinline__ f32x4 unpack4(u32x2 w) { f32x4 o; o[0] = __uint_as_float(w.x << 16); o[1] = __uint_as_float(w.x & 0xffff0000u); o[2] = __uint_as_float(w.y << 16); o[3] = __uint_as_float(w.y & 0xffff0000u); return o; }
__device__ __forceinline__ float sumsq4(f32x4 v) { return (v[0] * v[0] + v[1] * v[1]) + (v[2] * v[2] + v[3] * v[3]); }
__device__ __forceinline__ void rope4(f32x4& x1, f32x4& x2, const float* cs, int fq) {
    const f32x4 c01 = *(const f32x4*)(cs + 8 * fq), c23 = *(const f32x4*)(cs + 8 * fq + 4);
    const f32x4 co = {c01[0], c01[2], c23[0], c23[2]}, si = {c01[1], c01[3], c23[1], c23[3]};
    const f32x4 a = x1 * co - x2 * si, b = x2 * co + x1 * si;
    x1 = a; x2 = b;
}

struct EpiProj {
    static constexpr bool PERM = false, AFTER_DRAIN = false;
    bf16_t *SBQ, *SBK, *SBV, *GATE, *CQ, *CKV, *MK; float *RQSS, *RKVSS; const float* rpre; const float* cs;
    __device__ __forceinline__ void operator()(const f32x4 (&acc)[2][2][4][2], const Unit& u, int wr, int wc, int fr, int fq) const {
        const int pn = u.pn;
#pragma unroll
        for (int ai = 0; ai < 2; ++ai)
#pragma unroll
            for (int m = 0; m < 4; ++m) {
                const int row = u.pm * BM + ai * HALF + wr * 64 + m * 16 + fr;
                const float rs = rpre[row];
                f32x4 v[2][2];
#pragma unroll
                for (int bj = 0; bj < 2; ++bj)
#pragma unroll
                    for (int n = 0; n < 2; ++n) v[bj][n] = acc[ai][bj][m][n] * rs;
                const int cw = wc * 32 + fq * 4;
                if (pn < 6) {
                    bf16_t* dst = SBQ + (size_t)(pn >> 1) * (size_t)(16u << 20) + (size_t)row * 512 + (pn & 1) * 256 + cw;
                    const float sc = pn < 2 ? QS_SB : 1.0f;
#pragma unroll
                    for (int bj = 0; bj < 2; ++bj)
#pragma unroll
                        for (int n = 0; n < 2; ++n) *(u32x2*)(dst + bj * HALF + n * 16) = pack4(v[bj][n] * sc);
                } else if (pn < 8) {
                    bf16_t* dst = GATE + (size_t)row * 1024 + (pn - 6) * 256 + cw;
#pragma unroll
                    for (int bj = 0; bj < 2; ++bj)
#pragma unroll
                        for (int n = 0; n < 2; ++n) *(u32x2*)(dst + bj * HALF + n * 16) = pack4(silu4(v[bj][n]));
                } else if (pn == 8) {
                    bf16_t* dst = CQ + (size_t)row * 256 + cw; float ss = 0.f;
#pragma unroll
                    for (int bj = 0; bj < 2; ++bj)
#pragma unroll
                        for (int n = 0; n < 2; ++n) { *(u32x2*)(dst + bj * HALF + n * 16) = pack4(v[bj][n]); ss += sumsq4(v[bj][n]); }
                    ss += __shfl_xor(ss, 16); ss += __shfl_xor(ss, 32);
                    if (fq == 0) RQSS[(size_t)row * 4 + wc] = ss;
                } else if (pn == 9) {
                    bf16_t* dst = CKV + (size_t)row * 256 + cw; float ss = 0.f;
#pragma unroll
                    for (int n = 0; n < 2; ++n) { *(u32x2*)(dst + n * 16) = pack4(v[0][n]); *(u32x2*)(dst + HALF + n * 16) = (u32x2){0u, 0u}; ss += sumsq4(v[0][n]); }
                    ss += __shfl_xor(ss, 16); ss += __shfl_xor(ss, 32);
                    if (fq == 0) RKVSS[(size_t)row * 4 + wc] = ss;
                    if (wc == 0) {
                        f32x4 x1 = v[1][0], x2 = v[1][1]; rope4(x1, x2, cs + (size_t)row * 32, fq);
                        const u32x2 w1 = pack4(x1), w2 = pack4(x2);
                        bf16_t* kd = MK + (size_t)row * 768 + 64 + fq * 4;
#pragma unroll
                        for (int h = 0; h < 8; ++h) { *(u32x2*)(kd + h * 96) = w1; *(u32x2*)(kd + h * 96 + 16) = w2; }
                    } else {
                        bf16_t* gd = GATE + (size_t)row * 1024 + 512 + (wc - 1) * 32 + fq * 4;
#pragma unroll
                        for (int n = 0; n < 2; ++n) *(u32x2*)(gd + n * 16) = pack4(silu4(v[1][n]));
                    }
                } else {
                    const int base = 96 + (pn - 10) * 256 + cw;
#pragma unroll
                    for (int bj = 0; bj < 2; ++bj)
#pragma unroll
                        for (int n = 0; n < 2; ++n) { const int idx = base + bj * HALF + n * 16; if (idx < 512) *(u32x2*)(GATE + (size_t)row * 1024 + 512 + idx) = pack4(silu4(v[bj][n])); }
                }
            }
    }
};
struct EpiQ {
    static constexpr bool PERM = false, AFTER_DRAIN = false;
    bf16_t* MQ; const float* RQSS; const float* cs;
    __device__ __forceinline__ void operator()(const f32x4 (&acc)[2][2][4][2], const Unit& u, int wr, int wc, int fr, int fq) const {
#pragma unroll
        for (int ai = 0; ai < 2; ++ai)
#pragma unroll
            for (int m = 0; m < 4; ++m) {
                const int row = u.pm * BM + ai * HALF + wr * 64 + m * 16 + fr;
                const f32x4 s4 = *(const f32x4*)(RQSS + (size_t)row * 4);
                const float rs = QS_MLA * __builtin_amdgcn_rsqf(((s4[0] + s4[1]) + (s4[2] + s4[3])) * (1.0f / 256.0f) + kEps);
#pragma unroll
                for (int bj = 0; bj < 2; ++bj) {
                    const int g = u.pn * 8 + bj * 4 + wc;
                    f32x4 x1 = acc[ai][bj][m][0] * rs, x2 = acc[ai][bj][m][1] * rs;
                    if (g % 3 == 2) rope4(x1, x2, cs + (size_t)row * 32, fq);
                    bf16_t* dst = MQ + (size_t)row * 768 + g * 32 + fq * 4;
                    *(u32x2*)dst = pack4(x1); *(u32x2*)(dst + 16) = pack4(x2);
                }
            }
    }
};
struct EpiKV {
    static constexpr bool PERM = false, AFTER_DRAIN = false;
    bf16_t *MK, *MV; const float* RKVSS;
    __device__ __forceinline__ void operator()(const f32x4 (&acc)[2][2][4][2], const Unit& u, int wr, int wc, int fr, int fq) const {
#pragma unroll
        for (int ai = 0; ai < 2; ++ai)
#pragma unroll
            for (int m = 0; m < 4; ++m) {
                const int row = u.pm * BM + ai * HALF + wr * 64 + m * 16 + fr;
                const f32x4 s4 = *(const f32x4*)(RKVSS + (size_t)row * 4);
                const float rs = __builtin_amdgcn_rsqf(((s4[0] + s4[1]) + (s4[2] + s4[3])) * (1.0f / 128.0f) + kEps);
#pragma unroll
                for (int bj = 0; bj < 2; ++bj) {
                    const int h = u.pn * 2 + bj;
                    bf16_t* dst = (wc < 2) ? (MK + (size_t)row * 768 + h * 96 + wc * 32 + fq * 4) : (MV + (size_t)row * 512 + h * 64 + (wc - 2) * 32 + fq * 4);
#pragma unroll
                    for (int n = 0; n < 2; ++n) *(u32x2*)(dst + n * 16) = pack4(acc[ai][bj][m][n] * rs);
                }
            }
    }
};
struct EpiStat {
    static constexpr bool PERM = false, AFTER_DRAIN = false;
    bf16_t* OUT; float* SS;
    __device__ __forceinline__ void operator()(const f32x4 (&acc)[2][2][4][2], const Unit& u, int wr, int wc, int fr, int fq) const {
#pragma unroll
        for (int ai = 0; ai < 2; ++ai)
#pragma unroll
            for (int m = 0; m < 4; ++m) {
                const int row = u.pm * BM + ai * HALF + wr * 64 + m * 16 + fr;
                bf16_t* dst = OUT + (size_t)row * 1024 + u.pn * BM + wc * 32 + fq * 4; float ss = 0.f;
#pragma unroll
                for (int bj = 0; bj < 2; ++bj)
#pragma unroll
                    for (int n = 0; n < 2; ++n) { *(u32x2*)(dst + bj * HALF + n * 16) = pack4(acc[ai][bj][m][n]); ss += sumsq4(acc[ai][bj][m][n]); }
                ss += __shfl_xor(ss, 16); ss += __shfl_xor(ss, 32);
                if (fq == 0) SS[(size_t)row * 16 + u.pn * 4 + wc] = ss;
            }
    }
};
struct EpiFinal {
    static constexpr bool PERM = false, AFTER_DRAIN = false;
    const float* x; const bf16_t* Y; const bf16_t* PLE; const float* RY; const float* RP; const float* gpost; const float* gple; const float* bias; float* out;
    __device__ __forceinline__ void operator()(const f32x4 (&acc)[2][2][4][2], const Unit& u, int wr, int wc, int fr, int fq) const {
#pragma unroll
        for (int ai = 0; ai < 2; ++ai)
#pragma unroll
            for (int m = 0; m < 4; ++m) {
                const int row = u.pm * BM + ai * HALF + wr * 64 + m * 16 + fr;
                const float ry = RY[row], rp = RP[row];
#pragma unroll
                for (int bj = 0; bj < 2; ++bj)
#pragma unroll
                    for (int n = 0; n < 2; ++n) {
                        const int col = u.pn * BM + bj * HALF + wc * 32 + n * 16 + fq * 4; const size_t off = (size_t)row * 1024 + col;
                        const f32x4 gp = *(const f32x4*)(gpost + col), gl = *(const f32x4*)(gple + col), bb = *(const f32x4*)(bias + col);
                        const f32x4 xv = *(const f32x4*)(x + off); const f32x4 yv = unpack4(*(const u32x2*)(Y + off)), pv = unpack4(*(const u32x2*)(PLE + off));
                        const f32x4 gt = acc[ai][bj][m][n] + bb; f32x4 o;
#pragma unroll
                        for (int e = 0; e < 4; ++e) o[e] = (xv[e] + yv[e] * ry * gp[e]) + pv[e] * rp * gl[e] * sigmoid_f(gt[e]);
                        *(f32x4*)(out + off) = o;
                    }
            }
    }
};
template <class Epi, class Sched, bool ALIGN_EPI = false, bool SP2 = false>
__device__ __forceinline__ void gemm_phase(PG8_LAS unsigned char* lds, const Gemm g, const Sched& S, const Epi& E) {
    const int tid = threadIdx.x, wid = __builtin_amdgcn_readfirstlane(tid >> 6), lane = tid & 63, wr = wid >> 2, wc = wid & 3, fr = lane & 15, fq = lane >> 4;
    const int K = g.K, nt = K / BK;
    unsigned voffA[2], voffB[2];
#pragma unroll
    for (int i = 0; i < 2; ++i) { int R, C; stage_rc(tid * 16 + i * 8192, R, C); const int Rb = Epi::PERM ? ((R & ~31) + perm32(R & 31)) : R;
        voffA[i] = (unsigned)(R * K + C) * 2u; voffB[i] = (unsigned)(Rb * K + C) * 2u; }
    const size_t kstep = (size_t)(BK * 2);
    const size_t hstep = (size_t)HALF * K * 2;
    const size_t tstep = 2 * hstep;
    const unsigned ldsw = (unsigned)wid * 1024u;
    const int aoff = lds_byte(wr * 64 + fr, fq * 8), boff = lds_byte(wc * 32 + fr, fq * 8);
#define PG8_SA(b, h) (((b) * 2 + (h)) * HTB)
#define PG8_SB(b, h) ((4 + (b) * 2 + (h)) * HTB)
#define PG8_STAGE(bufoff, gbase, voff) do { _Pragma("unroll") for (int _i = 0; _i < 2; ++_i) \
        __builtin_amdgcn_global_load_lds((const unsigned*)((const char*)(gbase) + (voff)[_i]), (PG8_LAS unsigned*)(lds + (bufoff) + ldsw + _i * 8192), 16, 0, 0); } while (0)
#define PG8_LDA(dst, b, h) do { _Pragma("unroll") for (int m = 0; m < 4; ++m) _Pragma("unroll") for (int k = 0; k < 2; ++k) dst[m][k] = *(const PG8_LAS bf16x8*)(lds + PG8_SA(b, h) + aoff + m * 2048 + k * 1024); } while (0)
#define PG8_LDB(dst, b, h) do { _Pragma("unroll") for (int n = 0; n < 2; ++n) _Pragma("unroll") for (int k = 0; k < 2; ++k) dst[n][k] = *(const PG8_LAS bf16x8*)(lds + PG8_SB(b, h) + boff + n * 2048 + k * 1024); } while (0)
#define PG8_MMA(ai, bj, At, Bt) do { __builtin_amdgcn_s_setprio(1); _Pragma("unroll") for (int m = 0; m < 4; ++m) _Pragma("unroll") for (int n = 0; n < 2; ++n) _Pragma("unroll") for (int k = 0; k < 2; ++k) \
        acc[ai][bj][m][n] = __builtin_amdgcn_mfma_f32_16x16x32_bf16(Bt[n][k], At[m][k], acc[ai][bj][m][n], 0, 0, 0); __builtin_amdgcn_s_setprio(0); } while (0)
#define PG8_WAIT_V(n) asm volatile("s_waitcnt vmcnt(" #n ")" ::: "memory")
#define PG8_WAIT_L(n) asm volatile("s_waitcnt lgkmcnt(" #n ")" ::: "memory")
#define PG8_BAR __builtin_amdgcn_s_barrier()
#define PG8_SCHED __builtin_amdgcn_sched_barrier(0)
    Unit cur, nxt; int ui = 0;
    if (!S.next(0, cur)) return;
    f32x4 acc[2][2][4][2];
#pragma unroll
    for (int a = 0; a < 2; ++a)
#pragma unroll
        for (int b = 0; b < 2; ++b)
#pragma unroll
            for (int m = 0; m < 4; ++m)
#pragma unroll
                for (int n = 0; n < 2; ++n) acc[a][b][m][n] = (f32x4){0.f, 0.f, 0.f, 0.f};
    bf16x8 At[4][2], B0[2][2], B1[2][2];
    const char* cA = (const char*)g.A + (size_t)cur.pm * tstep; const char* cB = (const char*)g.Bt + (size_t)cur.pn * tstep;
    S.a_ready(cur);
    if constexpr (SP2) {
        PG8_STAGE(PG8_SB(0, 0), cB, voffB); PG8_STAGE(PG8_SB(0, 1), cB + hstep, voffB); PG8_STAGE(PG8_SA(0, 0), cA, voffA); PG8_STAGE(PG8_SA(0, 1), cA + hstep, voffA);
        if (wr == 1) PG8_BAR;
        PG8_WAIT_V(2); PG8_BAR;
        PG8_STAGE(PG8_SB(1, 0), cB + kstep, voffB); PG8_STAGE(PG8_SA(1, 0), cA + kstep, voffA); PG8_STAGE(PG8_SB(1, 1), cB + hstep + kstep, voffB);
        PG8_WAIT_V(6); PG8_BAR;
    } else {
        PG8_STAGE(PG8_SB(0, 0), cB, voffB); PG8_STAGE(PG8_SA(0, 0), cA, voffA); PG8_STAGE(PG8_SB(0, 1), cB + hstep, voffB); PG8_STAGE(PG8_SA(0, 1), cA + hstep, voffA);
        if (wr == 1) PG8_BAR;
        PG8_WAIT_V(4); PG8_BAR;
        PG8_STAGE(PG8_SB(1, 0), cB + kstep, voffB); PG8_STAGE(PG8_SA(1, 0), cA + kstep, voffA); PG8_STAGE(PG8_SB(1, 1), cB + hstep + kstep, voffB);
        PG8_WAIT_V(6); PG8_BAR;
    }
    for (;;) {
        const bool has_next = S.next(ui + 1, nxt);
        const char* nA = has_next ? (const char*)g.A + (size_t)nxt.pm * tstep : cA; const char* nB = has_next ? (const char*)g.Bt + (size_t)nxt.pn * tstep : cB;
        for (int t = 0; t < nt; t += 2) {
            const bool last = (t == nt - 2);
            const char* a1 = cA + (size_t)(t + 1) * kstep;
            const char* a2 = last ? nA : cA + (size_t)(t + 2) * kstep; const char* b2 = last ? nB : cB + (size_t)(t + 2) * kstep;
            const char* a3 = a2 + kstep; const char* b3 = b2 + kstep;
            if (last && has_next) S.a_ready(nxt);
            if constexpr (SP2) {
            PG8_LDB(B0, 0, 0); PG8_LDB(B1, 0, 1); PG8_SCHED; PG8_LDA(At, 0, 0); PG8_STAGE(PG8_SA(1, 1), a1 + hstep, voffA);
            PG8_WAIT_V(8); PG8_WAIT_L(0); PG8_BAR; PG8_MMA(0, 0, At, B0); PG8_MMA(0, 1, At, B1); PG8_BAR; PG8_SCHED;
            PG8_LDA(At, 0, 1); PG8_STAGE(PG8_SB(0, 0), b2, voffB); PG8_STAGE(PG8_SB(0, 1), b2 + hstep, voffB); PG8_STAGE(PG8_SA(0, 0), a2, voffA);
            PG8_WAIT_V(8); PG8_WAIT_L(0); PG8_BAR; PG8_MMA(1, 0, At, B0); PG8_MMA(1, 1, At, B1); PG8_BAR; PG8_SCHED;
            PG8_LDB(B0, 1, 0); PG8_LDB(B1, 1, 1); PG8_SCHED; PG8_LDA(At, 1, 0); PG8_STAGE(PG8_SA(0, 1), a2 + hstep, voffA);
            PG8_WAIT_V(8); PG8_WAIT_L(0); PG8_BAR; PG8_MMA(0, 0, At, B0); PG8_MMA(0, 1, At, B1); PG8_BAR; PG8_SCHED;
            PG8_LDA(At, 1, 1); PG8_STAGE(PG8_SB(1, 0), b3, voffB); PG8_STAGE(PG8_SB(1, 1), b3 + hstep, voffB); PG8_STAGE(PG8_SA(1, 0), a3, voffA);
            PG8_WAIT_V(8); PG8_WAIT_L(0); PG8_BAR; PG8_MMA(1, 0, At, B0); PG8_MMA(1, 1, At, B1); PG8_BAR; PG8_SCHED;
            } else {
            PG8_LDB(B0, 0, 0); PG8_SCHED; PG8_LDA(At, 0, 0); PG8_STAGE(PG8_SA(1, 1), a1 + hstep, voffA);
            PG8_WAIT_L(8); PG8_BAR; PG8_WAIT_L(0); PG8_MMA(0, 0, At, B0); PG8_BAR; PG8_SCHED;
            PG8_LDB(B1, 0, 1); PG8_STAGE(PG8_SB(0, 0), b2, voffB);
            PG8_BAR; PG8_WAIT_L(0); PG8_MMA(0, 1, At, B1); PG8_BAR;
            PG8_LDA(At, 0, 1); PG8_STAGE(PG8_SA(0, 0), a2, voffA);
            PG8_BAR; PG8_WAIT_L(0); PG8_MMA(1, 0, At, B0); PG8_BAR; PG8_SCHED;
            PG8_STAGE(PG8_SB(0, 1), b2 + hstep, voffB);
            PG8_WAIT_V(6); PG8_BAR; PG8_MMA(1, 1, At, B1); PG8_BAR;
            PG8_LDB(B0, 1, 0); PG8_SCHED; PG8_LDA(At, 1, 0); PG8_STAGE(PG8_SA(0, 1), a2 + hstep, voffA);
            PG8_WAIT_L(8); PG8_BAR; PG8_WAIT_L(0); PG8_MMA(0, 0, At, B0); PG8_BAR; PG8_SCHED;
            PG8_LDB(B1, 1, 1); PG8_STAGE(PG8_SB(1, 0), b3, voffB);
            PG8_BAR; PG8_WAIT_L(0); PG8_MMA(0, 1, At, B1); PG8_BAR;
            PG8_LDA(At, 1, 1); PG8_STAGE(PG8_SA(1, 0), a3, voffA);
            PG8_BAR; PG8_WAIT_L(0); PG8_MMA(1, 0, At, B0); PG8_BAR; PG8_SCHED;
            PG8_STAGE(PG8_SB(1, 1), b3 + hstep, voffB);
            PG8_WAIT_V(6); PG8_BAR; PG8_MMA(1, 1, At, B1); PG8_BAR;
            }
        }
        if constexpr (ALIGN_EPI) { if (wr == 0) PG8_BAR; }
        if constexpr (!Epi::AFTER_DRAIN) { E(acc, cur, wr, wc, fr, fq); S.done(cur); }
        if (!has_next) break;
#pragma unroll
        for (int a = 0; a < 2; ++a)
#pragma unroll
            for (int b = 0; b < 2; ++b)
#pragma unroll
                for (int m = 0; m < 4; ++m)
#pragma unroll
                    for (int n = 0; n < 2; ++n) acc[a][b][m][n] = (f32x4){0.f, 0.f, 0.f, 0.f};
        cur = nxt; cA = nA; cB = nB; ++ui;
        if constexpr (ALIGN_EPI) { if (wr == 1) PG8_BAR; }
    }
    PG8_WAIT_V(0);
    if constexpr (!ALIGN_EPI) { if (wr == 0) PG8_BAR; }
    PG8_BAR;
    if constexpr (Epi::AFTER_DRAIN) { E.fused(acc, cur, wr, wc, fr, fq, lds, wid, lane); S.done(cur); }
#undef PG8_SA
#undef PG8_SB
#undef PG8_STAGE
#undef PG8_LDA
#undef PG8_LDB
#undef PG8_MMA
#undef PG8_WAIT_V
#undef PG8_WAIT_L
#undef PG8_BAR
#undef PG8_SCHED
}
}
namespace att {
using bf16x8 = __attribute__((ext_vector_type(8))) short;
using s16x4 = __attribute__((ext_vector_type(4))) short;
using f32x16 = __attribute__((ext_vector_type(16))) float;
using f32x4 = __attribute__((ext_vector_type(4))) float;
using u32x4 = __attribute__((ext_vector_type(4))) unsigned;
typedef unsigned short bf16_t;
#define ALAS __attribute__((address_space(3)))
constexpr int SEQ = 4096, KSLOT = 16384, VSLOT = 8192, NSLOT = 3;
constexpr int L_K = 0, L_V = NSLOT * KSLOT, L_WS = L_V + NSLOT * VSLOT, L_FLAG = L_WS + 8 * 64 * 4, L_OST = L_FLAG + 256, L_END = L_OST + 8 * 8192;
constexpr float kEps = 1e-6f;
constexpr float SB_DONE = 151.0f;
__device__ __forceinline__ int crow(int r, int hi) { return (r & 3) + 8 * (r >> 2) + 4 * hi; }
__device__ __forceinline__ void glds16(const void* gsrc, unsigned lds_dst) { unsigned keep;
    asm volatile("s_mov_b32 %0, m0\n\ts_mov_b32 m0, %2\n\ts_nop 0\n\tglobal_load_lds_dwordx4 %1, off\n\ts_mov_b32 m0, %0" : "=&s"(keep) : "v"(gsrc), "s"(lds_dst) : "memory"); }
typedef float f32x2_t __attribute__((ext_vector_type(2))); typedef __bf16 bf16x2_t __attribute__((ext_vector_type(2)));
__device__ __forceinline__ unsigned cvtpk(float lo, float hi) { f32x2_t v = {lo, hi}; bf16x2_t b = __builtin_convertvector(v, bf16x2_t); return __builtin_bit_cast(unsigned, b); }
#define A_WAIT_BAR(N) asm volatile("s_waitcnt vmcnt(" #N ") lgkmcnt(0)\n\ts_barrier" ::: "memory")

template <int ND0> __device__ __forceinline__ void qkt(f32x16& p0, f32x16& p1, const ALAS char* Kslot, const bf16x8* qr, int r32, int hi) {
    const ALAS char* kb = Kslot + hi * 1024 + r32 * 16;
    p0 = f32x16{}; p1 = f32x16{};
#pragma unroll
    for (int d0 = 0; d0 < ND0; ++d0) {
        const bf16x8 b0 = *(const ALAS bf16x8*)(kb + d0 * 2048);
        const bf16x8 b1 = *(const ALAS bf16x8*)(kb + d0 * 2048 + 512);
        p0 = __builtin_amdgcn_mfma_f32_32x32x16_bf16(b0, qr[d0], p0, 0, 0, 0);
        p1 = __builtin_amdgcn_mfma_f32_32x32x16_bf16(b1, qr[d0], p1, 0, 0, 0);
    }
}
__device__ __forceinline__ void pv(f32x16* o, int vb, bf16x8 pa0, bf16x8 pa1, bf16x8 pa2, bf16x8 pa3) {
#pragma unroll
    for (int d0 = 0; d0 < 2; ++d0) { s16x4 lo[4], hi[4];
#pragma unroll
        for (int ks = 0; ks < 4; ++ks) {
            asm volatile("ds_read_b64_tr_b16 %0,%1 offset:%c2" : "=&v"(lo[ks]) : "v"(vb), "i"(d0 * 4096 + ks * 1024) : "memory");
            asm volatile("ds_read_b64_tr_b16 %0,%1 offset:%c2" : "=&v"(hi[ks]) : "v"(vb), "i"(d0 * 4096 + ks * 1024 + 512) : "memory"); }
        asm volatile("s_waitcnt lgkmcnt(0)" ::: "memory"); __builtin_amdgcn_sched_barrier(0);
#define A_PK(k) (bf16x8){lo[k][0], lo[k][1], lo[k][2], lo[k][3], hi[k][0], hi[k][1], hi[k][2], hi[k][3]}
        o[d0] = __builtin_amdgcn_mfma_f32_32x32x16_bf16(pa0, A_PK(0), o[d0], 0, 0, 0);
        o[d0] = __builtin_amdgcn_mfma_f32_32x32x16_bf16(pa1, A_PK(1), o[d0], 0, 0, 0);
        o[d0] = __builtin_amdgcn_mfma_f32_32x32x16_bf16(pa2, A_PK(2), o[d0], 0, 0, 0);
        o[d0] = __builtin_amdgcn_mfma_f32_32x32x16_bf16(pa3, A_PK(3), o[d0], 0, 0, 0);
#undef A_PK
    }
}
typedef short v4i16_t __attribute__((ext_vector_type(4)));
__device__ __forceinline__ s16x4 vtr(const ALAS char* p) { return __builtin_bit_cast(s16x4, __builtin_amdgcn_ds_read_tr16_b64_v4i16((ALAS v4i16_t*)p)); }
__device__ __forceinline__ float xhalf_sum(float v) { auto rr = __builtin_amdgcn_permlane32_swap(__float_as_uint(v), __float_as_uint(v), false, false); return __uint_as_float(rr[0]) + __uint_as_float(rr[1]); }
__device__ __forceinline__ float xhalf_max(float v) { auto rr = __builtin_amdgcn_permlane32_swap(__float_as_uint(v), __float_as_uint(v), false, false); return fmaxf(__uint_as_float(rr[0]), __uint_as_float(rr[1])); }

template <bool SBK> __device__ __forceinline__ void attn_unit(int b, int h, int qb, const bf16_t* Q, const bf16_t* K, const bf16_t* V, const bf16_t* gate, const float* gnorm, bf16_t* out, int goff, ALAS char* shm) {
    constexpr int DQK = SBK ? 64 : 96, QP = SBK ? 512 : 768, ND0 = DQK / 16;
    const int tid = threadIdx.x, lane = tid & 63, r32 = lane & 31, hi = lane >> 5; const int wid = __builtin_amdgcn_readfirstlane(tid >> 6);
    const long rowbase = (long)b * SEQ; const int q0 = qb * 256;
    const bf16_t* Qw = Q + (rowbase + q0 + wid * 32) * QP + h * DQK;
    const bf16_t* Kh = K + rowbase * QP + h * DQK; const bf16_t* Vh = V + rowbase * 512 + h * 64;
    const unsigned lds0 = (unsigned)(uintptr_t)shm;
    ALAS float* wsf = (ALAS float*)(shm + L_WS) + wid * 64;
    ALAS unsigned* flags = (ALAS unsigned*)(shm + L_FLAG);
    const bf16_t* ksrc = Kh + (long)lane * QP + wid * 8;
    const bf16_t* ksrc2 = Kh + (long)lane * QP + (8 + (wid & 3)) * 8;
    const bf16_t* vsrc = Vh + (long)(16 * (wid & 3) + (lane >> 2)) * 512 + (wid >> 2) * 32 + (lane & 3) * 8;
    const unsigned kdst = lds0 + L_K + wid * 1024, vdst = lds0 + L_V + wid * 1024;
    const int NT = 4 * qb + 4;
    const int tw = 4 * qb + (wid >> 1);
#define A_TILE(i) (SBK ? (NT - 1 - (i)) : (i))
#define A_DMA(i, s) do { const int t_ = A_TILE(i); glds16(ksrc + (long)t_ * 64 * QP, (unsigned)__builtin_amdgcn_readfirstlane(kdst + (s) * KSLOT)); \
        if (!SBK) glds16(ksrc2 + (long)t_ * 64 * QP, (unsigned)__builtin_amdgcn_readfirstlane(kdst + 8192 + (s) * KSLOT)); \
        glds16(vsrc + (long)t_ * 64 * 512, (unsigned)__builtin_amdgcn_readfirstlane(vdst + (s) * VSLOT)); } while (0)
    A_DMA(0, 0); A_DMA(1, 1);
    bf16x8 qr[ND0];
#pragma unroll
    for (int d0 = 0; d0 < ND0; ++d0) qr[d0] = *(const bf16x8*)(Qw + (long)r32 * QP + d0 * 16 + hi * 8);
    f32x16 o[2]; o[0] = f32x16{}; o[1] = f32x16{};
    float m_run = -INFINITY, l_run = 0.f, carry = 0.f;
    const int vb0 = (int)(lds0 + L_V) + ((lane >> 4) & 1) * 32 + (lane & 3) * 8 + (4 * hi + ((lane & 15) >> 2)) * 64;
    int slot = 0;
    for (int i = 0; i < NT; ++i) {
        if (i + 1 < NT) { if (SBK) { A_WAIT_BAR(2); } else { A_WAIT_BAR(3); } } else { A_WAIT_BAR(0); }
        if (SBK && i > 0) {
            const ALAS unsigned* fl = flags + ((i - 1) & 1) * 8; unsigned all = 1u;
#pragma unroll
            for (int w = 0; w < 8; ++w) all &= fl[w];
            if (all) break;
        }
        if (i + 2 < NT) { const int s2 = (slot >= 1) ? slot - 1 : slot + 2; A_DMA(i + 2, s2); }
        const int t = A_TILE(i);
        if (t <= tw) {
            f32x16 p0, p1;
            qkt<ND0>(p0, p1, shm + L_K + slot * KSLOT, qr, r32, hi);
            if (SBK) {
                if (t == tw) { const int qrel = 32 * (wid & 1) + r32;
#pragma unroll
                    for (int r = 0; r < 16; ++r) { const int kv = crow(r, hi); if (kv >= qrel) p0[r] = -INFINITY; if (kv + 32 >= qrel) p1[r] = -INFINITY; } }
                f32x16 s0, s1;
#pragma unroll
                for (int r = 0; r < 16; ++r) {
                    s0[r] = fmaxf(p0[r], 0.f) + __builtin_amdgcn_logf(1.0f + __builtin_amdgcn_exp2f(-fabsf(p0[r])));
                    s1[r] = fmaxf(p1[r], 0.f) + __builtin_amdgcn_logf(1.0f + __builtin_amdgcn_exp2f(-fabsf(p1[r])));
                }
                float lo_[8], up_[8];
#pragma unroll
                for (int i4 = 0; i4 < 8; ++i4) {
                    const float bs = (i4 < 4) ? ((s0[4 * i4] + s0[4 * i4 + 1]) + (s0[4 * i4 + 2] + s0[4 * i4 + 3])) : ((s1[4 * i4 - 16] + s1[4 * i4 - 15]) + (s1[4 * i4 - 14] + s1[4 * i4 - 13]));
                    auto rr = __builtin_amdgcn_permlane32_swap(__float_as_uint(bs), __float_as_uint(bs), false, false);
                    lo_[i4] = __uint_as_float(rr[0]); up_[i4] = __uint_as_float(rr[1]);
                }
                float run = carry;
#pragma unroll
                for (int i4 = 7; i4 >= 0; --i4) {
                    float c = run + (hi == 0 ? up_[i4] : 0.f);
#pragma unroll
                    for (int e = 3; e >= 0; --e) {
                        if (i4 < 4) { c += s0[4 * i4 + e]; p0[4 * i4 + e] = __builtin_amdgcn_exp2f(p0[4 * i4 + e] - c); }
                        else { c += s1[4 * i4 - 16 + e]; p1[4 * i4 - 16 + e] = __builtin_amdgcn_exp2f(p1[4 * i4 - 16 + e] - c); }
                    }
                    run += lo_[i4] + up_[i4];
                }
                carry = run;
            } else {
                float rm = fmaxf(p0[0], p1[0]);
#pragma unroll
                for (int r = 1; r < 16; ++r) rm = fmaxf(rm, fmaxf(p0[r], p1[r]));
                rm = xhalf_max(rm);
                const float m_new = fmaxf(m_run, rm);
                const float alpha = __builtin_amdgcn_exp2f(m_run - m_new);
                float ls = 0.f;
#pragma unroll
                for (int r = 0; r < 16; ++r) { p0[r] = __builtin_amdgcn_exp2f(p0[r] - m_new); p1[r] = __builtin_amdgcn_exp2f(p1[r] - m_new); ls += p0[r] + p1[r]; }
                l_run = l_run * alpha + ls; m_run = m_new;
                if (!__all(alpha == 1.0f)) {
                    if (hi == 0) wsf[r32] = alpha;
#pragma unroll
                    for (int r = 0; r < 16; ++r) { const float f = wsf[crow(r, hi)]; o[0][r] *= f; o[1][r] *= f; }
                }
            }
            u32x4 pw0, pw1, pw2, pw3;
            pw0 = (u32x4){cvtpk(p0[0], p0[1]), cvtpk(p0[2], p0[3]), cvtpk(p0[4], p0[5]), cvtpk(p0[6], p0[7])};
            pw1 = (u32x4){cvtpk(p0[8], p0[9]), cvtpk(p0[10], p0[11]), cvtpk(p0[12], p0[13]), cvtpk(p0[14], p0[15])};
            pw2 = (u32x4){cvtpk(p1[0], p1[1]), cvtpk(p1[2], p1[3]), cvtpk(p1[4], p1[5]), cvtpk(p1[6], p1[7])};
            pw3 = (u32x4){cvtpk(p1[8], p1[9]), cvtpk(p1[10], p1[11]), cvtpk(p1[12], p1[13]), cvtpk(p1[14], p1[15])};
            pv(o, vb0 + slot * VSLOT, __builtin_bit_cast(bf16x8, pw0), __builtin_bit_cast(bf16x8, pw1), __builtin_bit_cast(bf16x8, pw2), __builtin_bit_cast(bf16x8, pw3));
        }
        if (SBK) { const bool done = (t <= tw) && __all(carry > SB_DONE); if (lane == 0) flags[(i & 1) * 8 + wid] = done ? 1u : 0u; }
        slot = (slot == NSLOT - 1) ? 0 : slot + 1;
    }
    A_WAIT_BAR(0);
    float rli[16];
    if (!SBK) {
        const float lt = xhalf_sum(l_run);
        if (hi == 0) wsf[32 + r32] = lt;
#pragma unroll
        for (int r = 0; r < 16; ++r) rli[r] = __builtin_amdgcn_rcpf(wsf[32 + crow(r, hi)]);
    } else {
#pragma unroll
        for (int r = 0; r < 16; ++r) rli[r] = 1.0f;
    }
    ALAS float* stg = (ALAS float*)(shm + L_OST) + wid * 2048;
#pragma unroll
    for (int r = 0; r < 16; ++r) { const int orow = crow(r, hi);
#pragma unroll
        for (int d0 = 0; d0 < 2; ++d0) stg[orow * 64 + d0 * 32 + r32] = o[d0][r] * rli[r]; }
    const long grow0 = rowbase + q0 + wid * 32;
#pragma unroll
    for (int i = 0; i < 4; ++i) {
        const int row = i * 8 + (lane >> 3), ch = lane & 7;
        const f32x4 a = *(const ALAS f32x4*)(stg + row * 64 + ch * 8), c = *(const ALAS f32x4*)(stg + row * 64 + ch * 8 + 4);
        float ss = ((a[0] * a[0] + a[1] * a[1]) + (a[2] * a[2] + a[3] * a[3])) + ((c[0] * c[0] + c[1] * c[1]) + (c[2] * c[2] + c[3] * c[3]));
        ss += __shfl_xor(ss, 1); ss += __shfl_xor(ss, 2); ss += __shfl_xor(ss, 4);
        const float rn = 1.0f / sqrtf(ss * (1.0f / 64.0f) + kEps);
        const size_t off = (size_t)(grow0 + row) * 1024 + goff + h * 64 + ch * 8;
        const u32x4 gv = *(const u32x4*)(gate + off);
        const f32x4 g0 = *(const f32x4*)(gnorm + h * 64 + ch * 8), g1 = *(const f32x4*)(gnorm + h * 64 + ch * 8 + 4);
        float v[8];
#pragma unroll
        for (int e = 0; e < 4; ++e) { v[e] = a[e] * rn * g0[e]; v[4 + e] = c[e] * rn * g1[e]; }
        u32x4 w;
#pragma unroll
        for (int e = 0; e < 4; ++e) { const unsigned gw = gv[e]; w[e] = cvtpk(v[2 * e] * __uint_as_float(gw << 16), v[2 * e + 1] * __uint_as_float(gw & 0xffff0000u)); }
        *(u32x4*)(out + off) = w;
    }
    A_WAIT_BAR(0);
#undef A_TILE
#undef A_DMA
}

constexpr int M_K = 0, M_V = NSLOT * KSLOT, M_WS = M_V + 4 * VSLOT, M_END = M_WS + 8 * 64 * 4;
constexpr float MLA_THR = 8.0f;
#define A_BAR_L() asm volatile("s_waitcnt lgkmcnt(0)\n\ts_barrier" ::: "memory")
__device__ __forceinline__ void mla_unit(int b, int h, int qb, const bf16_t* Q, const bf16_t* K, const bf16_t* V, const bf16_t* gate, const float* gnorm, bf16_t* out, int goff, ALAS char* shm) {
    constexpr int QP = 768, ND0 = 6;
    const int tid = threadIdx.x, lane = tid & 63, r32 = lane & 31, hi = lane >> 5; const int wid = __builtin_amdgcn_readfirstlane(tid >> 6);
    const int grp = wid >> 2;
    const long rowbase = (long)b * SEQ; const int q0 = qb * 256;
    const bf16_t* Qw = Q + (rowbase + q0 + wid * 32) * QP + h * 96;
    const bf16_t* Kh = K + rowbase * QP + h * 96; const bf16_t* Vh = V + rowbase * 512 + h * 64;
    const unsigned lds0 = (unsigned)(uintptr_t)shm;
    ALAS float* wsf = (ALAS float*)(shm + M_WS) + wid * 64;
    const bf16_t* ksrc = Kh + (long)lane * QP + wid * 8;
    const bf16_t* ksrc2 = Kh + (long)lane * QP + (8 + (wid & 3)) * 8;
    const bf16_t* vsrc = Vh + (long)(16 * (wid & 3) + (lane >> 2)) * 512 + (wid >> 2) * 32 + (lane & 3) * 8;
    const unsigned kdst = lds0 + M_K + wid * 1024, vdst = lds0 + M_V + wid * 1024;
    const int NT = 4 * qb + 4, tw = 4 * qb + (wid >> 1);
#define M_DMA(t_) do { const int tt_ = (t_); const int ks_ = tt_ % 3, vs_ = tt_ & 3; glds16(ksrc + (long)tt_ * 64 * QP, (unsigned)__builtin_amdgcn_readfirstlane(kdst + ks_ * KSLOT)); \
        glds16(ksrc2 + (long)tt_ * 64 * QP, (unsigned)__builtin_amdgcn_readfirstlane(kdst + 8192 + ks_ * KSLOT)); \
        glds16(vsrc + (long)tt_ * 64 * 512, (unsigned)__builtin_amdgcn_readfirstlane(vdst + vs_ * VSLOT)); } while (0)
    M_DMA(0); M_DMA(1);
    bf16x8 qr[ND0];
#pragma unroll
    for (int d0 = 0; d0 < ND0; ++d0) qr[d0] = *(const bf16x8*)(Qw + (long)r32 * QP + d0 * 16 + hi * 8);
    f32x16 o[2]; o[0] = f32x16{}; o[1] = f32x16{};
    f32x16 negm = f32x16{}; f32x16 p0 = f32x16{}, p1 = f32x16{};
    u32x4 pw0 = {0u, 0u, 0u, 0u}, pw1 = pw0, pw2 = pw0, pw3 = pw0;
    float m_hat = 0.f, l_run = 0.f; bool need = false;
    const int vb0 = (int)(lds0 + M_V) + ((lane >> 4) & 1) * 32 + (lane & 3) * 8 + (4 * hi + ((lane & 15) >> 2)) * 64;
    const int voff = ((lane >> 4) & 1) * 32 + (lane & 3) * 8 + (4 * hi + ((lane & 15) >> 2)) * 64;
#define M_BAR_EVEN(t_) do { if ((t_) + 1 < NT) { A_WAIT_BAR(3); } else { A_WAIT_BAR(0); } if ((t_) + 2 < NT) M_DMA((t_) + 2); } while (0)
#define M_KLD(d0) do { kf_[2 * (d0)] = *(const ALAS bf16x8*)(kb_ + (d0) * 2048); kf_[2 * (d0) + 1] = *(const ALAS bf16x8*)(kb_ + (d0) * 2048 + 512); } while (0)
#define M_QK(d0) do { p0 = __builtin_amdgcn_mfma_f32_32x32x16_bf16(kf_[2 * (d0)], qr[d0], (d0) == 0 ? negm : p0, 0, 0, 0); p1 = __builtin_amdgcn_mfma_f32_32x32x16_bf16(kf_[2 * (d0) + 1], qr[d0], (d0) == 0 ? negm : p1, 0, 0, 0); } while (0)
#define M_STAGE_A(t_) do { const int ta_ = (t_); \
        const ALAS char* vp_ = shm + M_V + ((ta_ - 1) & 3) * VSLOT + voff; const ALAS char* kb_ = shm + M_K + (ta_ % 3) * KSLOT + hi * 1024 + r32 * 16; \
        s16x4 vl_[4], vh_[4]; bf16x8 kf_[12]; \
        _Pragma("unroll") for (int ks = 0; ks < 4; ++ks) { vl_[ks] = vtr(vp_ + ks * 1024); vh_[ks] = vtr(vp_ + ks * 1024 + 512); } \
        M_KLD(0); M_KLD(1); \
        __builtin_amdgcn_sched_barrier(0); \
        if (need) { _Pragma("unroll") for (int r = 0; r < 16; ++r) { const float f = wsf[crow(r, hi)]; o[0][r] *= f; o[1][r] *= f; } } \
        _Pragma("unroll") for (int ks = 0; ks < 4; ++ks) o[0] = __builtin_amdgcn_mfma_f32_32x32x16_bf16(M_PA(ks), M_VF(ks), o[0], 0, 0, 0); \
        __builtin_amdgcn_sched_barrier(0); \
        M_KLD(2); M_KLD(3); \
        __builtin_amdgcn_sched_barrier(0); \
        M_QK(0); M_QK(1); \
        __builtin_amdgcn_sched_barrier(0); \
        _Pragma("unroll") for (int ks = 0; ks < 4; ++ks) { vl_[ks] = vtr(vp_ + 4096 + ks * 1024); vh_[ks] = vtr(vp_ + 4096 + ks * 1024 + 512); } \
        M_KLD(4); M_KLD(5); \
        __builtin_amdgcn_sched_barrier(0); \
        M_QK(2); M_QK(3); M_QK(4); M_QK(5); \
        _Pragma("unroll") for (int ks = 0; ks < 4; ++ks) o[1] = __builtin_amdgcn_mfma_f32_32x32x16_bf16(M_PA(ks), M_VF(ks), o[1], 0, 0, 0); } while (0)
      \
#define M_STAGE_A_SW(t_, PVON, QKON) do { const int ta_ = (t_); \
        if (PVON) { \
            if (need) { _Pragma("unroll") for (int r = 0; r < 16; ++r) { const float f = wsf[crow(r, hi)]; o[0][r] *= f; o[1][r] *= f; } } \
            pv(o, vb0 + ((ta_ - 1) & 3) * VSLOT, __builtin_bit_cast(bf16x8, pw0), __builtin_bit_cast(bf16x8, pw1), __builtin_bit_cast(bf16x8, pw2), __builtin_bit_cast(bf16x8, pw3)); } \
        if (QKON) { const ALAS char* kb = shm + M_K + (ta_ % 3) * KSLOT + hi * 1024 + r32 * 16; \
            _Pragma("unroll") for (int d0 = 0; d0 < ND0; ++d0) { \
                const bf16x8 b0 = *(const ALAS bf16x8*)(kb + d0 * 2048); const bf16x8 b1 = *(const ALAS bf16x8*)(kb + d0 * 2048 + 512); \
                p0 = __builtin_amdgcn_mfma_f32_32x32x16_bf16(b0, qr[d0], d0 == 0 ? negm : p0, 0, 0, 0); \
                p1 = __builtin_amdgcn_mfma_f32_32x32x16_bf16(b1, qr[d0], d0 == 0 ? negm : p1, 0, 0, 0); } } } while (0)
#define M_PA(k) ((k) == 0 ? __builtin_bit_cast(bf16x8, pw0) : (k) == 1 ? __builtin_bit_cast(bf16x8, pw1) : (k) == 2 ? __builtin_bit_cast(bf16x8, pw2) : __builtin_bit_cast(bf16x8, pw3))
#define M_VF(i) (bf16x8){vl_[i][0], vl_[i][1], vl_[i][2], vl_[i][3], vh_[i][0], vh_[i][1], vh_[i][2], vh_[i][3]}
#define M_STAGE_B(t_, ON) do { const int tb_ = (t_); if (ON) { \
        float a0 = fmaxf(fmaxf(p0[0], p0[1]), p1[0]), a1 = fmaxf(fmaxf(p0[2], p0[3]), p1[1]); a0 = fmaxf(fmaxf(a0, p1[2]), p1[3]); \
        _Pragma("unroll") for (int r = 4; r < 16; r += 4) { a0 = fmaxf(fmaxf(a0, p0[r]), p0[r + 1]); a1 = fmaxf(fmaxf(a1, p0[r + 2]), p0[r + 3]); a0 = fmaxf(fmaxf(a0, p1[r]), p1[r + 1]); a1 = fmaxf(fmaxf(a1, p1[r + 2]), p1[r + 3]); } \
        const float rm = xhalf_max(fmaxf(a0, a1)); \
        need = false; \
        if (tb_ == 0 || __any(rm > MLA_THR)) { \
            const float dl = (tb_ == 0) ? rm : fmaxf(rm, 0.f); \
            m_hat += dl; \
            _Pragma("unroll") for (int r = 0; r < 16; ++r) { p0[r] -= dl; p1[r] -= dl; } \
            _Pragma("unroll") for (int r = 0; r < 16; ++r) negm[r] = -m_hat; \
            if (tb_ > 0) { const float f = __builtin_amdgcn_exp2f(-dl); l_run *= f; if (hi == 0) wsf[r32] = f; need = true; } } \
        float ls0 = 0.f, ls1 = 0.f; \
        _Pragma("unroll") for (int r = 0; r < 16; ++r) { p0[r] = __builtin_amdgcn_exp2f(p0[r]); p1[r] = __builtin_amdgcn_exp2f(p1[r]); ls0 += p0[r]; ls1 += p1[r]; } \
        l_run += ls0 + ls1; \
        pw0 = (u32x4){cvtpk(p0[0], p0[1]), cvtpk(p0[2], p0[3]), cvtpk(p0[4], p0[5]), cvtpk(p0[6], p0[7])}; \
        pw1 = (u32x4){cvtpk(p0[8], p0[9]), cvtpk(p0[10], p0[11]), cvtpk(p0[12], p0[13]), cvtpk(p0[14], p0[15])}; \
        pw2 = (u32x4){cvtpk(p1[0], p1[1]), cvtpk(p1[2], p1[3]), cvtpk(p1[4], p1[5]), cvtpk(p1[6], p1[7])}; \
        pw3 = (u32x4){cvtpk(p1[8], p1[9]), cvtpk(p1[10], p1[11]), cvtpk(p1[12], p1[13]), cvtpk(p1[14], p1[15])}; } } while (0)
    const int tmain = NT - 4;
    if (grp == 0) {
        M_BAR_EVEN(0); M_STAGE_A_SW(0, false, true); A_BAR_L(); M_STAGE_B(0, true);
        int t = 1;
        for (; t < tmain; ++t) { M_BAR_EVEN(t); M_STAGE_A(t); A_BAR_L(); M_STAGE_B(t, true); }
        for (; t <= NT; ++t) { M_BAR_EVEN(t); M_STAGE_A_SW(t, (t - 1 <= tw), (t < NT && t <= tw)); A_BAR_L(); M_STAGE_B(t, (t < NT && t <= tw)); }
    } else {
        M_BAR_EVEN(0); A_BAR_L(); M_STAGE_A_SW(0, false, true);
        M_BAR_EVEN(1); M_STAGE_B(0, true); A_BAR_L(); M_STAGE_A_SW(1, true, true);
        int t = 2;
        for (; t < tmain; ++t) { M_BAR_EVEN(t); M_STAGE_B(t - 1, true); A_BAR_L(); M_STAGE_A(t); }
        for (; t <= NT; ++t) { M_BAR_EVEN(t); M_STAGE_B(t - 1, (t - 1 <= tw)); A_BAR_L(); M_STAGE_A_SW(t, (t - 1 <= tw), (t < NT && t <= tw)); }
    }
#undef M_BAR_EVEN
#undef M_STAGE_A
#undef M_STAGE_A_SW
#undef M_STAGE_B
#undef M_PA
#undef M_KLD
#undef M_QK
#undef M_VF
    A_WAIT_BAR(0);
    const float lt = xhalf_sum(l_run);
    if (hi == 0) wsf[32 + r32] = lt;
    float rli[16];
#pragma unroll
    for (int r = 0; r < 16; ++r) rli[r] = __builtin_amdgcn_rcpf(wsf[32 + crow(r, hi)]);
    ALAS float* stg = (ALAS float*)shm + wid * 2048;
#pragma unroll
    for (int r = 0; r < 16; ++r) { const int orow = crow(r, hi);
#pragma unroll
        for (int d0 = 0; d0 < 2; ++d0) stg[orow * 64 + d0 * 32 + r32] = o[d0][r] * rli[r]; }
    const long grow0 = rowbase + q0 + wid * 32;
#pragma unroll
    for (int i = 0; i < 4; ++i) {
        const int row = i * 8 + (lane >> 3), ch = lane & 7;
        const f32x4 a = *(const ALAS f32x4*)(stg + row * 64 + ch * 8), c = *(const ALAS f32x4*)(stg + row * 64 + ch * 8 + 4);
        float ss = ((a[0] * a[0] + a[1] * a[1]) + (a[2] * a[2] + a[3] * a[3])) + ((c[0] * c[0] + c[1] * c[1]) + (c[2] * c[2] + c[3] * c[3]));
        ss += __shfl_xor(ss, 1); ss += __shfl_xor(ss, 2); ss += __shfl_xor(ss, 4);
        const float rn = 1.0f / sqrtf(ss * (1.0f / 64.0f) + kEps);
        const size_t off = (size_t)(grow0 + row) * 1024 + goff + h * 64 + ch * 8;
        const u32x4 gv = *(const u32x4*)(gate + off);
        const f32x4 g0 = *(const f32x4*)(gnorm + h * 64 + ch * 8), g1 = *(const f32x4*)(gnorm + h * 64 + ch * 8 + 4);
        float v[8];
#pragma unroll
        for (int e = 0; e < 4; ++e) { v[e] = a[e] * rn * g0[e]; v[4 + e] = c[e] * rn * g1[e]; }
        u32x4 w;
#pragma unroll
        for (int e = 0; e < 4; ++e) { const unsigned gw = gv[e]; w[e] = cvtpk(v[2 * e] * __uint_as_float(gw << 16), v[2 * e + 1] * __uint_as_float(gw & 0xffff0000u)); }
        *(u32x4*)(out + off) = w;
    }
    A_WAIT_BAR(0);
#undef M_DMA
}

constexpr int S_RING = 0, S_FLAG = 131072, S_END = 131072 + 256;
__device__ __forceinline__ void sb_unit(int b, int h, int qb, const bf16_t* Q, const bf16_t* K, const bf16_t* V, const bf16_t* gate, const float* gnorm, bf16_t* out, int goff, ALAS char* shm) {
    constexpr int QP = 512;
    const int tid = threadIdx.x, lane = tid & 63, r32 = lane & 31, hi = lane >> 5; const int wid = __builtin_amdgcn_readfirstlane(tid >> 6);
    const int pair = wid >> 1, e2 = wid & 1;
    const long rowbase = (long)b * SEQ; const int q0 = qb * 256;
    const bf16_t* Qw = Q + (rowbase + q0 + wid * 32) * QP + h * 64;
    const bf16_t* Kh = K + rowbase * QP + h * 64; const bf16_t* Vh = V + rowbase * 512 + h * 64;
    const unsigned lds0 = (unsigned)(uintptr_t)shm;
    ALAS unsigned* flags = (ALAS unsigned*)(shm + S_FLAG);
    const int td = 4 * qb + pair;
    const bf16_t* ksrc = Kh + (long)lane * QP + (4 * e2) * 8;
    const bf16_t* vsrc = Vh + (long)(lane >> 2) * 512 + e2 * 32 + (lane & 3) * 8;
    const unsigned ring = lds0 + S_RING + pair * 32768;
    const unsigned kdst = ring + (4 * e2) * 1024, vdst = ring + 8192 + (4 * e2) * 1024;
#define S_DMA(t_, s_) do { const int tt_ = (t_) < 0 ? 0 : (t_); const unsigned so_ = (unsigned)(s_) * 16384u; \
        _Pragma("unroll") for (int c = 0; c < 4; ++c) glds16(ksrc + (long)tt_ * 64 * QP + c * 8, (unsigned)__builtin_amdgcn_readfirstlane(kdst + so_ + c * 1024)); \
        _Pragma("unroll") for (int c = 0; c < 4; ++c) glds16(vsrc + ((long)tt_ * 64 + 16 * c) * 512, (unsigned)__builtin_amdgcn_readfirstlane(vdst + so_ + c * 1024)); } while (0)
    S_DMA(td, 0);
    bf16x8 qr[4];
#pragma unroll
    for (int d0 = 0; d0 < 4; ++d0) qr[d0] = *(const bf16x8*)(Qw + (long)r32 * QP + d0 * 16 + hi * 8);
    f32x16 o[2]; o[0] = f32x16{}; o[1] = f32x16{};
    float carry = 1.0f;
    const int vb0 = (int)ring + 8192 + ((lane >> 4) & 1) * 32 + (lane & 3) * 8 + (4 * hi + ((lane & 15) >> 2)) * 64;
    const int qrel = 32 * e2 + r32;
    const int NI = 4 * qb + 4;
    for (int i = 0; i < NI; ++i) {
        A_WAIT_BAR(0);
        if (i > 0) { const ALAS unsigned* fl = flags + ((i - 1) & 1) * 8; unsigned all = 1u;
#pragma unroll
            for (int w = 0; w < 8; ++w) all &= fl[w];
            if (all) break; }
        const int t = td - i, slot = i & 1;
        if (i + 1 < NI) S_DMA(t - 1, slot ^ 1);
        bool done = true;
        if (t >= 0) {
            f32x16 p0, p1;
            qkt<4>(p0, p1, shm + S_RING + pair * 32768 + slot * 16384, qr, r32, hi);
            if (i == 0) {
#pragma unroll
                for (int r = 0; r < 16; ++r) { const int kv = crow(r, hi); if (kv >= qrel) p0[r] = -INFINITY; if (kv + 32 >= qrel) p1[r] = -INFINITY; } }
            f32x16 u0, u1;
#pragma unroll
            for (int r = 0; r < 16; ++r) { u0[r] = __builtin_amdgcn_rcpf(1.0f + __builtin_amdgcn_exp2f(p0[r])); u1[r] = __builtin_amdgcn_rcpf(1.0f + __builtin_amdgcn_exp2f(p1[r])); }
            float lo_[8], up_[8];
#pragma unroll
            for (int i4 = 0; i4 < 8; ++i4) {
                const float bp = (i4 < 4) ? ((u0[4 * i4] * u0[4 * i4 + 1]) * (u0[4 * i4 + 2] * u0[4 * i4 + 3])) : ((u1[4 * i4 - 16] * u1[4 * i4 - 15]) * (u1[4 * i4 - 14] * u1[4 * i4 - 13]));
                auto rr = __builtin_amdgcn_permlane32_swap(__float_as_uint(bp), __float_as_uint(bp), false, false);
                lo_[i4] = __uint_as_float(rr[0]); up_[i4] = __uint_as_float(rr[1]);
            }
            float run = carry;
#pragma unroll
            for (int i4 = 7; i4 >= 0; --i4) {
                float c = (hi == 0) ? run * up_[i4] : run;
#pragma unroll
                for (int e = 3; e >= 0; --e) {
                    if (i4 < 4) { const float uu = u0[4 * i4 + e]; p0[4 * i4 + e] = (1.0f - uu) * c; c *= uu; }
                    else { const float uu = u1[4 * i4 - 16 + e]; p1[4 * i4 - 16 + e] = (1.0f - uu) * c; c *= uu; }
                }
                run *= lo_[i4] * up_[i4];
            }
            carry = run;
            u32x4 pw0, pw1, pw2, pw3;
            pw0 = (u32x4){cvtpk(p0[0], p0[1]), cvtpk(p0[2], p0[3]), cvtpk(p0[4], p0[5]), cvtpk(p0[6], p0[7])};
            pw1 = (u32x4){cvtpk(p0[8], p0[9]), cvtpk(p0[10], p0[11]), cvtpk(p0[12], p0[13]), cvtpk(p0[14], p0[15])};
            pw2 = (u32x4){cvtpk(p1[0], p1[1]), cvtpk(p1[2], p1[3]), cvtpk(p1[4], p1[5]), cvtpk(p1[6], p1[7])};
            pw3 = (u32x4){cvtpk(p1[8], p1[9]), cvtpk(p1[10], p1[11]), cvtpk(p1[12], p1[13]), cvtpk(p1[14], p1[15])};
            pv(o, vb0 + slot * 16384, __builtin_bit_cast(bf16x8, pw0), __builtin_bit_cast(bf16x8, pw1), __builtin_bit_cast(bf16x8, pw2), __builtin_bit_cast(bf16x8, pw3));
            done = __all(carry < 1.0e-37f) || (t == 0);
        }
        if (lane == 0) flags[(i & 1) * 8 + wid] = done ? 1u : 0u;
    }
    A_WAIT_BAR(0);
    ALAS float* stg = (ALAS float*)shm + wid * 2048;
#pragma unroll
    for (int r = 0; r < 16; ++r) { const int orow = crow(r, hi);
#pragma unroll
        for (int d0 = 0; d0 < 2; ++d0) stg[orow * 64 + d0 * 32 + r32] = o[d0][r]; }
    const long grow0 = rowbase + q0 + wid * 32;
#pragma unroll
    for (int i = 0; i < 4; ++i) {
        const int row = i * 8 + (lane >> 3), ch = lane & 7;
        const f32x4 a = *(const ALAS f32x4*)(stg + row * 64 + ch * 8), c = *(const ALAS f32x4*)(stg + row * 64 + ch * 8 + 4);
        float ss = ((a[0] * a[0] + a[1] * a[1]) + (a[2] * a[2] + a[3] * a[3])) + ((c[0] * c[0] + c[1] * c[1]) + (c[2] * c[2] + c[3] * c[3]));
        ss += __shfl_xor(ss, 1); ss += __shfl_xor(ss, 2); ss += __shfl_xor(ss, 4);
        const float rn = 1.0f / sqrtf(ss * (1.0f / 64.0f) + kEps);
        const size_t off = (size_t)(grow0 + row) * 1024 + goff + h * 64 + ch * 8;
        const u32x4 gv = *(const u32x4*)(gate + off);
        const f32x4 g0 = *(const f32x4*)(gnorm + h * 64 + ch * 8), g1 = *(const f32x4*)(gnorm + h * 64 + ch * 8 + 4);
        float v[8];
#pragma unroll
        for (int e = 0; e < 4; ++e) { v[e] = a[e] * rn * g0[e]; v[4 + e] = c[e] * rn * g1[e]; }
        u32x4 w;
#pragma unroll
        for (int e = 0; e < 4; ++e) { const unsigned gw = gv[e]; w[e] = cvtpk(v[2 * e] * __uint_as_float(gw << 16), v[2 * e + 1] * __uint_as_float(gw & 0xffff0000u)); }
        *(u32x4*)(out + off) = w;
    }
    A_WAIT_BAR(0);
#undef S_DMA
}
}
#include <hip/hip_cooperative_groups.h>
namespace cg = cooperative_groups;
#ifndef MK_N_LAUNCHES
#define MK_N_LAUNCHES 1
#endif
#ifndef REP_MLA
#define REP_MLA 1
#endif
#ifndef REP_SB
#define REP_SB 1
#endif
#ifndef REP_P1
#define REP_P1 1
#endif
#ifndef REP_MISC
#define REP_MISC 1
#endif
#ifndef REP_SYNC
#define REP_SYNC 0
#endif
#ifndef REP_TAIL
#define REP_TAIL 1
#endif
constexpr int NWAVES = 8;
constexpr int N_PHASES = 7;
constexpr int M = 32768, D = 1024, SEQ = 4096, NIN = 2976, NINP = 3072, PLE = 256;
constexpr size_t MiB = 1u << 20;
constexpr size_t WS_A = 0;
constexpr size_t WS_B = 64 * MiB;
constexpr size_t WS_PLE = 128 * MiB;
constexpr size_t WS_SBQ = 192 * MiB, WS_SBK = 224 * MiB, WS_SBV = 256 * MiB;
constexpr size_t WS_MQ = 288 * MiB, WS_MK = 336 * MiB, WS_MV = 384 * MiB;
constexpr size_t WS_PB = 416 * MiB, WS_CQ = 432 * MiB, WS_CKV = 448 * MiB;
constexpr size_t WS_WIN = 464 * MiB;
constexpr size_t WS_WUQ = 470 * MiB;
constexpr size_t WS_WUKV = 471 * MiB;
constexpr size_t WS_WOUT = 472 * MiB;
constexpr size_t WS_WPLE = 474 * MiB;
constexpr size_t WS_WPG = 475 * MiB;
constexpr size_t WS_CS = 477 * MiB;
constexpr size_t WS_RPRE = 481 * MiB;
constexpr size_t WS_RQSS = 482 * MiB;
constexpr size_t WS_RKVSS = 483 * MiB;
constexpr size_t WS_YSS = 484 * MiB;
constexpr size_t WS_PSS = 486 * MiB;
constexpr size_t WS_RY = 488 * MiB, WS_RP = 489 * MiB;
constexpr size_t WS_CTL = 490 * MiB, CTL_ZERO_BYTES = 16384;
constexpr size_t WS_END = 491 * MiB;
constexpr int MISC_OFF = 147456 - 256;
constexpr int LDS_BYTES = 147456;
static_assert(WS_SBK - WS_SBQ == 32 * MiB && WS_SBV - WS_SBK == 32 * MiB, "EpiProj addresses SBK/SBV relative to SBQ");
static_assert(att::L_END <= MISC_OFF && pg8::STAGE_BYTES <= MISC_OFF, "control words");
static_assert(att::M_END <= MISC_OFF && att::S_END <= MISC_OFF, "LDS map");
static_assert(att::L_END <= LDS_BYTES && pg8::STAGE_BYTES <= LDS_BYTES, "LDS map");

typedef unsigned short bf16;
typedef unsigned v4u __attribute__((ext_vector_type(4)));
typedef unsigned v2u __attribute__((ext_vector_type(2)));
typedef float f32x4 __attribute__((ext_vector_type(4)));
#define LAS __attribute__((address_space(3)))
__device__ __forceinline__ unsigned f2bf(float f) { unsigned u = __builtin_bit_cast(unsigned, f); return (u + 0x7fffu + ((u >> 16) & 1u)) >> 16; }
__device__ __forceinline__ unsigned pk2(float lo, float hi) { return f2bf(lo) | (f2bf(hi) << 16); }
__device__ __forceinline__ float wave_sum(float v) {
#pragma unroll
    for (int o = 1; o < 64; o <<= 1) v += __shfl_xor(v, o);
    return v;
}
__device__ __forceinline__ void transpose_item(const float* W, int K, int N, bf16* WT, int ldk, const float* gain, LAS float* scr, int item, int lane) {
    const int nblk = N / 32, kb = item / nblk, nb = item % nblk, k0 = 64 * kb, n0 = 32 * nb;
#pragma unroll 8
    for (int i = 0; i < 32; ++i) { const int kk = 2 * i + (lane >> 5); const float gk = gain ? gain[k0 + kk] : 1.0f; scr[kk * 33 + (lane & 31)] = W[(size_t)(k0 + kk) * N + n0 + (lane & 31)] * gk; }
    asm volatile("s_waitcnt lgkmcnt(0)" ::: "memory");
    const int c = lane & 7;
#pragma unroll
    for (int j = 0; j < 4; ++j) { const int n = (lane >> 3) + 8 * j; const LAS float* s = scr + (8 * c) * 33 + n;
        v4u o; o.x = pk2(s[0 * 33], s[1 * 33]); o.y = pk2(s[2 * 33], s[3 * 33]); o.z = pk2(s[4 * 33], s[5 * 33]); o.w = pk2(s[6 * 33], s[7 * 33]);
        *(v4u*)(WT + (size_t)(n0 + n) * ldk + k0 + 8 * c) = o; }
    asm volatile("s_waitcnt lgkmcnt(0)" ::: "memory");
}

#define XB_TMO      128
#define XB_XCNT(j)  (256  + 64 * (j))
#define XB_XSUB(j)  (1280 + 64 * (j))
#define XB_XGEN(j)  (2304 + 64 * (j))
#define XB_TOP      3328
#define XB_TOPGEN   3392
#define XCD_BAR_WORDS 3456
#define XB_SPIN_CAP (1u << 18)

__device__ __forceinline__ unsigned xb_ld(unsigned* p)              { return __hip_atomic_load(p, __ATOMIC_RELAXED, __HIP_MEMORY_SCOPE_AGENT); }
__device__ __forceinline__ unsigned xb_add(unsigned* p, unsigned v) { return __hip_atomic_fetch_add(p, v, __ATOMIC_RELAXED, __HIP_MEMORY_SCOPE_AGENT); }
__device__ __forceinline__ unsigned xb_xcc_id() { return (unsigned)__builtin_amdgcn_s_getreg((3 << 11) | 20) & 0xFu; }
#define XB_SPIN(cond, bar) do { unsigned _sp = 0; while (cond) { __builtin_amdgcn_s_sleep(1); \
    if ((++_sp & 255u) == 0u) { if (xb_ld(&(bar)[XB_TMO])) break; if (_sp > XB_SPIN_CAP) { atomicAdd(&(bar)[XB_TMO], 1u); break; } } } } while (0)

struct XcdBarrier {
    unsigned* bar; unsigned x;
    volatile LAS unsigned* st;
};

__device__ __forceinline__ XcdBarrier xcd_barrier_post(unsigned* bar, volatile LAS unsigned* st) {
    XcdBarrier b; b.bar = bar; b.x = xb_xcc_id(); b.st = st;
    if (threadIdx.x == 0) (void)xb_add(&bar[XB_XCNT(b.x)], 1u);
    return b;
}
__device__ __forceinline__ void xcd_barrier_complete(unsigned* bar, unsigned x, unsigned& nloc, unsigned& nx) {
    const unsigned G = gridDim.x * gridDim.y * gridDim.z;
    unsigned sum, cnt, mine, sp = 0u;
    for (;;) {
        sum = 0u; cnt = 0u; mine = 0u;
#pragma unroll
        for (unsigned j = 0; j < 16; ++j) { const unsigned c = xb_ld(&bar[XB_XCNT(j)]); sum += c; cnt += (c > 0u) ? 1u : 0u; mine = (j == x) ? c : mine; }
        if (sum == G) break;
        __builtin_amdgcn_s_sleep(1);
        if ((++sp & 255u) == 0u) { if (xb_ld(&bar[XB_TMO])) break; if (sp > XB_SPIN_CAP) { atomicAdd(&bar[XB_TMO], 1u); break; } }
    }
    nloc = mine > 0u ? mine : 1u; nx = cnt > 0u ? cnt : 1u;
}

__device__ __forceinline__ void xcd_barrier(const XcdBarrier& b) {
    asm volatile("s_waitcnt vmcnt(0)" ::: "memory");
    __syncthreads();
    if (threadIdx.x == 0) {
        unsigned* bar = b.bar;
        __builtin_amdgcn_s_waitcnt(0);
        unsigned nloc = b.st[0], nx = b.st[1];
        if (nloc == 0u) { xcd_barrier_complete(bar, b.x, nloc, nx); b.st[0] = nloc; b.st[1] = nx; }
        const unsigned old = xb_add(&bar[XB_XSUB(b.x)], 1u);
        const unsigned gen = old / nloc;
        if (old + 1u == (gen + 1u) * nloc) {
            __builtin_amdgcn_fence(__ATOMIC_RELEASE, "agent");
            asm volatile("s_waitcnt vmcnt(0)" ::: "memory");
            const unsigned og = xb_add(&bar[XB_TOP], 1u);
            const unsigned tg = og / nx;
            if (og + 1u == (tg + 1u) * nx) xb_add(&bar[XB_TOPGEN], 1u);
            else XB_SPIN(xb_ld(&bar[XB_TOPGEN]) == tg, bar);
            __builtin_amdgcn_fence(__ATOMIC_ACQUIRE, "agent");
            xb_add(&bar[XB_XGEN(b.x)], 1u);
            asm volatile("s_waitcnt vmcnt(0)" ::: "memory");
        } else {
            XB_SPIN(xb_ld(&bar[XB_XGEN(b.x)]) == gen, bar);
            __builtin_amdgcn_fence(__ATOMIC_ACQUIRE, "agent");
            asm volatile("s_waitcnt vmcnt(0)" ::: "memory");
        }
    }
    __syncthreads();
}

static_assert(XCD_BAR_WORDS * 4 <= (int)CTL_ZERO_BYTES, "barrier words inside the memset");
__device__ __forceinline__ int opq(int v) { asm volatile("" : "+s"(v)); return v; }
struct Args { const float* in[17]; const int* pos; float* out; unsigned char* ws; int ph_lo, ph_hi; };

__global__ void __launch_bounds__(NWAVES * 64, 2) fwd_kernel(Args args) {
    extern __shared__ __attribute__((aligned(16))) unsigned char lds[];
    const int tid = threadIdx.x, lane = tid & 63, wave = __builtin_amdgcn_readfirstlane(tid >> 6);
    const int G = gridDim.x; const int bx = blockIdx.x; const int vcu = (G % 8 == 0) ? (bx % 8) * (G / 8) + bx / 8 : bx;
    unsigned char* ws = args.ws;
    const float* x = args.in[0]; const float* pin = args.in[1];
    const float* g_pre = args.in[3]; const float* w_in = args.in[4]; const float* g_q = args.in[5]; const float* w_uq = args.in[6]; const float* g_kv = args.in[7]; const float* w_ukv = args.in[8];
    const float* g_sb = args.in[9]; const float* g_mla = args.in[10]; const float* w_out = args.in[11]; const float* g_post = args.in[12]; const float* w_ple = args.in[13]; const float* g_ple = args.in[14];
    const float* w_pg = args.in[15]; const float* b_pg = args.in[16];
    bf16* XB = (bf16*)(ws + WS_A); bf16* MIX = (bf16*)(ws + WS_A); bf16* X1B = (bf16*)(ws + WS_A);
    bf16* GATE = (bf16*)(ws + WS_B); bf16* YB = (bf16*)(ws + WS_B); bf16* PLEB = (bf16*)(ws + WS_PLE);
    bf16* SBQ = (bf16*)(ws + WS_SBQ); bf16* SBK = (bf16*)(ws + WS_SBK); bf16* SBV = (bf16*)(ws + WS_SBV);
    bf16* MQ = (bf16*)(ws + WS_MQ); bf16* MK = (bf16*)(ws + WS_MK); bf16* MV = (bf16*)(ws + WS_MV);
    bf16* PB = (bf16*)(ws + WS_PB); bf16* CQ = (bf16*)(ws + WS_CQ); bf16* CKV = (bf16*)(ws + WS_CKV);
    bf16* WIN = (bf16*)(ws + WS_WIN); bf16* WUQ = (bf16*)(ws + WS_WUQ); bf16* WUKV = (bf16*)(ws + WS_WUKV); bf16* WOUT = (bf16*)(ws + WS_WOUT); bf16* WPLE = (bf16*)(ws + WS_WPLE); bf16* WPG = (bf16*)(ws + WS_WPG);
    float* CS = (float*)(ws + WS_CS); float* RPRE = (float*)(ws + WS_RPRE); float* RQSS = (float*)(ws + WS_RQSS); float* RKVSS = (float*)(ws + WS_RKVSS);
    float* YSS = (float*)(ws + WS_YSS); float* PSS = (float*)(ws + WS_PSS); float* RY = (float*)(ws + WS_RY); float* RP = (float*)(ws + WS_RP);
    const int lo = args.ph_lo, hi = args.ph_hi;
#define IN(k) (lo <= (k) && (k) < hi)
#define SEAM(k) do { if (IN(k) && IN((k) + 1)) { xcd_barrier(bar); } } while (0)
    if (lo < 0) cg::this_grid().sync();
    volatile LAS unsigned* MISC = (volatile LAS unsigned*)((LAS unsigned char*)lds + MISC_OFF);
    if (tid < 8) MISC[tid] = 0u;
    __syncthreads();
    XcdBarrier bar; bar.bar = (unsigned*)(ws + WS_CTL); bar.x = 0; bar.st = nullptr;
    if (hi - lo > 1) bar = xcd_barrier_post((unsigned*)(ws + WS_CTL), MISC);
    const int gw = vcu * NWAVES + wave, NGW = G * NWAVES;

    for (int rep0 = 0; rep0 < REP_MISC; ++rep0)
    if (IN(0)) {
        LAS float* scr = (LAS float*)((LAS unsigned char*)lds + wave * 16384);
        constexpr int I_IN = 16 * 93, I_UQ = 4 * 24, I_UKV = 2 * 32, I_OUT = 16 * 32, I_PLE = 4 * 32, I_PG = 16 * 32;
        constexpr int NITEMS = I_IN + I_UQ + I_UKV + I_OUT + I_PLE + I_PG;
        for (int it = gw; it < NITEMS; it += NGW) {
            int r = it;
            if (r < I_IN) { transpose_item(w_in, 1024, NIN, WIN, 1024, g_pre, scr, r, lane); continue; } r -= I_IN;
            if (r < I_UQ) { transpose_item(w_uq, 256, 768, WUQ, 256, g_q, scr, r, lane); continue; } r -= I_UQ;
            if (r < I_UKV) { transpose_item(w_ukv, 128, 1024, WUKV, 256, g_kv, scr, r, lane); continue; } r -= I_UKV;
            if (r < I_OUT) { transpose_item(w_out, 1024, 1024, WOUT, 1024, nullptr, scr, r, lane); continue; } r -= I_OUT;
            if (r < I_PLE) { transpose_item(w_ple, 256, 1024, WPLE, 256, nullptr, scr, r, lane); continue; } r -= I_PLE;
            transpose_item(w_pg, 1024, 1024, WPG, 1024, nullptr, scr, r, lane);
        }
        const int gt = vcu * (NWAVES * 64) + tid, NGT = G * NWAVES * 64;
        for (int i = gt; i < (NINP - NIN) * 1024 / 8; i += NGT) *(v4u*)(WIN + (size_t)NIN * 1024 + (size_t)i * 8) = (v4u){0u, 0u, 0u, 0u};
        for (int i = gt; i < 1024 * 128 / 8; i += NGT) { const int n = i / 16, c = i % 16; *(v4u*)(WUKV + (size_t)n * 256 + 128 + c * 8) = (v4u){0u, 0u, 0u, 0u}; }
        for (int i = gt; i < M * 16; i += NGT) {
            const int row = i >> 4, k = i & 15;
            const float freq = exp2f(-(float)k * 0.8304820237218407f);
            const float ang = (float)args.pos[row] * freq;
            double tt = (double)ang * 0.15915494309189535; tt -= __builtin_rint(tt);
            const float tf = (float)tt;
            CS[(size_t)i * 2] = __builtin_amdgcn_cosf(tf); CS[(size_t)i * 2 + 1] = __builtin_amdgcn_sinf(tf);
        }
        for (int m = gw; m < M; m += NGW) {
            const f32x4* xr = (const f32x4*)(x + (size_t)m * D) + lane; f32x4 v[4]; float s = 0.f;
#pragma unroll
            for (int j = 0; j < 4; ++j) { v[j] = xr[64 * j]; s += (v[j][0] * v[j][0] + v[j][1] * v[j][1]) + (v[j][2] * v[j][2] + v[j][3] * v[j][3]); }
            s = wave_sum(s);
            if (lane == 0) RPRE[m] = 1.0f / sqrtf(s * (1.0f / D) + 1e-6f);
            v2u* o8 = (v2u*)(XB + (size_t)m * D) + lane;
#pragma unroll
            for (int j = 0; j < 4; ++j) o8[64 * j] = (v2u){pk2(v[j][0], v[j][1]), pk2(v[j][2], v[j][3])};
        }
        for (int i = gt; i < M * PLE / 4; i += NGT) { const f32x4 v = *((const f32x4*)pin + i); *((v2u*)PB + i) = (v2u){pk2(v[0], v[1]), pk2(v[2], v[3])}; }
    }
    SEAM(0);

    if (IN(1)) {
        { pg8::Gemm g{XB, WIN, M, NINP, 1024}; pg8::StaticOrder S; S.init(M, NINP, G, bx);
          pg8::EpiProj E{SBQ, SBK, SBV, GATE, CQ, CKV, MK, RQSS, RKVSS, RPRE, CS};
          pg8::gemm_phase<pg8::EpiProj, pg8::StaticOrder, true, true>((PG8_LAS unsigned char*)lds, g, S, E); }
#if REP_P1 > 1
        { pg8::Gemm g{XB, WIN, M, NINP, 1024}; pg8::StaticOrder S; S.init(M, NINP, G, bx);
          pg8::EpiProj E{SBQ, SBK, SBV, GATE, CQ, CKV, MK, RQSS, RKVSS, RPRE, CS};
          pg8::gemm_phase<pg8::EpiProj, pg8::StaticOrder, true, true>((PG8_LAS unsigned char*)lds, g, S, E); }
#endif
        { pg8::Gemm g{PB, WPLE, M, 1024, opq(256)}; pg8::StaticOrder S; S.init(M, 1024, G, bx);
          pg8::EpiStat E{PLEB, PSS};
          pg8::gemm_phase<pg8::EpiStat, pg8::StaticOrder, true, true>((PG8_LAS unsigned char*)lds, g, S, E); }
#if REP_MISC > 1
        { pg8::Gemm g{PB, WPLE, M, 1024, opq(256)}; pg8::StaticOrder S; S.init(M, 1024, G, bx);
          pg8::EpiStat E{PLEB, PSS};
          pg8::gemm_phase<pg8::EpiStat, pg8::StaticOrder, true, true>((PG8_LAS unsigned char*)lds, g, S, E); }
#endif
    }
    SEAM(1);

    if (IN(2)) {
        { pg8::Gemm g{CQ, WUQ, M, 768, opq(256)}; pg8::StaticOrder S; S.init(M, 768, G, bx);
          pg8::EpiQ E{MQ, RQSS, CS};
          pg8::gemm_phase<pg8::EpiQ, pg8::StaticOrder, true, true>((PG8_LAS unsigned char*)lds, g, S, E); }
        { pg8::Gemm g{CKV, WUKV, M, 1024, opq(256)}; pg8::StaticOrder S; S.init(M, 1024, G, bx);
          pg8::EpiKV E{MK, MV, RKVSS};
          pg8::gemm_phase<pg8::EpiKV, pg8::StaticOrder, true, true>((PG8_LAS unsigned char*)lds, g, S, E); }
#if REP_MISC > 1
        { pg8::Gemm g{CQ, WUQ, M, 768, opq(256)}; pg8::StaticOrder S; S.init(M, 768, G, bx);
          pg8::EpiQ E{MQ, RQSS, CS};
          pg8::gemm_phase<pg8::EpiQ, pg8::StaticOrder, true, true>((PG8_LAS unsigned char*)lds, g, S, E); }
        { pg8::Gemm g{CKV, WUKV, M, 1024, opq(256)}; pg8::StaticOrder S; S.init(M, 1024, G, bx);
          pg8::EpiKV E{MK, MV, RKVSS};
          pg8::gemm_phase<pg8::EpiKV, pg8::StaticOrder, true, true>((PG8_LAS unsigned char*)lds, g, S, E); }
#endif
    }
    SEAM(2);

    if (IN(3)) {
        __attribute__((address_space(3))) char* shm = (__attribute__((address_space(3))) char*)lds;
        for (int rep = 0; rep < REP_MLA; ++rep)
        for (int idx = vcu; idx < 1024; idx += G) {
            const int j = idx >> 8, v = idx & 255, bh = v >> 2, s = v & 3;
            const int qb = (j == 0) ? 15 - s : (j == 1) ? s : (j == 2) ? 8 + s : 7 - s;
            att::mla_unit(bh >> 3, bh & 7, qb, MQ, MK, MV, GATE, g_mla, MIX, 512, shm);
        }
        for (int rep = 0; rep < REP_SB; ++rep)
        for (int idx = vcu; idx < 1024; idx += G) {
            const int bh = idx >> 4, qb = idx & 15;
            att::sb_unit(bh >> 3, bh & 7, qb, SBQ, SBK, SBV, GATE, g_sb, MIX, 0, shm);
        }
    }
    SEAM(3);
    for (int rs_ = 0; rs_ < REP_SYNC; ++rs_) xcd_barrier(bar);

    if (IN(4)) {
        {
        pg8::Gemm g{MIX, WOUT, M, 1024, 1024}; pg8::StaticOrder S; S.init(M, 1024, G, bx);
        pg8::EpiStat E{YB, YSS};
        pg8::gemm_phase<pg8::EpiStat, pg8::StaticOrder, true, true>((PG8_LAS unsigned char*)lds, g, S, E);
        }
#if REP_TAIL > 1
        {
        pg8::Gemm g{MIX, WOUT, M, 1024, 1024}; pg8::StaticOrder S; S.init(M, 1024, G, bx);
        pg8::EpiStat E{YB, YSS};
        pg8::gemm_phase<pg8::EpiStat, pg8::StaticOrder, true, true>((PG8_LAS unsigned char*)lds, g, S, E);
        }
#endif
    }
    SEAM(4);

    if (IN(5)) {
        for (int rep = 0; rep < REP_TAIL; ++rep)
        for (int m = gw; m < M; m += NGW) {
            float sv = (lane < 16) ? YSS[(size_t)m * 16 + lane] : ((lane < 32) ? PSS[(size_t)m * 16 + lane - 16] : 0.f);
            sv += __shfl_xor(sv, 1); sv += __shfl_xor(sv, 2); sv += __shfl_xor(sv, 4); sv += __shfl_xor(sv, 8);
            const float sy = __shfl(sv, 0), sp = __shfl(sv, 16);
            const float ry = 1.0f / sqrtf(sy * (1.0f / 1024.0f) + 1e-6f), rp = 1.0f / sqrtf(sp * (1.0f / 1024.0f) + 1e-6f);
            if (lane == 0) { RY[m] = ry; RP[m] = rp; }
            const f32x4* xr = (const f32x4*)(x + (size_t)m * D) + lane; const v2u* yr = (const v2u*)(YB + (size_t)m * D) + lane; const f32x4* gr = (const f32x4*)g_post + lane;
            v2u* o8 = (v2u*)(X1B + (size_t)m * D) + lane;
#pragma unroll
            for (int j = 0; j < 4; ++j) { const f32x4 xv = xr[64 * j], gv = gr[64 * j]; const v2u yw = yr[64 * j];
                const float y0 = __uint_as_float(yw.x << 16), y1 = __uint_as_float(yw.x & 0xffff0000u), y2 = __uint_as_float(yw.y << 16), y3 = __uint_as_float(yw.y & 0xffff0000u);
                o8[64 * j] = (v2u){pk2(xv[0] + y0 * ry * gv[0], xv[1] + y1 * ry * gv[1]), pk2(xv[2] + y2 * ry * gv[2], xv[3] + y3 * ry * gv[3])}; }
        }
    }
    SEAM(5);

    if (IN(6)) {
        {
        pg8::Gemm g{X1B, WPG, M, 1024, 1024}; pg8::StaticOrder S; S.init(M, 1024, G, bx);
        pg8::EpiFinal E{x, YB, PLEB, RY, RP, g_post, g_ple, b_pg, args.out};
        pg8::gemm_phase<pg8::EpiFinal, pg8::StaticOrder, true, true>((PG8_LAS unsigned char*)lds, g, S, E);
        }
#if REP_TAIL > 1
        {
        pg8::Gemm g{X1B, WPG, M, 1024, 1024}; pg8::StaticOrder S; S.init(M, 1024, G, bx);
        pg8::EpiFinal E{x, YB, PLEB, RY, RP, g_post, g_ple, b_pg, args.out};
        pg8::gemm_phase<pg8::EpiFinal, pg8::StaticOrder, true, true>((PG8_LAS unsigned char*)lds, g, S, E);
        }
#endif
    }
#undef IN
#undef SEAM
}

extern "C" void kernel_launch(void* const* d_in, const int* in_sizes, int n_in, void* d_out, int out_size, void* d_ws, size_t ws_size, hipStream_t stream) {
    static int grid = 0;
    if (grid == 0) {
        if (n_in != 17 || out_size != M * D || ws_size < WS_END) { fprintf(stderr, "kernel_launch: unexpected shapes (n_in %d, out %d, ws %zu); nothing launched\n", n_in, out_size, ws_size); grid = -1; return; }
        int dev = 0, cus = 0, per_cu = 0;
        if (hipGetDevice(&dev) != hipSuccess || hipDeviceGetAttribute(&cus, hipDeviceAttributeMultiprocessorCount, dev) != hipSuccess) { grid = -1; return; }
        if (hipFuncSetAttribute((const void*)fwd_kernel, hipFuncAttributeMaxDynamicSharedMemorySize, LDS_BYTES) != hipSuccess) { fprintf(stderr, "kernel_launch: hipFuncSetAttribute failed\n"); grid = -1; return; }
        if (hipOccupancyMaxActiveBlocksPerMultiprocessor(&per_cu, (const void*)fwd_kernel, NWAVES * 64, LDS_BYTES) != hipSuccess || per_cu < 1) { fprintf(stderr, "kernel_launch: occupancy query says %d blocks per CU\n", per_cu); per_cu = 1; }
        (void)hipGetLastError();
        grid = cus * 1;
    }
    if (grid < 0) return;
    if (hipMemsetAsync((char*)d_ws + WS_CTL, 0, CTL_ZERO_BYTES, stream) != hipSuccess) { fprintf(stderr, "kernel_launch: hipMemsetAsync failed\n"); return; }
    Args a{};
    for (int i = 0; i < 17; ++i) a.in[i] = (const float*)d_in[i];
    a.pos = (const int*)d_in[2]; a.out = (float*)d_out; a.ws = (unsigned char*)d_ws;
#if MK_N_LAUNCHES == 1
    a.ph_lo = 0; a.ph_hi = N_PHASES;
    void* kargs[] = {&a};
    hipError_t e = hipLaunchCooperativeKernel((const void*)fwd_kernel, dim3(grid), dim3(NWAVES * 64), kargs, LDS_BYTES, stream);
    if (e != hipSuccess) fprintf(stderr, "kernel_launch: cooperative launch failed: %s (grid %d)\n", hipGetErrorString(e), grid);
#else
    for (int li = 0; li < N_PHASES; ++li) { a.ph_lo = li; a.ph_hi = li + 1; hipLaunchKernelGGL(fwd_kernel, dim3(grid), dim3(NWAVES * 64), LDS_BYTES, stream, a); }
#endif
}
```

```cpp
#include <hip/hip_runtime.h>
#include <cstdio>
#include <cstdint>
#include <cmath>
constexpr int M = 32768, D = 1024, SEQ = 4096, NIN = 2976, NINP = 3072, PLE = 256;
constexpr size_t MiB = 1u << 20;
constexpr size_t WS_A = 0;
constexpr size_t WS_B = 64 * MiB;
constexpr size_t WS_PLE = 128 * MiB;
constexpr size_t WS_SBQ = 192 * MiB, WS_SBK = 224 * MiB, WS_SBV = 256 * MiB;
constexpr size_t WS_MQ = 288 * MiB, WS_MK = 336 * MiB, WS_MV = 384 * MiB;
constexpr size_t WS_PB = 416 * MiB, WS_CQ = 432 * MiB, WS_CKV = 448 * MiB;
constexpr size_t WS_WIN = 464 * MiB;
constexpr size_t WS_WUQ = 470 * MiB;
constexpr size_t WS_WUKV = 471 * MiB;
constexpr size_t WS_WOUT = 472 * MiB;
constexpr size_t WS_WPLE = 474 * MiB;
constexpr size_t WS_WPG = 475 * MiB;
constexpr size_t WS_CS = 477 * MiB;
constexpr size_t WS_RPRE = 481 * MiB;
constexpr size_t WS_RQSS = 482 * MiB;
constexpr size_t WS_RKVSS = 483 * MiB;
constexpr size_t WS_YSS = 484 * MiB;
constexpr size_t WS_PSS = 486 * MiB;
constexpr size_t WS_RY = 488 * MiB, WS_RP = 489 * MiB;
constexpr size_t WS_CTL = 490 * MiB, CTL_ZERO_BYTES = 16384;
constexpr size_t WS_END = 491 * MiB;
constexpr int MISC_OFF = 147456 - 256;
namespace pg8 {
#define PG8_LAS __attribute__((address_space(3)))
typedef unsigned short bf16_t;
typedef short bf16x8 __attribute__((ext_vector_type(8)));
typedef float f32x4 __attribute__((ext_vector_type(4)));
typedef unsigned u32x4 __attribute__((ext_vector_type(4)));
constexpr int BM = 256, BK = 64, HALF = 128, HTB = HALF * BK * 2  , STAGE_BYTES = 8 * HTB, NXCD = 8, WGM = 8;

__host__ __device__ __forceinline__ int lds_byte(int r, int c) { const int st = (r >> 4) * 2 + (c >> 5), rr = r & 15, cc = c & 31, ob = rr * 64 + cc * 2; return st * 1024 + (ob ^ (((ob >> 9) & 1) << 5)); }
__host__ __device__ __forceinline__ void stage_rc(int b, int& R, int& C) { const int st = b / 1024, sb = b % 1024, swz = sb ^ (((sb >> 9) & 1) << 5); R = (st >> 1) * 16 + swz / 64; C = (st & 1) * 32 + (swz % 64) / 2; }
__host__ __device__ __forceinline__ int perm32(int rho) { const int n = rho >> 4, i = rho & 15; return 8 * (i >> 2) + 4 * n + (i & 3); }

struct Unit { int pm, pn; };
struct Gemm { const bf16_t* A; const bf16_t* Bt; int M, N, K; };

struct StaticOrder {
    int nM, nN, nwg, G, c;
    __host__ __device__ void init(int M, int N, int G_, int c_) { nM = M / BM; nN = N / BM; nwg = nM * nN; G = G_; c = c_; }
    __host__ __device__ bool next(int i, Unit& u) const {
        const long L = (long)i * G + c; if (L >= nwg) return false;
        int wgid = (int)L; { const int q = nwg / NXCD, r = nwg % NXCD, xcd = wgid % NXCD, off = wgid / NXCD; wgid = (xcd < r ? xcd * (q + 1) : r * (q + 1) + (xcd - r) * q) + off; }
        const int nig = WGM * nN, gid = wgid / nig, fm = gid * WGM, gsz = (nM - fm) < WGM ? (nM - fm) : WGM;
        u.pm = fm + ((wgid % nig) % gsz); u.pn = (wgid % nig) / gsz; return true;
    }
    __device__ __forceinline__ void a_ready(const Unit&) const {}
    __device__ __forceinline__ void done(const Unit&) const {}
};

__device__ __forceinline__ unsigned cvt_pk_bf16(float lo, float hi) { unsigned r; asm volatile("v_cvt_pk_bf16_f32 %0, %1, %2" : "=v"(r) : "v"(lo), "v"(hi)); return r; }
typedef float f32x2 __attribute__((ext_vector_type(2)));
typedef unsigned u32x2 __attribute__((ext_vector_type(2)));
constexpr float kLog2e = 1.4426950408889634f;
constexpr float kEps = 1e-6f;
constexpr float QS_SB = 0.125f * kLog2e;
constexpr float QS_MLA = 0.10206207261596577f * kLog2e;
__device__ __forceinline__ u32x2 pack4(f32x4 v) { u32x2 w; w.x = cvt_pk_bf16(v[0], v[1]); w.y = cvt_pk_bf16(v[2], v[3]); return w; }
__device__ __forceinline__ float sigmoid_f(float v) { return __builtin_amdgcn_rcpf(1.0f + __builtin_amdgcn_exp2f(-kLog2e * v)); }
__device__ __forceinline__ f32x4 silu4(f32x4 v) { f32x4 o; o[0] = v[0] * sigmoid_f(v[0]); o[1] = v[1] * sigmoid_f(v[1]); o[2] = v[2] * sigmoid_f(v[2]); o[3] = v[3] * sigmoid_f(v[3]); return o; }
__device__ __forceinline__ f32x4 unpack4(u32x2 w) { f32x4 o; o[0] = __uint_as_float(w.x << 16); o[1] = __uint_as_float(w.x & 0xffff0000u); o[2] = __uint_as_float(w.y << 16); o[3] = __uint_as_float(w.y & 0xffff0000u); return o; }
__device__ __forceinline__ float sumsq4(f32x4 v) { return (v[0] * v[0] + v[1] * v[1]) + (v[2] * v[2] + v[3] * v[3]); }
typedef unsigned u32x4e __attribute__((ext_vector_type(4)));
__device__ __forceinline__ u32x4e pack8(f32x4 a, f32x4 b) { u32x4e w; w.x = cvt_pk_bf16(a[0], a[1]); w.y = cvt_pk_bf16(a[2], a[3]); w.z = cvt_pk_bf16(b[0], b[1]); w.w = cvt_pk_bf16(b[2], b[3]); return w; }
__device__ __forceinline__ f32x4 rope4p(f32x4 v, const float* c, float sg) {
    const f32x4 c0 = *(const f32x4*)(c), c1 = *(const f32x4*)(c + 4);
    f32x4 o;
    o[0] = v[0] * c0[0] + (__shfl_xor(v[0], 32) * sg) * c0[1]; o[1] = v[1] * c0[2] + (__shfl_xor(v[1], 32) * sg) * c0[3];
    o[2] = v[2] * c1[0] + (__shfl_xor(v[2], 32) * sg) * c1[1]; o[3] = v[3] * c1[2] + (__shfl_xor(v[3], 32) * sg) * c1[3];
    return o;
}
__device__ __forceinline__ void rope8(f32x4& v0, f32x4& v1, const float* cs, int fq) {
    const float* c = cs + 16 * (fq & 1); const float sg = (fq < 2) ? -1.0f : 1.0f;
    v0 = rope4p(v0, c, sg); v1 = rope4p(v1, c + 8, sg);
}

struct EpiProj {
    static constexpr bool PERM = true, AFTER_DRAIN = false;
    unsigned char* ws;
    __device__ __forceinline__ void operator()(const f32x4 (&acc)[2][2][4][2], const Unit& u, int wr, int wc, int fr, int fq) const {
        const int pn = u.pn;
        bf16_t* const SBQ = (bf16_t*)(ws + WS_SBQ); bf16_t* const GATE = (bf16_t*)(ws + WS_B); bf16_t* const CQ = (bf16_t*)(ws + WS_CQ); bf16_t* const CKV = (bf16_t*)(ws + WS_CKV); bf16_t* const MK = (bf16_t*)(ws + WS_MK);
        float* const RQSS = (float*)(ws + WS_RQSS); float* const RKVSS = (float*)(ws + WS_RKVSS); const float* const rpre = (const float*)(ws + WS_RPRE); const float* const cs = (const float*)(ws + WS_CS);
#pragma unroll
        for (int ai = 0; ai < 2; ++ai)
#pragma unroll
            for (int m = 0; m < 4; ++m) {
                const int row = u.pm * BM + ai * HALF + wr * 64 + m * 16 + fr;
                const float rs = rpre[row];
                const int cw = wc * 32 + fq * 8;
#define PV_(bj, n) (acc[ai][bj][m][n] * rs)
                if (pn < 6) {
                    bf16_t* dst = SBQ + (size_t)(pn >> 1) * (size_t)(16u << 20) + (size_t)row * 512 + (pn & 1) * 256 + cw;
                    const float sc = pn < 2 ? QS_SB * rs : rs;
#pragma unroll
                    for (int bj = 0; bj < 2; ++bj) *(u32x4e*)(dst + bj * HALF) = pack8(acc[ai][bj][m][0] * sc, acc[ai][bj][m][1] * sc);
                } else if (pn < 8) {
                    bf16_t* dst = GATE + (size_t)row * 1024 + (pn - 6) * 256 + cw;
#pragma unroll
                    for (int bj = 0; bj < 2; ++bj) *(u32x4e*)(dst + bj * HALF) = pack8(silu4(PV_(bj, 0)), silu4(PV_(bj, 1)));
                } else if (pn == 8) {
                    bf16_t* dst = CQ + (size_t)row * 256 + cw; float ss = 0.f;
#pragma unroll
                    for (int bj = 0; bj < 2; ++bj) { const f32x4 a = PV_(bj, 0), b = PV_(bj, 1); *(u32x4e*)(dst + bj * HALF) = pack8(a, b); ss += sumsq4(a) + sumsq4(b); }
                    ss += __shfl_xor(ss, 16); ss += __shfl_xor(ss, 32);
                    if (fq == 0) RQSS[(size_t)row * 4 + wc] = ss;
                } else if (pn == 9) {
                    bf16_t* dst = CKV + (size_t)row * 256 + cw;
                    { const f32x4 a = PV_(0, 0), b = PV_(0, 1);
                      *(u32x4e*)dst = pack8(a, b); *(u32x4e*)(dst + HALF) = (u32x4e){0u, 0u, 0u, 0u};
                      float ss = sumsq4(a) + sumsq4(b);
                      ss += __shfl_xor(ss, 16); ss += __shfl_xor(ss, 32);
                      if (fq == 0) RKVSS[(size_t)row * 4 + wc] = ss; }
                    if (wc == 0) {
                        f32x4 x0 = PV_(1, 0), x1 = PV_(1, 1); rope8(x0, x1, cs + (size_t)row * 32, fq);
                        const u32x4e w = pack8(x0, x1);
                        bf16_t* kd = MK + (size_t)row * 768 + 64 + fq * 8;
#pragma unroll
                        for (int h = 0; h < 8; ++h) *(u32x4e*)(kd + h * 96) = w;
                    } else {
                        *(u32x4e*)(GATE + (size_t)row * 1024 + 512 + (wc - 1) * 32 + fq * 8) = pack8(silu4(PV_(1, 0)), silu4(PV_(1, 1)));
                    }
                } else {
                    const int base = 96 + (pn - 10) * 256 + cw;
#pragma unroll
                    for (int bj = 0; bj < 2; ++bj) { const int idx = base + bj * HALF; if (idx < 512) *(u32x4e*)(GATE + (size_t)row * 1024 + 512 + idx) = pack8(silu4(PV_(bj, 0)), silu4(PV_(bj, 1))); }
                }
#undef PV_
            }
    }
};
struct EpiQ {
    static constexpr bool PERM = true, AFTER_DRAIN = false;
    bf16_t* MQ; const float* RQSS; const float* cs;
    __device__ __forceinline__ void operator()(const f32x4 (&acc)[2][2][4][2], const Unit& u, int wr, int wc, int fr, int fq) const {
#pragma unroll
        for (int ai = 0; ai < 2; ++ai)
#pragma unroll
            for (int m = 0; m < 4; ++m) {
                const int row = u.pm * BM + ai * HALF + wr * 64 + m * 16 + fr;
                const f32x4 s4 = *(const f32x4*)(RQSS + (size_t)row * 4);
                const float rs = QS_MLA * __builtin_amdgcn_rsqf(((s4[0] + s4[1]) + (s4[2] + s4[3])) * (1.0f / 256.0f) + kEps);
#pragma unroll
                for (int bj = 0; bj < 2; ++bj) {
                    const int g = u.pn * 8 + bj * 4 + wc;
                    f32x4 x0 = acc[ai][bj][m][0] * rs, x1 = acc[ai][bj][m][1] * rs;
                    if (g % 3 == 2) rope8(x0, x1, cs + (size_t)row * 32, fq);
                    *(u32x4e*)(MQ + (size_t)row * 768 + g * 32 + fq * 8) = pack8(x0, x1);
                }
            }
    }
};
struct EpiKV {
    static constexpr bool PERM = true, AFTER_DRAIN = false;
    bf16_t *MK, *MV; const float* RKVSS;
    __device__ __forceinline__ void operator()(const f32x4 (&acc)[2][2][4][2], const Unit& u, int wr, int wc, int fr, int fq) const {
#pragma unroll
        for (int ai = 0; ai < 2; ++ai)
#pragma unroll
            for (int m = 0; m < 4; ++m) {
                const int row = u.pm * BM + ai * HALF + wr * 64 + m * 16 + fr;
                const f32x4 s4 = *(const f32x4*)(RKVSS + (size_t)row * 4);
                const float rs = __builtin_amdgcn_rsqf(((s4[0] + s4[1]) + (s4[2] + s4[3])) * (1.0f / 128.0f) + kEps);
#pragma unroll
                for (int bj = 0; bj < 2; ++bj) {
                    const int h = u.pn * 2 + bj;
                    bf16_t* dst = (wc < 2) ? (MK + (size_t)row * 768 + h * 96 + wc * 32 + fq * 8) : (MV + (size_t)row * 512 + h * 64 + (wc - 2) * 32 + fq * 8);
                    *(u32x4e*)dst = pack8(acc[ai][bj][m][0] * rs, acc[ai][bj][m][1] * rs);
                }
            }
    }
};
struct EpiStat {
    static constexpr bool PERM = true, AFTER_DRAIN = false;
    bf16_t* OUT; float* SS;
    __device__ __forceinline__ void operator()(const f32x4 (&acc)[2][2][4][2], const Unit& u, int wr, int wc, int fr, int fq) const {
#pragma unroll
        for (int ai = 0; ai < 2; ++ai)
#pragma unroll
            for (int m = 0; m < 4; ++m) {
                const int row = u.pm * BM + ai * HALF + wr * 64 + m * 16 + fr;
                bf16_t* dst = OUT + (size_t)row * 1024 + u.pn * BM + wc * 32 + fq * 8; float ss = 0.f;
#pragma unroll
                for (int bj = 0; bj < 2; ++bj) { const f32x4 v0 = acc[ai][bj][m][0], v1 = acc[ai][bj][m][1];
                    u32x4e w; w.x = cvt_pk_bf16(v0[0], v0[1]); w.y = cvt_pk_bf16(v0[2], v0[3]); w.z = cvt_pk_bf16(v1[0], v1[1]); w.w = cvt_pk_bf16(v1[2], v1[3]);
                    *(u32x4e*)(dst + bj * HALF) = w; ss += sumsq4(v0) + sumsq4(v1); }
                ss += __shfl_xor(ss, 16); ss += __shfl_xor(ss, 32);
                if (fq == 0) SS[(size_t)row * 16 + u.pn * 4 + wc] = ss;
            }
    }
};
struct EpiFinal {
    static constexpr bool PERM = true, AFTER_DRAIN = false;
    const float* x; const bf16_t* Y; const bf16_t* PLE; const float* RY; const float* RP; const float* gpost; const float* gple; const float* bias; float* out;
    __device__ __forceinline__ void operator()(const f32x4 (&acc)[2][2][4][2], const Unit& u, int wr, int wc, int fr, int fq) const {
#pragma unroll
        for (int ai = 0; ai < 2; ++ai)
#pragma unroll
            for (int m = 0; m < 4; ++m) {
                const int row = u.pm * BM + ai * HALF + wr * 64 + m * 16 + fr;
                const float ry = RY[row], rp = RP[row];
#pragma unroll
                for (int bj = 0; bj < 2; ++bj) {
                    const int col = u.pn * BM + bj * HALF + wc * 32 + fq * 8; const size_t off = (size_t)row * 1024 + col;
                    const u32x4e yw = *(const u32x4e*)(Y + off), pw = *(const u32x4e*)(PLE + off);
#pragma unroll
                    for (int n = 0; n < 2; ++n) {
                        const f32x4 gp = *(const f32x4*)(gpost + col + 4 * n), gl = *(const f32x4*)(gple + col + 4 * n), bb = *(const f32x4*)(bias + col + 4 * n);
                        const f32x4 xv = *(const f32x4*)(x + off + 4 * n);
                        const f32x4 yv = unpack4((u32x2){n == 0 ? yw.x : yw.z, n == 0 ? yw.y : yw.w}), pv = unpack4((u32x2){n == 0 ? pw.x : pw.z, n == 0 ? pw.y : pw.w});
                        const f32x4 gt = acc[ai][bj][m][n] + bb; f32x4 o;
#pragma unroll
                        for (int e = 0; e < 4; ++e) o[e] = (xv[e] + yv[e] * ry * gp[e]) + pv[e] * rp * gl[e] * sigmoid_f(gt[e]);
                        *(f32x4*)(out + off + 4 * n) = o;
                    }
                }
            }
    }
};
template <class Epi, class Sched, bool ALIGN_EPI = false, bool SP2 = false>
__device__ __forceinline__ void gemm_phase(PG8_LAS unsigned char* lds, const Gemm g, const Sched& S, const Epi& E) {
    const int tid = threadIdx.x, wid = __builtin_amdgcn_readfirstlane(tid >> 6), lane = tid & 63, wr = wid >> 2, wc = wid & 3, fr = lane & 15, fq = lane >> 4;
    const int K = g.K, nt = K / BK;
    unsigned voffA[2], voffB[2];
#pragma unroll
    for (int i = 0; i < 2; ++i) { int R, C; stage_rc(tid * 16 + i * 8192, R, C); const int Rb = Epi::PERM ? ((R & ~31) + perm32(R & 31)) : R;
        voffA[i] = (unsigned)(R * K + C) * 2u; voffB[i] = (unsigned)(Rb * K + C) * 2u; }
    const size_t kstep = (size_t)(BK * 2);
    const size_t hstep = (size_t)HALF * K * 2;
    const size_t tstep = 2 * hstep;
    const unsigned ldsw = (unsigned)wid * 1024u;
    const int aoff = lds_byte(wr * 64 + fr, fq * 8), boff = lds_byte(wc * 32 + fr, fq * 8);
#define PG8_SA(b, h) (((b) * 2 + (h)) * HTB)
#define PG8_SB(b, h) ((4 + (b) * 2 + (h)) * HTB)
#define PG8_STAGE(bufoff, gbase, voff) do { _Pragma("unroll") for (int _i = 0; _i < 2; ++_i) \
        __builtin_amdgcn_global_load_lds((const unsigned*)((const char*)(gbase) + (voff)[_i]), (PG8_LAS unsigned*)(lds + (bufoff) + ldsw + _i * 8192), 16, 0, 0); } while (0)
#define PG8_LDA(dst, b, h) do { _Pragma("unroll") for (int m = 0; m < 4; ++m) _Pragma("unroll") for (int k = 0; k < 2; ++k) dst[m][k] = *(const PG8_LAS bf16x8*)(lds + PG8_SA(b, h) + aoff + m * 2048 + k * 1024); } while (0)
#define PG8_LDB(dst, b, h) do { _Pragma("unroll") for (int n = 0; n < 2; ++n) _Pragma("unroll") for (int k = 0; k < 2; ++k) dst[n][k] = *(const PG8_LAS bf16x8*)(lds + PG8_SB(b, h) + boff + n * 2048 + k * 1024); } while (0)
#define PG8_MMA(ai, bj, At, Bt) do { __builtin_amdgcn_s_setprio(1); _Pragma("unroll") for (int m = 0; m < 4; ++m) _Pragma("unroll") for (int n = 0; n < 2; ++n) _Pragma("unroll") for (int k = 0; k < 2; ++k) \
        acc[ai][bj][m][n] = __builtin_amdgcn_mfma_f32_16x16x32_bf16(Bt[n][k], At[m][k], acc[ai][bj][m][n], 0, 0, 0); __builtin_amdgcn_s_setprio(0); } while (0)
#define PG8_WAIT_V(n) asm volatile("s_waitcnt vmcnt(" #n ")" ::: "memory")
#define PG8_WAIT_L(n) asm volatile("s_waitcnt lgkmcnt(" #n ")" ::: "memory")
#define PG8_BAR __builtin_amdgcn_s_barrier()
#define PG8_SCHED __builtin_amdgcn_sched_barrier(0)
    Unit cur, nxt; int ui = 0;
    if (!S.next(0, cur)) return;
    f32x4 acc[2][2][4][2];
#pragma unroll
    for (int a = 0; a < 2; ++a)
#pragma unroll
        for (int b = 0; b < 2; ++b)
#pragma unroll
            for (int m = 0; m < 4; ++m)
#pragma unroll
                for (int n = 0; n < 2; ++n) acc[a][b][m][n] = (f32x4){0.f, 0.f, 0.f, 0.f};
    bf16x8 At[4][2], B0[2][2], B1[2][2];
    const char* cA = (const char*)g.A + (size_t)cur.pm * tstep; const char* cB = (const char*)g.Bt + (size_t)cur.pn * tstep;
    S.a_ready(cur);
    if constexpr (SP2) {
        PG8_STAGE(PG8_SB(0, 0), cB, voffB); PG8_STAGE(PG8_SB(0, 1), cB + hstep, voffB); PG8_STAGE(PG8_SA(0, 0), cA, voffA); PG8_STAGE(PG8_SA(0, 1), cA + hstep, voffA);
        if (wr == 1) PG8_BAR;
        PG8_WAIT_V(2); PG8_BAR;
        PG8_STAGE(PG8_SB(1, 0), cB + kstep, voffB); PG8_STAGE(PG8_SA(1, 0), cA + kstep, voffA); PG8_STAGE(PG8_SB(1, 1), cB + hstep + kstep, voffB);
        PG8_WAIT_V(6); PG8_BAR;
    } else {
        PG8_STAGE(PG8_SB(0, 0), cB, voffB); PG8_STAGE(PG8_SA(0, 0), cA, voffA); PG8_STAGE(PG8_SB(0, 1), cB + hstep, voffB); PG8_STAGE(PG8_SA(0, 1), cA + hstep, voffA);
        if (wr == 1) PG8_BAR;
        PG8_WAIT_V(4); PG8_BAR;
        PG8_STAGE(PG8_SB(1, 0), cB + kstep, voffB); PG8_STAGE(PG8_SA(1, 0), cA + kstep, voffA); PG8_STAGE(PG8_SB(1, 1), cB + hstep + kstep, voffB);
        PG8_WAIT_V(6); PG8_BAR;
    }
    for (;;) {
        const bool has_next = S.next(ui + 1, nxt);
        const char* nA = has_next ? (const char*)g.A + (size_t)nxt.pm * tstep : cA; const char* nB = has_next ? (const char*)g.Bt + (size_t)nxt.pn * tstep : cB;
        for (int t = 0; t < nt; t += 2) {
            const bool last = (t == nt - 2);
            const char* a1 = cA + (size_t)(t + 1) * kstep;
            const char* a2 = last ? nA : cA + (size_t)(t + 2) * kstep; const char* b2 = last ? nB : cB + (size_t)(t + 2) * kstep;
            const char* a3 = a2 + kstep; const char* b3 = b2 + kstep;
            if (last && has_next) S.a_ready(nxt);
            if constexpr (SP2) {
            PG8_LDB(B0, 0, 0); PG8_LDB(B1, 0, 1); PG8_SCHED; PG8_LDA(At, 0, 0); PG8_STAGE(PG8_SA(1, 1), a1 + hstep, voffA);
            PG8_WAIT_V(8); PG8_WAIT_L(0); PG8_BAR; PG8_MMA(0, 0, At, B0); PG8_MMA(0, 1, At, B1); PG8_BAR; PG8_SCHED;
            PG8_LDA(At, 0, 1); PG8_STAGE(PG8_SB(0, 0), b2, voffB); PG8_STAGE(PG8_SB(0, 1), b2 + hstep, voffB); PG8_STAGE(PG8_SA(0, 0), a2, voffA);
            PG8_WAIT_V(8); PG8_WAIT_L(0); PG8_BAR; PG8_MMA(1, 0, At, B0); PG8_MMA(1, 1, At, B1); PG8_BAR; PG8_SCHED;
            PG8_LDB(B0, 1, 0); PG8_LDB(B1, 1, 1); PG8_SCHED; PG8_LDA(At, 1, 0); PG8_STAGE(PG8_SA(0, 1), a2 + hstep, voffA);
            PG8_WAIT_V(8); PG8_WAIT_L(0); PG8_BAR; PG8_MMA(0, 0, At, B0); PG8_MMA(0, 1, At, B1); PG8_BAR; PG8_SCHED;
            PG8_LDA(At, 1, 1); PG8_STAGE(PG8_SB(1, 0), b3, voffB); PG8_STAGE(PG8_SB(1, 1), b3 + hstep, voffB); PG8_STAGE(PG8_SA(1, 0), a3, voffA);
            PG8_WAIT_V(8); PG8_WAIT_L(0); PG8_BAR; PG8_MMA(1, 0, At, B0); PG8_MMA(1, 1, At, B1); PG8_BAR; PG8_SCHED;
            } else {
            PG8_LDB(B0, 0, 0); PG8_SCHED; PG8_LDA(At, 0, 0); PG8_STAGE(PG8_SA(1, 1), a1 + hstep, voffA);
            PG8_WAIT_L(8); PG8_BAR; PG8_WAIT_L(0); PG8_MMA(0, 0, At, B0); PG8_BAR; PG8_SCHED;
            PG8_LDB(B1, 0, 1); PG8_STAGE(PG8_SB(0, 0), b2, voffB);
            PG8_BAR; PG8_WAIT_L(0); PG8_MMA(0, 1, At, B1); PG8_BAR;
            PG8_LDA(At, 0, 1); PG8_STAGE(PG8_SA(0, 0), a2, voffA);
            PG8_BAR; PG8_WAIT_L(0); PG8_MMA(1, 0, At, B0); PG8_BAR; PG8_SCHED;
            PG8_STAGE(PG8_SB(0, 1), b2 + hstep, voffB);
            PG8_WAIT_V(6); PG8_BAR; PG8_MMA(1, 1, At, B1); PG8_BAR;
            PG8_LDB(B0, 1, 0); PG8_SCHED; PG8_LDA(At, 1, 0); PG8_STAGE(PG8_SA(0, 1), a2 + hstep, voffA);
            PG8_WAIT_L(8); PG8_BAR; PG8_WAIT_L(0); PG8_MMA(0, 0, At, B0); PG8_BAR; PG8_SCHED;
            PG8_LDB(B1, 1, 1); PG8_STAGE(PG8_SB(1, 0), b3, voffB);
            PG8_BAR; PG8_WAIT_L(0); PG8_MMA(0, 1, At, B1); PG8_BAR;
            PG8_LDA(At, 1, 1); PG8_STAGE(PG8_SA(1, 0), a3, voffA);
            PG8_BAR; PG8_WAIT_L(0); PG8_MMA(1, 0, At, B0); PG8_BAR; PG8_SCHED;
            PG8_STAGE(PG8_SB(1, 1), b3 + hstep, voffB);
            PG8_WAIT_V(6); PG8_BAR; PG8_MMA(1, 1, At, B1); PG8_BAR;
            }
        }
        if constexpr (ALIGN_EPI) { if (wr == 0) PG8_BAR; }
        if constexpr (!Epi::AFTER_DRAIN) { E(acc, cur, wr, wc, fr, fq); S.done(cur); }
        if (!has_next) break;
#pragma unroll
        for (int a = 0; a < 2; ++a)
#pragma unroll
            for (int b = 0; b < 2; ++b)
#pragma unroll
                for (int m = 0; m < 4; ++m)
#pragma unroll
                    for (int n = 0; n < 2; ++n) acc[a][b][m][n] = (f32x4){0.f, 0.f, 0.f, 0.f};
        cur = nxt; cA = nA; cB = nB; ++ui;
        if constexpr (ALIGN_EPI) { if (wr == 1) PG8_BAR; }
    }
    PG8_WAIT_V(0);
    if constexpr (!ALIGN_EPI) { if (wr == 0) PG8_BAR; }
    PG8_BAR;
    if constexpr (Epi::AFTER_DRAIN) { E.fused(acc, cur, wr, wc, fr, fq, lds, wid, lane); S.done(cur); }
#undef PG8_SA
#undef PG8_SB
#undef PG8_STAGE
#undef PG8_LDA
#undef PG8_LDB
#undef PG8_MMA
#undef PG8_WAIT_V
#undef PG8_WAIT_L
#undef PG8_BAR
#undef PG8_SCHED
}
}
namespace att {
using bf16x8 = __attribute__((ext_vector_type(8))) short;
using s16x4 = __attribute__((ext_vector_type(4))) short;
using f32x16 = __attribute__((ext_vector_type(16))) float;
using f32x4 = __attribute__((ext_vector_type(4))) float;
using u32x4 = __attribute__((ext_vector_type(4))) unsigned;
typedef unsigned short bf16_t;
#define ALAS __attribute__((address_space(3)))
constexpr int SEQ = 4096, KSLOT = 16384, VSLOT = 8192, NSLOT = 3;
constexpr int L_K = 0, L_V = NSLOT * KSLOT, L_WS = L_V + NSLOT * VSLOT, L_FLAG = L_WS + 8 * 64 * 4, L_OST = L_FLAG + 256, L_END = L_OST + 8 * 8192;
constexpr float kEps = 1e-6f;
constexpr float SB_DONE = 151.0f;
__device__ __forceinline__ int crow(int r, int hi) { return (r & 3) + 8 * (r >> 2) + 4 * hi; }
__device__ __forceinline__ void glds16(const void* gsrc, unsigned lds_dst) { unsigned keep;
    asm volatile("s_mov_b32 %0, m0\n\ts_mov_b32 m0, %2\n\ts_nop 0\n\tglobal_load_lds_dwordx4 %1, off\n\ts_mov_b32 m0, %0" : "=&s"(keep) : "v"(gsrc), "s"(lds_dst) : "memory"); }
typedef float f32x2_t __attribute__((ext_vector_type(2))); typedef __bf16 bf16x2_t __attribute__((ext_vector_type(2)));
__device__ __forceinline__ unsigned cvtpk(float lo, float hi) { f32x2_t v = {lo, hi}; bf16x2_t b = __builtin_convertvector(v, bf16x2_t); return __builtin_bit_cast(unsigned, b); }
#define A_WAIT_BAR(N) asm volatile("s_waitcnt vmcnt(" #N ") lgkmcnt(0)\n\ts_barrier" ::: "memory")

template <int ND0> __device__ __forceinline__ void qkt(f32x16& p0, f32x16& p1, const ALAS char* Kslot, const bf16x8* qr, int r32, int hi) {
    const ALAS char* kb = Kslot + hi * 1024 + r32 * 16;
    p0 = f32x16{}; p1 = f32x16{};
#pragma unroll
    for (int d0 = 0; d0 < ND0; ++d0) {
        const bf16x8 b0 = *(const ALAS bf16x8*)(kb + d0 * 2048);
        const bf16x8 b1 = *(const ALAS bf16x8*)(kb + d0 * 2048 + 512);
        p0 = __builtin_amdgcn_mfma_f32_32x32x16_bf16(b0, qr[d0], p0, 0, 0, 0);
        p1 = __builtin_amdgcn_mfma_f32_32x32x16_bf16(b1, qr[d0], p1, 0, 0, 0);
    }
}
__device__ __forceinline__ void pv(f32x16* o, int vb, bf16x8 pa0, bf16x8 pa1, bf16x8 pa2, bf16x8 pa3) {
#pragma unroll
    for (int d0 = 0; d0 < 2; ++d0) { s16x4 lo[4], hi[4];
#pragma unroll
        for (int ks = 0; ks < 4; ++ks) {
            asm volatile("ds_read_b64_tr_b16 %0,%1 offset:%c2" : "=&v"(lo[ks]) : "v"(vb), "i"(d0 * 4096 + ks * 1024) : "memory");
            asm volatile("ds_read_b64_tr_b16 %0,%1 offset:%c2" : "=&v"(hi[ks]) : "v"(vb), "i"(d0 * 4096 + ks * 1024 + 512) : "memory"); }
        asm volatile("s_waitcnt lgkmcnt(0)" ::: "memory"); __builtin_amdgcn_sched_barrier(0);
#define A_PK(k) (bf16x8){lo[k][0], lo[k][1], lo[k][2], lo[k][3], hi[k][0], hi[k][1], hi[k][2], hi[k][3]}
        o[d0] = __builtin_amdgcn_mfma_f32_32x32x16_bf16(pa0, A_PK(0), o[d0], 0, 0, 0);
        o[d0] = __builtin_amdgcn_mfma_f32_32x32x16_bf16(pa1, A_PK(1), o[d0], 0, 0, 0);
        o[d0] = __builtin_amdgcn_mfma_f32_32x32x16_bf16(pa2, A_PK(2), o[d0], 0, 0, 0);
        o[d0] = __builtin_amdgcn_mfma_f32_32x32x16_bf16(pa3, A_PK(3), o[d0], 0, 0, 0);
#undef A_PK
    }
}
typedef short v4i16_t __attribute__((ext_vector_type(4)));
__device__ __forceinline__ s16x4 vtr(const ALAS char* p) { return __builtin_bit_cast(s16x4, __builtin_amdgcn_ds_read_tr16_b64_v4i16((ALAS v4i16_t*)p)); }
__device__ __forceinline__ float xhalf_sum(float v) { auto rr = __builtin_amdgcn_permlane32_swap(__float_as_uint(v), __float_as_uint(v), false, false); return __uint_as_float(rr[0]) + __uint_as_float(rr[1]); }
__device__ __forceinline__ float xhalf_max(float v) { auto rr = __builtin_amdgcn_permlane32_swap(__float_as_uint(v), __float_as_uint(v), false, false); return fmaxf(__uint_as_float(rr[0]), __uint_as_float(rr[1])); }

template <bool SBK> __device__ __forceinline__ void attn_unit(int b, int h, int qb, const bf16_t* Q, const bf16_t* K, const bf16_t* V, const bf16_t* gate, const float* gnorm, bf16_t* out, int goff, ALAS char* shm) {
    constexpr int DQK = SBK ? 64 : 96, QP = SBK ? 512 : 768, ND0 = DQK / 16;
    const int tid = threadIdx.x, lane = tid & 63, r32 = lane & 31, hi = lane >> 5; const int wid = __builtin_amdgcn_readfirstlane(tid >> 6);
    const long rowbase = (long)b * SEQ; const int q0 = qb * 256;
    const bf16_t* Qw = Q + (rowbase + q0 + wid * 32) * QP + h * DQK;
    const bf16_t* Kh = K + rowbase * QP + h * DQK; const bf16_t* Vh = V + rowbase * 512 + h * 64;
    const unsigned lds0 = (unsigned)(uintptr_t)shm;
    ALAS float* wsf = (ALAS float*)(shm + L_WS) + wid * 64;
    ALAS unsigned* flags = (ALAS unsigned*)(shm + L_FLAG);
    const bf16_t* ksrc = Kh + (long)lane * QP + wid * 8;
    const bf16_t* ksrc2 = Kh + (long)lane * QP + (8 + (wid & 3)) * 8;
    const bf16_t* vsrc = Vh + (long)(16 * (wid & 3) + (lane >> 2)) * 512 + (wid >> 2) * 32 + (lane & 3) * 8;
    const unsigned kdst = lds0 + L_K + wid * 1024, vdst = lds0 + L_V + wid * 1024;
    const int NT = 4 * qb + 4;
    const int tw = 4 * qb + (wid >> 1);
#define A_TILE(i) (SBK ? (NT - 1 - (i)) : (i))
#define A_DMA(i, s) do { const int t_ = A_TILE(i); glds16(ksrc + (long)t_ * 64 * QP, (unsigned)__builtin_amdgcn_readfirstlane(kdst + (s) * KSLOT)); \
        if (!SBK) glds16(ksrc2 + (long)t_ * 64 * QP, (unsigned)__builtin_amdgcn_readfirstlane(kdst + 8192 + (s) * KSLOT)); \
        glds16(vsrc + (long)t_ * 64 * 512, (unsigned)__builtin_amdgcn_readfirstlane(vdst + (s) * VSLOT)); } while (0)
    A_DMA(0, 0); A_DMA(1, 1);
    bf16x8 qr[ND0];
#pragma unroll
    for (int d0 = 0; d0 < ND0; ++d0) qr[d0] = *(const bf16x8*)(Qw + (long)r32 * QP + d0 * 16 + hi * 8);
    f32x16 o[2]; o[0] = f32x16{}; o[1] = f32x16{};
    float m_run = -INFINITY, l_run = 0.f, carry = 0.f;
    const int vb0 = (int)(lds0 + L_V) + ((lane >> 4) & 1) * 32 + (lane & 3) * 8 + (4 * hi + ((lane & 15) >> 2)) * 64;
    int slot = 0;
    for (int i = 0; i < NT; ++i) {
        if (i + 1 < NT) { if (SBK) { A_WAIT_BAR(2); } else { A_WAIT_BAR(3); } } else { A_WAIT_BAR(0); }
        if (SBK && i > 0) {
            const ALAS unsigned* fl = flags + ((i - 1) & 1) * 8; unsigned all = 1u;
#pragma unroll
            for (int w = 0; w < 8; ++w) all &= fl[w];
            if (all) break;
        }
        if (i + 2 < NT) { const int s2 = (slot >= 1) ? slot - 1 : slot + 2; A_DMA(i + 2, s2); }
        const int t = A_TILE(i);
        if (t <= tw) {
            f32x16 p0, p1;
            qkt<ND0>(p0, p1, shm + L_K + slot * KSLOT, qr, r32, hi);
            if (SBK) {
                if (t == tw) { const int qrel = 32 * (wid & 1) + r32;
#pragma unroll
                    for (int r = 0; r < 16; ++r) { const int kv = crow(r, hi); if (kv >= qrel) p0[r] = -INFINITY; if (kv + 32 >= qrel) p1[r] = -INFINITY; } }
                f32x16 s0, s1;
#pragma unroll
                for (int r = 0; r < 16; ++r) {
                    s0[r] = fmaxf(p0[r], 0.f) + __builtin_amdgcn_logf(1.0f + __builtin_amdgcn_exp2f(-fabsf(p0[r])));
                    s1[r] = fmaxf(p1[r], 0.f) + __builtin_amdgcn_logf(1.0f + __builtin_amdgcn_exp2f(-fabsf(p1[r])));
                }
                float lo_[8], up_[8];
#pragma unroll
                for (int i4 = 0; i4 < 8; ++i4) {
                    const float bs = (i4 < 4) ? ((s0[4 * i4] + s0[4 * i4 + 1]) + (s0[4 * i4 + 2] + s0[4 * i4 + 3])) : ((s1[4 * i4 - 16] + s1[4 * i4 - 15]) + (s1[4 * i4 - 14] + s1[4 * i4 - 13]));
                    auto rr = __builtin_amdgcn_permlane32_swap(__float_as_uint(bs), __float_as_uint(bs), false, false);
                    lo_[i4] = __uint_as_float(rr[0]); up_[i4] = __uint_as_float(rr[1]);
                }
                float run = carry;
#pragma unroll
                for (int i4 = 7; i4 >= 0; --i4) {
                    float c = run + (hi == 0 ? up_[i4] : 0.f);
#pragma unroll
                    for (int e = 3; e >= 0; --e) {
                        if (i4 < 4) { c += s0[4 * i4 + e]; p0[4 * i4 + e] = __builtin_amdgcn_exp2f(p0[4 * i4 + e] - c); }
                        else { c += s1[4 * i4 - 16 + e]; p1[4 * i4 - 16 + e] = __builtin_amdgcn_exp2f(p1[4 * i4 - 16 + e] - c); }
                    }
                    run += lo_[i4] + up_[i4];
                }
                carry = run;
            } else {
                float rm = fmaxf(p0[0], p1[0]);
#pragma unroll
                for (int r = 1; r < 16; ++r) rm = fmaxf(rm, fmaxf(p0[r], p1[r]));
                rm = xhalf_max(rm);
                const float m_new = fmaxf(m_run, rm);
                const float alpha = __builtin_amdgcn_exp2f(m_run - m_new);
                float ls = 0.f;
#pragma unroll
                for (int r = 0; r < 16; ++r) { p0[r] = __builtin_amdgcn_exp2f(p0[r] - m_new); p1[r] = __builtin_amdgcn_exp2f(p1[r] - m_new); ls += p0[r] + p1[r]; }
                l_run = l_run * alpha + ls; m_run = m_new;
                if (!__all(alpha == 1.0f)) {
                    if (hi == 0) wsf[r32] = alpha;
#pragma unroll
                    for (int r = 0; r < 16; ++r) { const float f = wsf[crow(r, hi)]; o[0][r] *= f; o[1][r] *= f; }
                }
            }
            u32x4 pw0, pw1, pw2, pw3;
            pw0 = (u32x4){cvtpk(p0[0], p0[1]), cvtpk(p0[2], p0[3]), cvtpk(p0[4], p0[5]), cvtpk(p0[6], p0[7])};
            pw1 = (u32x4){cvtpk(p0[8], p0[9]), cvtpk(p0[10], p0[11]), cvtpk(p0[12], p0[13]), cvtpk(p0[14], p0[15])};
            pw2 = (u32x4){cvtpk(p1[0], p1[1]), cvtpk(p1[2], p1[3]), cvtpk(p1[4], p1[5]), cvtpk(p1[6], p1[7])};
            pw3 = (u32x4){cvtpk(p1[8], p1[9]), cvtpk(p1[10], p1[11]), cvtpk(p1[12], p1[13]), cvtpk(p1[14], p1[15])};
            pv(o, vb0 + slot * VSLOT, __builtin_bit_cast(bf16x8, pw0), __builtin_bit_cast(bf16x8, pw1), __builtin_bit_cast(bf16x8, pw2), __builtin_bit_cast(bf16x8, pw3));
        }
        if (SBK) { const bool done = (t <= tw) && __all(carry > SB_DONE); if (lane == 0) flags[(i & 1) * 8 + wid] = done ? 1u : 0u; }
        slot = (slot == NSLOT - 1) ? 0 : slot + 1;
    }
    A_WAIT_BAR(0);
    float rli[16];
    if (!SBK) {
        const float lt = xhalf_sum(l_run);
        if (hi == 0) wsf[32 + r32] = lt;
#pragma unroll
        for (int r = 0; r < 16; ++r) rli[r] = __builtin_amdgcn_rcpf(wsf[32 + crow(r, hi)]);
    } else {
#pragma unroll
        for (int r = 0; r < 16; ++r) rli[r] = 1.0f;
    }
    ALAS float* stg = (ALAS float*)(shm + L_OST) + wid * 2048;
#pragma unroll
    for (int r = 0; r < 16; ++r) { const int orow = crow(r, hi);
#pragma unroll
        for (int d0 = 0; d0 < 2; ++d0) stg[orow * 64 + d0 * 32 + r32] = o[d0][r] * rli[r]; }
    const long grow0 = rowbase + q0 + wid * 32;
#pragma unroll
    for (int i = 0; i < 4; ++i) {
        const int row = i * 8 + (lane >> 3), ch = lane & 7;
        const f32x4 a = *(const ALAS f32x4*)(stg + row * 64 + ch * 8), c = *(const ALAS f32x4*)(stg + row * 64 + ch * 8 + 4);
        float ss = ((a[0] * a[0] + a[1] * a[1]) + (a[2] * a[2] + a[3] * a[3])) + ((c[0] * c[0] + c[1] * c[1]) + (c[2] * c[2] + c[3] * c[3]));
        ss += __shfl_xor(ss, 1); ss += __shfl_xor(ss, 2); ss += __shfl_xor(ss, 4);
        const float rn = 1.0f / sqrtf(ss * (1.0f / 64.0f) + kEps);
        const size_t off = (size_t)(grow0 + row) * 1024 + goff + h * 64 + ch * 8;
        const u32x4 gv = *(const u32x4*)(gate + off);
        const f32x4 g0 = *(const f32x4*)(gnorm + h * 64 + ch * 8), g1 = *(const f32x4*)(gnorm + h * 64 + ch * 8 + 4);
        float v[8];
#pragma unroll
        for (int e = 0; e < 4; ++e) { v[e] = a[e] * rn * g0[e]; v[4 + e] = c[e] * rn * g1[e]; }
        u32x4 w;
#pragma unroll
        for (int e = 0; e < 4; ++e) { const unsigned gw = gv[e]; w[e] = cvtpk(v[2 * e] * __uint_as_float(gw << 16), v[2 * e + 1] * __uint_as_float(gw & 0xffff0000u)); }
        *(u32x4*)(out + off) = w;
    }
    A_WAIT_BAR(0);
#undef A_TILE
#undef A_DMA
}

constexpr int M_K = 0, M_V = NSLOT * KSLOT, M_WS = M_V + 4 * VSLOT, M_END = M_WS + 8 * 64 * 4;
constexpr float MLA_THR = 8.0f;
#define A_BAR_L() asm volatile("s_waitcnt lgkmcnt(0)\n\ts_barrier" ::: "memory")
__device__ __forceinline__ void mla_unit(int b, int h, int qb, const bf16_t* Q, const bf16_t* K, const bf16_t* V, const bf16_t* gate, const float* gnorm, bf16_t* out, int goff, ALAS char* shm) {
    constexpr int QP = 768, ND0 = 6;
    const int tid = threadIdx.x, lane = tid & 63, r32 = lane & 31, hi = lane >> 5; const int wid = __builtin_amdgcn_readfirstlane(tid >> 6);
    const int grp = wid >> 2;
    const long rowbase = (long)b * SEQ; const int q0 = qb * 256;
    const bf16_t* Qw = Q + (rowbase + q0 + wid * 32) * QP + h * 96;
    const bf16_t* Kh = K + rowbase * QP + h * 96; const bf16_t* Vh = V + rowbase * 512 + h * 64;
    const unsigned lds0 = (unsigned)(uintptr_t)shm;
    ALAS float* wsf = (ALAS float*)(shm + M_WS) + wid * 64;
    const bf16_t* ksrc = Kh + (long)lane * QP + wid * 8;
    const bf16_t* ksrc2 = Kh + (long)lane * QP + (8 + (wid & 3)) * 8;
    const bf16_t* vsrc = Vh + (long)(16 * (wid & 3) + (lane >> 2)) * 512 + (wid >> 2) * 32 + (lane & 3) * 8;
    const unsigned kdst = lds0 + M_K + wid * 1024, vdst = lds0 + M_V + wid * 1024;
    const int NT = 4 * qb + 4, tw = 4 * qb + (wid >> 1);
#define M_DMA(t_) do { const int tt_ = (t_); const int ks_ = tt_ % 3, vs_ = tt_ & 3; glds16(ksrc + (long)tt_ * 64 * QP, (unsigned)__builtin_amdgcn_readfirstlane(kdst + ks_ * KSLOT)); \
        glds16(ksrc2 + (long)tt_ * 64 * QP, (unsigned)__builtin_amdgcn_readfirstlane(kdst + 8192 + ks_ * KSLOT)); \
        glds16(vsrc + (long)tt_ * 64 * 512, (unsigned)__builtin_amdgcn_readfirstlane(vdst + vs_ * VSLOT)); } while (0)
    M_DMA(0); M_DMA(1);
    bf16x8 qr[ND0];
#pragma unroll
    for (int d0 = 0; d0 < ND0; ++d0) qr[d0] = *(const bf16x8*)(Qw + (long)r32 * QP + d0 * 16 + hi * 8);
    f32x16 o[2]; o[0] = f32x16{}; o[1] = f32x16{};
    f32x16 negm = f32x16{}; f32x16 p0 = f32x16{}, p1 = f32x16{};
    u32x4 pw0 = {0u, 0u, 0u, 0u}, pw1 = pw0, pw2 = pw0, pw3 = pw0;
    float m_hat = 0.f, l_run = 0.f; bool need = false;
    const int vb0 = (int)(lds0 + M_V) + ((lane >> 4) & 1) * 32 + (lane & 3) * 8 + (4 * hi + ((lane & 15) >> 2)) * 64;
    const int voff = ((lane >> 4) & 1) * 32 + (lane & 3) * 8 + (4 * hi + ((lane & 15) >> 2)) * 64;
#define M_BAR_EVEN(t_) do { if ((t_) + 1 < NT) { A_WAIT_BAR(3); } else { A_WAIT_BAR(0); } if ((t_) + 2 < NT) M_DMA((t_) + 2); } while (0)
#define M_KLD(d0) do { kf_[2 * (d0)] = *(const ALAS bf16x8*)(kb_ + (d0) * 2048); kf_[2 * (d0) + 1] = *(const ALAS bf16x8*)(kb_ + (d0) * 2048 + 512); } while (0)
#define M_QK(d0) do { p0 = __builtin_amdgcn_mfma_f32_32x32x16_bf16(kf_[2 * (d0)], qr[d0], (d0) == 0 ? negm : p0, 0, 0, 0); p1 = __builtin_amdgcn_mfma_f32_32x32x16_bf16(kf_[2 * (d0) + 1], qr[d0], (d0) == 0 ? negm : p1, 0, 0, 0); } while (0)
#define M_STAGE_A(t_) do { const int ta_ = (t_); \
        const ALAS char* vp_ = shm + M_V + ((ta_ - 1) & 3) * VSLOT + voff; const ALAS char* kb_ = shm + M_K + (ta_ % 3) * KSLOT + hi * 1024 + r32 * 16; \
        s16x4 vl_[4], vh_[4]; bf16x8 kf_[12]; \
        _Pragma("unroll") for (int ks = 0; ks < 4; ++ks) { vl_[ks] = vtr(vp_ + ks * 1024); vh_[ks] = vtr(vp_ + ks * 1024 + 512); } \
        M_KLD(0); M_KLD(1); \
        __builtin_amdgcn_sched_barrier(0); \
        if (need) { _Pragma("unroll") for (int r = 0; r < 16; ++r) { const float f = wsf[crow(r, hi)]; o[0][r] *= f; o[1][r] *= f; } } \
        _Pragma("unroll") for (int ks = 0; ks < 4; ++ks) o[0] = __builtin_amdgcn_mfma_f32_32x32x16_bf16(M_PA(ks), M_VF(ks), o[0], 0, 0, 0); \
        __builtin_amdgcn_sched_barrier(0); \
        M_KLD(2); M_KLD(3); \
        __builtin_amdgcn_sched_barrier(0); \
        M_QK(0); M_QK(1); \
        __builtin_amdgcn_sched_barrier(0); \
        _Pragma("unroll") for (int ks = 0; ks < 4; ++ks) { vl_[ks] = vtr(vp_ + 4096 + ks * 1024); vh_[ks] = vtr(vp_ + 4096 + ks * 1024 + 512); } \
        M_KLD(4); M_KLD(5); \
        __builtin_amdgcn_sched_barrier(0); \
        M_QK(2); M_QK(3); M_QK(4); M_QK(5); \
        _Pragma("unroll") for (int ks = 0; ks < 4; ++ks) o[1] = __builtin_amdgcn_mfma_f32_32x32x16_bf16(M_PA(ks), M_VF(ks), o[1], 0, 0, 0); } while (0)
      \
#define M_STAGE_A_SW(t_, PVON, QKON) do { const int ta_ = (t_); \
        if (PVON) { \
            if (need) { _Pragma("unroll") for (int r = 0; r < 16; ++r) { const float f = wsf[crow(r, hi)]; o[0][r] *= f; o[1][r] *= f; } } \
            pv(o, vb0 + ((ta_ - 1) & 3) * VSLOT, __builtin_bit_cast(bf16x8, pw0), __builtin_bit_cast(bf16x8, pw1), __builtin_bit_cast(bf16x8, pw2), __builtin_bit_cast(bf16x8, pw3)); } \
        if (QKON) { const ALAS char* kb = shm + M_K + (ta_ % 3) * KSLOT + hi * 1024 + r32 * 16; \
            _Pragma("unroll") for (int d0 = 0; d0 < ND0; ++d0) { \
                const bf16x8 b0 = *(const ALAS bf16x8*)(kb + d0 * 2048); const bf16x8 b1 = *(const ALAS bf16x8*)(kb + d0 * 2048 + 512); \
                p0 = __builtin_amdgcn_mfma_f32_32x32x16_bf16(b0, qr[d0], d0 == 0 ? negm : p0, 0, 0, 0); \
                p1 = __builtin_amdgcn_mfma_f32_32x32x16_bf16(b1, qr[d0], d0 == 0 ? negm : p1, 0, 0, 0); } } } while (0)
#define M_PA(k) ((k) == 0 ? __builtin_bit_cast(bf16x8, pw0) : (k) == 1 ? __builtin_bit_cast(bf16x8, pw1) : (k) == 2 ? __builtin_bit_cast(bf16x8, pw2) : __builtin_bit_cast(bf16x8, pw3))
#define M_VF(i) (bf16x8){vl_[i][0], vl_[i][1], vl_[i][2], vl_[i][3], vh_[i][0], vh_[i][1], vh_[i][2], vh_[i][3]}
#define M_STAGE_B(t_, ON) do { const int tb_ = (t_); if (ON) { \
        float a0 = fmaxf(fmaxf(p0[0], p0[1]), p1[0]), a1 = fmaxf(fmaxf(p0[2], p0[3]), p1[1]); a0 = fmaxf(fmaxf(a0, p1[2]), p1[3]); \
        _Pragma("unroll") for (int r = 4; r < 16; r += 4) { a0 = fmaxf(fmaxf(a0, p0[r]), p0[r + 1]); a1 = fmaxf(fmaxf(a1, p0[r + 2]), p0[r + 3]); a0 = fmaxf(fmaxf(a0, p1[r]), p1[r + 1]); a1 = fmaxf(fmaxf(a1, p1[r + 2]), p1[r + 3]); } \
        const float rm = xhalf_max(fmaxf(a0, a1)); \
        need = false; \
        if (tb_ == 0 || __any(rm > MLA_THR)) { \
            const float dl = (tb_ == 0) ? rm : fmaxf(rm, 0.f); \
            m_hat += dl; \
            _Pragma("unroll") for (int r = 0; r < 16; ++r) { p0[r] -= dl; p1[r] -= dl; } \
            _Pragma("unroll") for (int r = 0; r < 16; ++r) negm[r] = -m_hat; \
            if (tb_ > 0) { const float f = __builtin_amdgcn_exp2f(-dl); l_run *= f; if (hi == 0) wsf[r32] = f; need = true; } } \
        float ls0 = 0.f, ls1 = 0.f; \
        _Pragma("unroll") for (int r = 0; r < 16; ++r) { p0[r] = __builtin_amdgcn_exp2f(p0[r]); p1[r] = __builtin_amdgcn_exp2f(p1[r]); ls0 += p0[r]; ls1 += p1[r]; } \
        l_run += ls0 + ls1; \
        pw0 = (u32x4){cvtpk(p0[0], p0[1]), cvtpk(p0[2], p0[3]), cvtpk(p0[4], p0[5]), cvtpk(p0[6], p0[7])}; \
        pw1 = (u32x4){cvtpk(p0[8], p0[9]), cvtpk(p0[10], p0[11]), cvtpk(p0[12], p0[13]), cvtpk(p0[14], p0[15])}; \
        pw2 = (u32x4){cvtpk(p1[0], p1[1]), cvtpk(p1[2], p1[3]), cvtpk(p1[4], p1[5]), cvtpk(p1[6], p1[7])}; \
        pw3 = (u32x4){cvtpk(p1[8], p1[9]), cvtpk(p1[10], p1[11]), cvtpk(p1[12], p1[13]), cvtpk(p1[14], p1[15])}; } } while (0)
    const int tmain = NT - 4;
    if (grp == 0) {
        M_BAR_EVEN(0); M_STAGE_A_SW(0, false, true); A_BAR_L(); M_STAGE_B(0, true);
        int t = 1;
        for (; t < tmain; ++t) { M_BAR_EVEN(t); M_STAGE_A(t); A_BAR_L(); M_STAGE_B(t, true); }
        for (; t <= NT; ++t) { M_BAR_EVEN(t); M_STAGE_A_SW(t, (t - 1 <= tw), (t < NT && t <= tw)); A_BAR_L(); M_STAGE_B(t, (t < NT && t <= tw)); }
    } else {
        M_BAR_EVEN(0); A_BAR_L(); M_STAGE_A_SW(0, false, true);
        M_BAR_EVEN(1); M_STAGE_B(0, true); A_BAR_L(); M_STAGE_A_SW(1, true, true);
        int t = 2;
        for (; t < tmain; ++t) { M_BAR_EVEN(t); M_STAGE_B(t - 1, true); A_BAR_L(); M_STAGE_A(t); }
        for (; t <= NT; ++t) { M_BAR_EVEN(t); M_STAGE_B(t - 1, (t - 1 <= tw)); A_BAR_L(); M_STAGE_A_SW(t, (t - 1 <= tw), (t < NT && t <= tw)); }
    }
#undef M_BAR_EVEN
#undef M_STAGE_A
#undef M_STAGE_A_SW
#undef M_STAGE_B
#undef M_PA
#undef M_KLD
#undef M_QK
#undef M_VF
    A_WAIT_BAR(0);
    const float lt = xhalf_sum(l_run);
    if (hi == 0) wsf[32 + r32] = lt;
    float rli[16];
#pragma unroll
    for (int r = 0; r < 16; ++r) rli[r] = __builtin_amdgcn_rcpf(wsf[32 + crow(r, hi)]);
    ALAS float* stg = (ALAS float*)shm + wid * 2048;
#pragma unroll
    for (int r = 0; r < 16; ++r) { const int orow = crow(r, hi);
#pragma unroll
        for (int d0 = 0; d0 < 2; ++d0) stg[orow * 64 + d0 * 32 + r32] = o[d0][r] * rli[r]; }
    const long grow0 = rowbase + q0 + wid * 32;
#pragma unroll
    for (int i = 0; i < 4; ++i) {
        const int row = i * 8 + (lane >> 3), ch = lane & 7;
        const f32x4 a = *(const ALAS f32x4*)(stg + row * 64 + ch * 8), c = *(const ALAS f32x4*)(stg + row * 64 + ch * 8 + 4);
        float ss = ((a[0] * a[0] + a[1] * a[1]) + (a[2] * a[2] + a[3] * a[3])) + ((c[0] * c[0] + c[1] * c[1]) + (c[2] * c[2] + c[3] * c[3]));
        ss += __shfl_xor(ss, 1); ss += __shfl_xor(ss, 2); ss += __shfl_xor(ss, 4);
        const float rn = 1.0f / sqrtf(ss * (1.0f / 64.0f) + kEps);
        const size_t off = (size_t)(grow0 + row) * 1024 + goff + h * 64 + ch * 8;
        const u32x4 gv = *(const u32x4*)(gate + off);
        const f32x4 g0 = *(const f32x4*)(gnorm + h * 64 + ch * 8), g1 = *(const f32x4*)(gnorm + h * 64 + ch * 8 + 4);
        float v[8];
#pragma unroll
        for (int e = 0; e < 4; ++e) { v[e] = a[e] * rn * g0[e]; v[4 + e] = c[e] * rn * g1[e]; }
        u32x4 w;
#pragma unroll
        for (int e = 0; e < 4; ++e) { const unsigned gw = gv[e]; w[e] = cvtpk(v[2 * e] * __uint_as_float(gw << 16), v[2 * e + 1] * __uint_as_float(gw & 0xffff0000u)); }
        *(u32x4*)(out + off) = w;
    }
    A_WAIT_BAR(0);
#undef M_DMA
}

constexpr int S_RING = 0, S_FLAG = 131072, S_END = 131072 + 256;
__device__ __forceinline__ void sb_unit(int b, int h, int qb, const bf16_t* Q, const bf16_t* K, const bf16_t* V, const bf16_t* gate, const float* gnorm, bf16_t* out, int goff, ALAS char* shm) {
    constexpr int QP = 512;
    const int tid = threadIdx.x, lane = tid & 63, r32 = lane & 31, hi = lane >> 5; const int wid = __builtin_amdgcn_readfirstlane(tid >> 6);
    const int pair = wid >> 1, e2 = wid & 1;
    const long rowbase = (long)b * SEQ; const int q0 = qb * 256;
    const bf16_t* Qw = Q + (rowbase + q0 + wid * 32) * QP + h * 64;
    const bf16_t* Kh = K + rowbase * QP + h * 64; const bf16_t* Vh = V + rowbase * 512 + h * 64;
    const unsigned lds0 = (unsigned)(uintptr_t)shm;
    ALAS unsigned* flags = (ALAS unsigned*)(shm + S_FLAG);
    const int td = 4 * qb + pair;
    const bf16_t* ksrc = Kh + (long)lane * QP + (4 * e2) * 8;
    const bf16_t* vsrc = Vh + (long)(lane >> 2) * 512 + e2 * 32 + (lane & 3) * 8;
    const unsigned ring = lds0 + S_RING + pair * 32768;
    const unsigned kdst = ring + (4 * e2) * 1024, vdst = ring + 8192 + (4 * e2) * 1024;
#define S_DMA(t_, s_) do { const int tt_ = (t_) < 0 ? 0 : (t_); const unsigned so_ = (unsigned)(s_) * 16384u; \
        _Pragma("unroll") for (int c = 0; c < 4; ++c) glds16(ksrc + (long)tt_ * 64 * QP + c * 8, (unsigned)__builtin_amdgcn_readfirstlane(kdst + so_ + c * 1024)); \
        _Pragma("unroll") for (int c = 0; c < 4; ++c) glds16(vsrc + ((long)tt_ * 64 + 16 * c) * 512, (unsigned)__builtin_amdgcn_readfirstlane(vdst + so_ + c * 1024)); } while (0)
    S_DMA(td, 0);
    bf16x8 qr[4];
#pragma unroll
    for (int d0 = 0; d0 < 4; ++d0) qr[d0] = *(const bf16x8*)(Qw + (long)r32 * QP + d0 * 16 + hi * 8);
    f32x16 o[2]; o[0] = f32x16{}; o[1] = f32x16{};
    float carry = 1.0f;
    const int vb0 = (int)ring + 8192 + ((lane >> 4) & 1) * 32 + (lane & 3) * 8 + (4 * hi + ((lane & 15) >> 2)) * 64;
    const int qrel = 32 * e2 + r32;
    const int NI = 4 * qb + 4;
    for (int i = 0; i < NI; ++i) {
        A_WAIT_BAR(0);
        if (i > 0) { const ALAS unsigned* fl = flags + ((i - 1) & 1) * 8; unsigned all = 1u;
#pragma unroll
            for (int w = 0; w < 8; ++w) all &= fl[w];
            if (all) break; }
        const int t = td - i, slot = i & 1;
        if (i + 1 < NI) S_DMA(t - 1, slot ^ 1);
        bool done = true;
        if (t >= 0) {
            f32x16 p0, p1;
            qkt<4>(p0, p1, shm + S_RING + pair * 32768 + slot * 16384, qr, r32, hi);
            if (i == 0) {
#pragma unroll
                for (int r = 0; r < 16; ++r) { const int kv = crow(r, hi); if (kv >= qrel) p0[r] = -INFINITY; if (kv + 32 >= qrel) p1[r] = -INFINITY; } }
            f32x16 u0, u1;
#pragma unroll
            for (int r = 0; r < 16; ++r) { u0[r] = __builtin_amdgcn_rcpf(1.0f + __builtin_amdgcn_exp2f(p0[r])); u1[r] = __builtin_amdgcn_rcpf(1.0f + __builtin_amdgcn_exp2f(p1[r])); }
            float lo_[8], up_[8];
#pragma unroll
            for (int i4 = 0; i4 < 8; ++i4) {
                const float bp = (i4 < 4) ? ((u0[4 * i4] * u0[4 * i4 + 1]) * (u0[4 * i4 + 2] * u0[4 * i4 + 3])) : ((u1[4 * i4 - 16] * u1[4 * i4 - 15]) * (u1[4 * i4 - 14] * u1[4 * i4 - 13]));
                auto rr = __builtin_amdgcn_permlane32_swap(__float_as_uint(bp), __float_as_uint(bp), false, false);
                lo_[i4] = __uint_as_float(rr[0]); up_[i4] = __uint_as_float(rr[1]);
            }
            float run = carry;
#pragma unroll
            for (int i4 = 7; i4 >= 0; --i4) {
                float c = (hi == 0) ? run * up_[i4] : run;
#pragma unroll
                for (int e = 3; e >= 0; --e) {
                    if (i4 < 4) { const float uu = u0[4 * i4 + e]; p0[4 * i4 + e] = (1.0f - uu) * c; c *= uu; }
                    else { const float uu = u1[4 * i4 - 16 + e]; p1[4 * i4 - 16 + e] = (1.0f - uu) * c; c *= uu; }
                }
                run *= lo_[i4] * up_[i4];
            }
            carry = run;
            u32x4 pw0, pw1, pw2, pw3;
            pw0 = (u32x4){cvtpk(p0[0], p0[1]), cvtpk(p0[2], p0[3]), cvtpk(p0[4], p0[5]), cvtpk(p0[6], p0[7])};
            pw1 = (u32x4){cvtpk(p0[8], p0[9]), cvtpk(p0[10], p0[11]), cvtpk(p0[12], p0[13]), cvtpk(p0[14], p0[15])};
            pw2 = (u32x4){cvtpk(p1[0], p1[1]), cvtpk(p1[2], p1[3]), cvtpk(p1[4], p1[5]), cvtpk(p1[6], p1[7])};
            pw3 = (u32x4){cvtpk(p1[8], p1[9]), cvtpk(p1[10], p1[11]), cvtpk(p1[12], p1[13]), cvtpk(p1[14], p1[15])};
            pv(o, vb0 + slot * 16384, __builtin_bit_cast(bf16x8, pw0), __builtin_bit_cast(bf16x8, pw1), __builtin_bit_cast(bf16x8, pw2), __builtin_bit_cast(bf16x8, pw3));
            done = __all(carry < 1.0e-37f) || (t == 0);
        }
        if (lane == 0) flags[(i & 1) * 8 + wid] = done ? 1u : 0u;
    }
    A_WAIT_BAR(0);
    ALAS float* stg = (ALAS float*)shm + wid * 2048;
#pragma unroll
    for (int r = 0; r < 16; ++r) { const int orow = crow(r, hi);
#pragma unroll
        for (int d0 = 0; d0 < 2; ++d0) stg[orow * 64 + d0 * 32 + r32] = o[d0][r]; }
    const long grow0 = rowbase + q0 + wid * 32;
#pragma unroll
    for (int i = 0; i < 4; ++i) {
        const int row = i * 8 + (lane >> 3), ch = lane & 7;
        const f32x4 a = *(const ALAS f32x4*)(stg + row * 64 + ch * 8), c = *(const ALAS f32x4*)(stg + row * 64 + ch * 8 + 4);
        float ss = ((a[0] * a[0] + a[1] * a[1]) + (a[2] * a[2] + a[3] * a[3])) + ((c[0] * c[0] + c[1] * c[1]) + (c[2] * c[2] + c[3] * c[3]));
        ss += __shfl_xor(ss, 1); ss += __shfl_xor(ss, 2); ss += __shfl_xor(ss, 4);
        const float rn = 1.0f / sqrtf(ss * (1.0f / 64.0f) + kEps);
        const size_t off = (size_t)(grow0 + row) * 1024 + goff + h * 64 + ch * 8;
        const u32x4 gv = *(const u32x4*)(gate + off);
        const f32x4 g0 = *(const f32x4*)(gnorm + h * 64 + ch * 8), g1 = *(const f32x4*)(gnorm + h * 64 + ch * 8 + 4);
        float v[8];
#pragma unroll
        for (int e = 0; e < 4; ++e) { v[e] = a[e] * rn * g0[e]; v[4 + e] = c[e] * rn * g1[e]; }
        u32x4 w;
#pragma unroll
        for (int e = 0; e < 4; ++e) { const unsigned gw = gv[e]; w[e] = cvtpk(v[2 * e] * __uint_as_float(gw << 16), v[2 * e + 1] * __uint_as_float(gw & 0xffff0000u)); }
        *(u32x4*)(out + off) = w;
    }
    A_WAIT_BAR(0);
#undef S_DMA
}
}
#include <hip/hip_cooperative_groups.h>
namespace cg = cooperative_groups;
#ifndef MK_N_LAUNCHES
#define MK_N_LAUNCHES 1
#endif
#ifndef REP_MLA
#define REP_MLA 1
#endif
#ifndef REP_SB
#define REP_SB 1
#endif
#ifndef REP_P1
#define REP_P1 1
#endif
#ifndef REP_MISC
#define REP_MISC 1
#endif
#ifndef REP_SYNC
#define REP_SYNC 0
#endif
#ifndef REP_TAIL
#define REP_TAIL 1
#endif
constexpr int NWAVES = 8;
constexpr int N_PHASES = 7;
constexpr int LDS_BYTES = 147456;
static_assert(WS_SBK - WS_SBQ == 32 * MiB && WS_SBV - WS_SBK == 32 * MiB, "EpiProj addresses SBK/SBV relative to SBQ");
static_assert(att::L_END <= MISC_OFF && pg8::STAGE_BYTES <= MISC_OFF, "control words");
static_assert(att::M_END <= MISC_OFF && att::S_END <= MISC_OFF, "LDS map");
static_assert(att::L_END <= LDS_BYTES && pg8::STAGE_BYTES <= LDS_BYTES, "LDS map");

typedef unsigned short bf16;
typedef unsigned v4u __attribute__((ext_vector_type(4)));
typedef unsigned v2u __attribute__((ext_vector_type(2)));
typedef float f32x4 __attribute__((ext_vector_type(4)));
#define LAS __attribute__((address_space(3)))
__device__ __forceinline__ unsigned f2bf(float f) { unsigned u = __builtin_bit_cast(unsigned, f); return (u + 0x7fffu + ((u >> 16) & 1u)) >> 16; }
__device__ __forceinline__ unsigned pk2(float lo, float hi) { return f2bf(lo) | (f2bf(hi) << 16); }
__device__ __forceinline__ float wave_sum(float v) {
#pragma unroll
    for (int o = 1; o < 64; o <<= 1) v += __shfl_xor(v, o);
    return v;
}
__device__ __forceinline__ void transpose_item(const float* W, int K, int N, bf16* WT, int ldk, const float* gain, LAS float* scr, int item, int lane) {
    const int nblk = N / 32, kb = item / nblk, nb = item % nblk, k0 = 64 * kb, n0 = 32 * nb;
#pragma unroll 8
    for (int i = 0; i < 32; ++i) { const int kk = 2 * i + (lane >> 5); const float gk = gain ? gain[k0 + kk] : 1.0f; scr[kk * 33 + (lane & 31)] = W[(size_t)(k0 + kk) * N + n0 + (lane & 31)] * gk; }
    asm volatile("s_waitcnt lgkmcnt(0)" ::: "memory");
    const int c = lane & 7;
#pragma unroll
    for (int j = 0; j < 4; ++j) { const int n = (lane >> 3) + 8 * j; const LAS float* s = scr + (8 * c) * 33 + n;
        v4u o; o.x = pk2(s[0 * 33], s[1 * 33]); o.y = pk2(s[2 * 33], s[3 * 33]); o.z = pk2(s[4 * 33], s[5 * 33]); o.w = pk2(s[6 * 33], s[7 * 33]);
        *(v4u*)(WT + (size_t)(n0 + n) * ldk + k0 + 8 * c) = o; }
    asm volatile("s_waitcnt lgkmcnt(0)" ::: "memory");
}

#define XB_TMO      128
#define XB_XCNT(j)  (256  + 64 * (j))
#define XB_XSUB(j)  (1280 + 64 * (j))
#define XB_XGEN(j)  (2304 + 64 * (j))
#define XB_TOP      3328
#define XB_TOPGEN   3392
#define XCD_BAR_WORDS 3456
#define XB_SPIN_CAP (1u << 18)

__device__ __forceinline__ unsigned xb_ld(unsigned* p)              { return __hip_atomic_load(p, __ATOMIC_RELAXED, __HIP_MEMORY_SCOPE_AGENT); }
__device__ __forceinline__ unsigned xb_add(unsigned* p, unsigned v) { return __hip_atomic_fetch_add(p, v, __ATOMIC_RELAXED, __HIP_MEMORY_SCOPE_AGENT); }
__device__ __forceinline__ unsigned xb_xcc_id() { return (unsigned)__builtin_amdgcn_s_getreg((3 << 11) | 20) & 0xFu; }
#define XB_SPIN(cond, bar) do { unsigned _sp = 0; while (cond) { __builtin_amdgcn_s_sleep(1); \
    if ((++_sp & 255u) == 0u) { if (xb_ld(&(bar)[XB_TMO])) break; if (_sp > XB_SPIN_CAP) { atomicAdd(&(bar)[XB_TMO], 1u); break; } } } } while (0)

struct XcdBarrier {
    unsigned* bar; unsigned x;
    volatile LAS unsigned* st;
};

__device__ __forceinline__ XcdBarrier xcd_barrier_post(unsigned* bar, volatile LAS unsigned* st) {
    XcdBarrier b; b.bar = bar; b.x = xb_xcc_id(); b.st = st;
    if (threadIdx.x == 0) (void)xb_add(&bar[XB_XCNT(b.x)], 1u);
    return b;
}
__device__ __forceinline__ void xcd_barrier_complete(unsigned* bar, unsigned x, unsigned& nloc, unsigned& nx) {
    const unsigned G = gridDim.x * gridDim.y * gridDim.z;
    unsigned sum, cnt, mine, sp = 0u;
    for (;;) {
        sum = 0u; cnt = 0u; mine = 0u;
#pragma unroll
        for (unsigned j = 0; j < 16; ++j) { const unsigned c = xb_ld(&bar[XB_XCNT(j)]); sum += c; cnt += (c > 0u) ? 1u : 0u; mine = (j == x) ? c : mine; }
        if (sum == G) break;
        __builtin_amdgcn_s_sleep(1);
        if ((++sp & 255u) == 0u) { if (xb_ld(&bar[XB_TMO])) break; if (sp > XB_SPIN_CAP) { atomicAdd(&bar[XB_TMO], 1u); break; } }
    }
    nloc = mine > 0u ? mine : 1u; nx = cnt > 0u ? cnt : 1u;
}

__device__ __forceinline__ void xcd_barrier(const XcdBarrier& b) {
    asm volatile("s_waitcnt vmcnt(0)" ::: "memory");
    __syncthreads();
    if (threadIdx.x == 0) {
        unsigned* bar = b.bar;
        __builtin_amdgcn_s_waitcnt(0);
        unsigned nloc = b.st[0], nx = b.st[1];
        if (nloc == 0u) { xcd_barrier_complete(bar, b.x, nloc, nx); b.st[0] = nloc; b.st[1] = nx; }
        const unsigned old = xb_add(&bar[XB_XSUB(b.x)], 1u);
        const unsigned gen = old / nloc;
        if (old + 1u == (gen + 1u) * nloc) {
            __builtin_amdgcn_fence(__ATOMIC_RELEASE, "agent");
            asm volatile("s_waitcnt vmcnt(0)" ::: "memory");
            const unsigned og = xb_add(&bar[XB_TOP], 1u);
            const unsigned tg = og / nx;
            if (og + 1u == (tg + 1u) * nx) xb_add(&bar[XB_TOPGEN], 1u);
            else XB_SPIN(xb_ld(&bar[XB_TOPGEN]) == tg, bar);
            __builtin_amdgcn_fence(__ATOMIC_ACQUIRE, "agent");
            xb_add(&bar[XB_XGEN(b.x)], 1u);
            asm volatile("s_waitcnt vmcnt(0)" ::: "memory");
        } else {
            XB_SPIN(xb_ld(&bar[XB_XGEN(b.x)]) == gen, bar);
            __builtin_amdgcn_fence(__ATOMIC_ACQUIRE, "agent");
            asm volatile("s_waitcnt vmcnt(0)" ::: "memory");
        }
    }
    __syncthreads();
}

static_assert(XCD_BAR_WORDS * 4 <= (int)CTL_ZERO_BYTES, "barrier words inside the memset");
__device__ __forceinline__ int opq(int v) { asm volatile("" : "+s"(v)); return v; }
struct Args { const float* in[17]; const int* pos; float* out; unsigned char* ws; int ph_lo, ph_hi; };

typedef const Args __attribute__((address_space(4)))* ArgsK;
#define PHASE_PTRS \
    ArgsK ap_ = (ArgsK)__builtin_amdgcn_kernarg_segment_ptr(); asm volatile("" : "+s"(ap_)); unsigned char* ws = ap_->ws; const int* posp = ap_->pos; float* outp = ap_->out; \
    const float* x = ap_->in[0]; const float* pin = ap_->in[1]; \
    const float* g_pre = ap_->in[3]; const float* w_in = ap_->in[4]; const float* g_q = ap_->in[5]; const float* w_uq = ap_->in[6]; const float* g_kv = ap_->in[7]; const float* w_ukv = ap_->in[8]; \
    const float* g_sb = ap_->in[9]; const float* g_mla = ap_->in[10]; const float* w_out = ap_->in[11]; const float* g_post = ap_->in[12]; const float* w_ple = ap_->in[13]; const float* g_ple = ap_->in[14]; \
    const float* w_pg = ap_->in[15]; const float* b_pg = ap_->in[16]; \
    bf16* XB = (bf16*)(ws + WS_A); bf16* MIX = (bf16*)(ws + WS_A); bf16* X1B = (bf16*)(ws + WS_A); \
    bf16* GATE = (bf16*)(ws + WS_B); bf16* YB = (bf16*)(ws + WS_B); bf16* PLEB = (bf16*)(ws + WS_PLE); \
    bf16* SBQ = (bf16*)(ws + WS_SBQ); bf16* SBK = (bf16*)(ws + WS_SBK); bf16* SBV = (bf16*)(ws + WS_SBV); \
    bf16* MQ = (bf16*)(ws + WS_MQ); bf16* MK = (bf16*)(ws + WS_MK); bf16* MV = (bf16*)(ws + WS_MV); \
    bf16* PB = (bf16*)(ws + WS_PB); bf16* CQ = (bf16*)(ws + WS_CQ); bf16* CKV = (bf16*)(ws + WS_CKV); \
    bf16* WIN = (bf16*)(ws + WS_WIN); bf16* WUQ = (bf16*)(ws + WS_WUQ); bf16* WUKV = (bf16*)(ws + WS_WUKV); bf16* WOUT = (bf16*)(ws + WS_WOUT); bf16* WPLE = (bf16*)(ws + WS_WPLE); bf16* WPG = (bf16*)(ws + WS_WPG); \
    float* CS = (float*)(ws + WS_CS); float* RPRE = (float*)(ws + WS_RPRE); float* RQSS = (float*)(ws + WS_RQSS); float* RKVSS = (float*)(ws + WS_RKVSS); \
    float* YSS = (float*)(ws + WS_YSS); float* PSS = (float*)(ws + WS_PSS); float* RY = (float*)(ws + WS_RY); float* RP = (float*)(ws + WS_RP);
__global__ void __launch_bounds__(NWAVES * 64, 2) fwd_kernel(Args args) {
    extern __shared__ __attribute__((aligned(16))) unsigned char lds[];
    const int tid = threadIdx.x, lane = tid & 63, wave = __builtin_amdgcn_readfirstlane(tid >> 6);
    const int G = gridDim.x; const int bx = blockIdx.x; const int vcu = (G % 8 == 0) ? (bx % 8) * (G / 8) + bx / 8 : bx;
    const int lo = args.ph_lo, hi = args.ph_hi;
#define IN(k) (lo <= (k) && (k) < hi)
#define SEAM(k) do { if (IN(k) && IN((k) + 1)) { xcd_barrier(bar); } } while (0)
    if (lo < 0) cg::this_grid().sync();
    volatile LAS unsigned* MISC = (volatile LAS unsigned*)((LAS unsigned char*)lds + MISC_OFF);
    if (tid < 8) MISC[tid] = 0u;
    __syncthreads();
    XcdBarrier bar; bar.bar = (unsigned*)(args.ws + WS_CTL); bar.x = 0; bar.st = nullptr;
    if (hi - lo > 1) bar = xcd_barrier_post((unsigned*)(args.ws + WS_CTL), MISC);
    const int gw = vcu * NWAVES + wave, NGW = G * NWAVES;

    for (int rep0 = 0; rep0 < REP_MISC; ++rep0)
    if (IN(0)) {
        PHASE_PTRS
        LAS float* scr = (LAS float*)((LAS unsigned char*)lds + wave * 16384);
        constexpr int I_IN = 16 * 93, I_UQ = 4 * 24, I_UKV = 2 * 32, I_OUT = 16 * 32, I_PLE = 4 * 32, I_PG = 16 * 32;
        constexpr int NITEMS = I_IN + I_UQ + I_UKV + I_OUT + I_PLE + I_PG;
        for (int it = gw; it < NITEMS; it += NGW) {
            int r = it;
            if (r < I_IN) { transpose_item(w_in, 1024, NIN, WIN, 1024, g_pre, scr, r, lane); continue; } r -= I_IN;
            if (r < I_UQ) { transpose_item(w_uq, 256, 768, WUQ, 256, g_q, scr, r, lane); continue; } r -= I_UQ;
            if (r < I_UKV) { transpose_item(w_ukv, 128, 1024, WUKV, 256, g_kv, scr, r, lane); continue; } r -= I_UKV;
            if (r < I_OUT) { transpose_item(w_out, 1024, 1024, WOUT, 1024, nullptr, scr, r, lane); continue; } r -= I_OUT;
            if (r < I_PLE) { transpose_item(w_ple, 256, 1024, WPLE, 256, nullptr, scr, r, lane); continue; } r -= I_PLE;
            transpose_item(w_pg, 1024, 1024, WPG, 1024, nullptr, scr, r, lane);
        }
        const int gt = vcu * (NWAVES * 64) + tid, NGT = G * NWAVES * 64;
        for (int i = gt; i < (NINP - NIN) * 1024 / 8; i += NGT) *(v4u*)(WIN + (size_t)NIN * 1024 + (size_t)i * 8) = (v4u){0u, 0u, 0u, 0u};
        for (int i = gt; i < 1024 * 128 / 8; i += NGT) { const int n = i / 16, c = i % 16; *(v4u*)(WUKV + (size_t)n * 256 + 128 + c * 8) = (v4u){0u, 0u, 0u, 0u}; }
        for (int i = gt; i < M * 16; i += NGT) {
            const int row = i >> 4, k = i & 15;
            const float freq = exp2f(-(float)k * 0.8304820237218407f);
            const float ang = (float)posp[row] * freq;
            double tt = (double)ang * 0.15915494309189535; tt -= __builtin_rint(tt);
            const float tf = (float)tt;
            CS[(size_t)i * 2] = __builtin_amdgcn_cosf(tf); CS[(size_t)i * 2 + 1] = __builtin_amdgcn_sinf(tf);
        }
        for (int m = gw; m < M; m += 2 * NGW) {
            const int m2 = (m + NGW < M) ? m + NGW : m;
            const f32x4* xr = (const f32x4*)(x + (size_t)m * D) + lane; const f32x4* xr2 = (const f32x4*)(x + (size_t)m2 * D) + lane; f32x4 v[4], w[4]; float s = 0.f, s2 = 0.f;
#pragma unroll
            for (int j = 0; j < 4; ++j) { v[j] = xr[64 * j]; w[j] = xr2[64 * j]; }
#pragma unroll
            for (int j = 0; j < 4; ++j) { s += (v[j][0] * v[j][0] + v[j][1] * v[j][1]) + (v[j][2] * v[j][2] + v[j][3] * v[j][3]); s2 += (w[j][0] * w[j][0] + w[j][1] * w[j][1]) + (w[j][2] * w[j][2] + w[j][3] * w[j][3]); }
            s = wave_sum(s); s2 = wave_sum(s2);
            if (lane == 0) { RPRE[m] = 1.0f / sqrtf(s * (1.0f / D) + 1e-6f); RPRE[m2] = 1.0f / sqrtf(s2 * (1.0f / D) + 1e-6f); }
            v2u* o8 = (v2u*)(XB + (size_t)m * D) + lane; v2u* o82 = (v2u*)(XB + (size_t)m2 * D) + lane;
#pragma unroll
            for (int j = 0; j < 4; ++j) { o8[64 * j] = (v2u){pk2(v[j][0], v[j][1]), pk2(v[j][2], v[j][3])}; o82[64 * j] = (v2u){pk2(w[j][0], w[j][1]), pk2(w[j][2], w[j][3])}; }
        }
        for (int i = gt; i < M * PLE / 4; i += 4 * NGT) {
            f32x4 v[4];
#pragma unroll
            for (int j = 0; j < 4; ++j) { const int ij = (i + j * NGT < M * PLE / 4) ? i + j * NGT : i; v[j] = *((const f32x4*)pin + ij); }
#pragma unroll
            for (int j = 0; j < 4; ++j) { const int ij = (i + j * NGT < M * PLE / 4) ? i + j * NGT : i; *((v2u*)PB + ij) = (v2u){pk2(v[j][0], v[j][1]), pk2(v[j][2], v[j][3])}; }
        }
    }
    SEAM(0);

    if (IN(1)) {
        PHASE_PTRS
        { pg8::Gemm g{XB, WIN, M, NINP, 1024}; pg8::StaticOrder S; S.init(M, NINP, G, bx);
          pg8::EpiProj E{ws};
          pg8::gemm_phase<pg8::EpiProj, pg8::StaticOrder, true, true>((PG8_LAS unsigned char*)lds, g, S, E); }
#if REP_P1 > 1
        { pg8::Gemm g{XB, WIN, M, NINP, 1024}; pg8::StaticOrder S; S.init(M, NINP, G, bx);
          pg8::EpiProj E{ws};
          pg8::gemm_phase<pg8::EpiProj, pg8::StaticOrder, true, true>((PG8_LAS unsigned char*)lds, g, S, E); }
#endif
        { pg8::Gemm g{PB, WPLE, M, 1024, opq(256)}; pg8::StaticOrder S; S.init(M, 1024, G, bx);
          pg8::EpiStat E{PLEB, PSS};
          pg8::gemm_phase<pg8::EpiStat, pg8::StaticOrder, true, true>((PG8_LAS unsigned char*)lds, g, S, E); }
#if REP_MISC > 1
        { pg8::Gemm g{PB, WPLE, M, 1024, opq(256)}; pg8::StaticOrder S; S.init(M, 1024, G, bx);
          pg8::EpiStat E{PLEB, PSS};
          pg8::gemm_phase<pg8::EpiStat, pg8::StaticOrder, true, true>((PG8_LAS unsigned char*)lds, g, S, E); }
#endif
    }
    SEAM(1);

    if (IN(2)) {
        PHASE_PTRS
        { pg8::Gemm g{CQ, WUQ, M, 768, opq(256)}; pg8::StaticOrder S; S.init(M, 768, G, bx);
          pg8::EpiQ E{MQ, RQSS, CS};
          pg8::gemm_phase<pg8::EpiQ, pg8::StaticOrder, true, true>((PG8_LAS unsigned char*)lds, g, S, E); }
        { pg8::Gemm g{CKV, WUKV, M, 1024, opq(256)}; pg8::StaticOrder S; S.init(M, 1024, G, bx);
          pg8::EpiKV E{MK, MV, RKVSS};
          pg8::gemm_phase<pg8::EpiKV, pg8::StaticOrder, true, true>((PG8_LAS unsigned char*)lds, g, S, E); }
#if REP_MISC > 1
        { pg8::Gemm g{CQ, WUQ, M, 768, opq(256)}; pg8::StaticOrder S; S.init(M, 768, G, bx);
          pg8::EpiQ E{MQ, RQSS, CS};
          pg8::gemm_phase<pg8::EpiQ, pg8::StaticOrder, true, true>((PG8_LAS unsigned char*)lds, g, S, E); }
        { pg8::Gemm g{CKV, WUKV, M, 1024, opq(256)}; pg8::StaticOrder S; S.init(M, 1024, G, bx);
          pg8::EpiKV E{MK, MV, RKVSS};
          pg8::gemm_phase<pg8::EpiKV, pg8::StaticOrder, true, true>((PG8_LAS unsigned char*)lds, g, S, E); }
#endif
    }
    SEAM(2);

    if (IN(3)) {
        PHASE_PTRS
        __attribute__((address_space(3))) char* shm = (__attribute__((address_space(3))) char*)lds;
        for (int rep = 0; rep < REP_MLA; ++rep)
        for (int idx = vcu; idx < 1024; idx += G) {
            const int j = idx >> 8, v = idx & 255, bh = v >> 2, s = v & 3;
            const int qb = (j == 0) ? 15 - s : (j == 1) ? s : (j == 2) ? 8 + s : 7 - s;
            att::mla_unit(bh >> 3, bh & 7, qb, MQ, MK, MV, GATE, g_mla, MIX, 512, shm);
        }
        for (int rep = 0; rep < REP_SB; ++rep)
        for (int idx = vcu; idx < 1024; idx += G) {
            const int bh = idx >> 4, qb = idx & 15;
            att::sb_unit(bh >> 3, bh & 7, qb, SBQ, SBK, SBV, GATE, g_sb, MIX, 0, shm);
        }
    }
    SEAM(3);
    for (int rs_ = 0; rs_ < REP_SYNC; ++rs_) xcd_barrier(bar);

    if (IN(4)) {
        PHASE_PTRS
        {
        pg8::Gemm g{MIX, WOUT, M, 1024, 1024}; pg8::StaticOrder S; S.init(M, 1024, G, bx);
        pg8::EpiStat E{YB, YSS};
        pg8::gemm_phase<pg8::EpiStat, pg8::StaticOrder, true, true>((PG8_LAS unsigned char*)lds, g, S, E);
        }
#if REP_TAIL > 1
        {
        pg8::Gemm g{MIX, WOUT, M, 1024, 1024}; pg8::StaticOrder S; S.init(M, 1024, G, bx);
        pg8::EpiStat E{YB, YSS};
        pg8::gemm_phase<pg8::EpiStat, pg8::StaticOrder, true, true>((PG8_LAS unsigned char*)lds, g, S, E);
        }
#endif
    }
    SEAM(4);

    if (IN(5)) {
        PHASE_PTRS
        for (int mm = gw; mm < M; mm += 2 * NGW) {
#pragma unroll
          for (int half = 0; half < 2; ++half) {
            const int m = (half == 0) ? mm : ((mm + NGW < M) ? mm + NGW : mm);
            float sv = (lane < 16) ? YSS[(size_t)m * 16 + lane] : ((lane < 32) ? PSS[(size_t)m * 16 + lane - 16] : 0.f);
            sv += __shfl_xor(sv, 1); sv += __shfl_xor(sv, 2); sv += __shfl_xor(sv, 4); sv += __shfl_xor(sv, 8);
            const float sy = __shfl(sv, 0), sp = __shfl(sv, 16);
            const float ry = 1.0f / sqrtf(sy * (1.0f / 1024.0f) + 1e-6f), rp = 1.0f / sqrtf(sp * (1.0f / 1024.0f) + 1e-6f);
            if (lane == 0) { RY[m] = ry; RP[m] = rp; }
            const f32x4* xr = (const f32x4*)(x + (size_t)m * D) + lane; const v2u* yr = (const v2u*)(YB + (size_t)m * D) + lane; const f32x4* gr = (const f32x4*)g_post + lane;
            v2u* o8 = (v2u*)(X1B + (size_t)m * D) + lane;
#pragma unroll
            for (int j = 0; j < 4; ++j) { const f32x4 xv = xr[64 * j], gv = gr[64 * j]; const v2u yw = yr[64 * j];
                const float y0 = __uint_as_float(yw.x << 16), y1 = __uint_as_float(yw.x & 0xffff0000u), y2 = __uint_as_float(yw.y << 16), y3 = __uint_as_float(yw.y & 0xffff0000u);
                o8[64 * j] = (v2u){pk2(xv[0] + y0 * ry * gv[0], xv[1] + y1 * ry * gv[1]), pk2(xv[2] + y2 * ry * gv[2], xv[3] + y3 * ry * gv[3])}; }
          }
        }
    }
    SEAM(5);

    if (IN(6)) {
        PHASE_PTRS
        {
        pg8::Gemm g{X1B, WPG, M, 1024, 1024}; pg8::StaticOrder S; S.init(M, 1024, G, bx);
        pg8::EpiFinal E{x, YB, PLEB, RY, RP, g_post, g_ple, b_pg, outp};
        pg8::gemm_phase<pg8::EpiFinal, pg8::StaticOrder, true, true>((PG8_LAS unsigned char*)lds, g, S, E);
        }
#if REP_TAIL > 1
        {
        pg8::Gemm g{X1B, WPG, M, 1024, 1024}; pg8::StaticOrder S; S.init(M, 1024, G, bx);
        pg8::EpiFinal E{x, YB, PLEB, RY, RP, g_post, g_ple, b_pg, outp};
        pg8::gemm_phase<pg8::EpiFinal, pg8::StaticOrder, true, true>((PG8_LAS unsigned char*)lds, g, S, E);
        }
#endif
    }
#undef IN
#undef SEAM
}

extern "C" void kernel_launch(void* const* d_in, const int* in_sizes, int n_in, void* d_out, int out_size, void* d_ws, size_t ws_size, hipStream_t stream) {
    static int grid = 0;
    if (grid == 0) {
        if (n_in != 17 || out_size != M * D || ws_size < WS_END) { fprintf(stderr, "kernel_launch: unexpected shapes (n_in %d, out %d, ws %zu); nothing launched\n", n_in, out_size, ws_size); grid = -1; return; }
        int dev = 0, cus = 0, per_cu = 0;
        if (hipGetDevice(&dev) != hipSuccess || hipDeviceGetAttribute(&cus, hipDeviceAttributeMultiprocessorCount, dev) != hipSuccess) { grid = -1; return; }
        if (hipFuncSetAttribute((const void*)fwd_kernel, hipFuncAttributeMaxDynamicSharedMemorySize, LDS_BYTES) != hipSuccess) { fprintf(stderr, "kernel_launch: hipFuncSetAttribute failed\n"); grid = -1; return; }
        if (hipOccupancyMaxActiveBlocksPerMultiprocessor(&per_cu, (const void*)fwd_kernel, NWAVES * 64, LDS_BYTES) != hipSuccess || per_cu < 1) { fprintf(stderr, "kernel_launch: occupancy query says %d blocks per CU\n", per_cu); per_cu = 1; }
        (void)hipGetLastError();
        grid = cus * 1;
    }
    if (grid < 0) return;
    if (hipMemsetAsync((char*)d_ws + WS_CTL, 0, CTL_ZERO_BYTES, stream) != hipSuccess) { fprintf(stderr, "kernel_launch: hipMemsetAsync failed\n"); return; }
    Args a{};
    for (int i = 0; i < 17; ++i) a.in[i] = (const float*)d_in[i];
    a.pos = (const int*)d_in[2]; a.out = (float*)d_out; a.ws = (unsigned char*)d_ws;
#if MK_N_LAUNCHES == 1
    a.ph_lo = 0; a.ph_hi = N_PHASES;
    void* kargs[] = {&a};
    hipError_t e = hipLaunchCooperativeKernel((const void*)fwd_kernel, dim3(grid), dim3(NWAVES * 64), kargs, LDS_BYTES, stream);
    if (e != hipSuccess) fprintf(stderr, "kernel_launch: cooperative launch failed: %s (grid %d)\n", hipGetErrorString(e), grid);
#else
    for (int li = 0; li < N_PHASES; ++li) { a.ph_lo = li; a.ph_hi = li + 1; hipLaunchKernelGGL(fwd_kernel, dim3(grid), dim3(NWAVES * 64), LDS_BYTES, stream, a); }
#endif
}
```

```cpp
#include <hip/hip_runtime.h>
#include <cstdio>
#include <cstdint>
#include <cmath>
constexpr int M = 32768, D = 1024, SEQ = 4096, NIN = 2976, NINP = 3072, PLE = 256;
constexpr size_t MiB = 1u << 20;
constexpr size_t WS_A = 0;
constexpr size_t WS_B = 64 * MiB;
constexpr size_t WS_PLE = 128 * MiB;
constexpr size_t WS_SBQ = 192 * MiB, WS_SBK = 224 * MiB, WS_SBV = 256 * MiB;
constexpr size_t WS_MQ = 288 * MiB, WS_MK = 336 * MiB, WS_MV = 384 * MiB;
constexpr size_t WS_PB = 416 * MiB, WS_CQ = 432 * MiB, WS_CKV = 448 * MiB;
constexpr size_t WS_WIN = 464 * MiB;
constexpr size_t WS_WUQ = 470 * MiB;
constexpr size_t WS_WUKV = 471 * MiB;
constexpr size_t WS_WOUT = 472 * MiB;
constexpr size_t WS_WPLE = 474 * MiB;
constexpr size_t WS_WPG = 475 * MiB;
constexpr size_t WS_CS = 477 * MiB;
constexpr size_t WS_RPRE = 481 * MiB;
constexpr size_t WS_RQSS = 482 * MiB;
constexpr size_t WS_RKVSS = 483 * MiB;
constexpr size_t WS_YSS = 484 * MiB;
constexpr size_t WS_PSS = 486 * MiB;
constexpr size_t WS_RY = 488 * MiB, WS_RP = 489 * MiB;
constexpr size_t WS_CTL = 490 * MiB, CTL_ZERO_BYTES = 16384;
constexpr size_t WS_END = 491 * MiB;
constexpr int MISC_OFF = 147456 - 256;
namespace pg8 {
#define PG8_LAS __attribute__((address_space(3)))
typedef unsigned short bf16_t;
typedef short bf16x8 __attribute__((ext_vector_type(8)));
typedef float f32x4 __attribute__((ext_vector_type(4)));
typedef unsigned u32x4 __attribute__((ext_vector_type(4)));
constexpr int BM = 256, BK = 64, HALF = 128, HTB = HALF * BK * 2  , STAGE_BYTES = 8 * HTB, NXCD = 8, WGM = 8;

__host__ __device__ __forceinline__ int lds_byte(int r, int c) { const int st = (r >> 4) * 2 + (c >> 5), rr = r & 15, cc = c & 31, ob = rr * 64 + cc * 2; return st * 1024 + (ob ^ (((ob >> 9) & 1) << 5)); }
__host__ __device__ __forceinline__ void stage_rc(int b, int& R, int& C) { const int st = b / 1024, sb = b % 1024, swz = sb ^ (((sb >> 9) & 1) << 5); R = (st >> 1) * 16 + swz / 64; C = (st & 1) * 32 + (swz % 64) / 2; }
__host__ __device__ __forceinline__ int perm32(int rho) { const int n = rho >> 4, i = rho & 15; return 8 * (i >> 2) + 4 * n + (i & 3); }

struct Unit { int pm, pn; };
struct Gemm { const bf16_t* A; const bf16_t* Bt; int M, N, K; };

struct StaticOrder {
    int nM, nN, nwg, G, c;
    __host__ __device__ void init(int M, int N, int G_, int c_) { nM = M / BM; nN = N / BM; nwg = nM * nN; G = G_; c = c_; }
    __host__ __device__ bool next(int i, Unit& u) const {
        const long L = (long)i * G + c; if (L >= nwg) return false;
        int wgid = (int)L; { const int q = nwg / NXCD, r = nwg % NXCD, xcd = wgid % NXCD, off = wgid / NXCD; wgid = (xcd < r ? xcd * (q + 1) : r * (q + 1) + (xcd - r) * q) + off; }
        const int nig = WGM * nN, gid = wgid / nig, fm = gid * WGM, gsz = (nM - fm) < WGM ? (nM - fm) : WGM;
        u.pm = fm + ((wgid % nig) % gsz); u.pn = (wgid % nig) / gsz; return true;
    }
    __device__ __forceinline__ void a_ready(const Unit&) const {}
    __device__ __forceinline__ void done(const Unit&) const {}
};

__device__ __forceinline__ unsigned cvt_pk_bf16(float lo, float hi) { unsigned r; asm volatile("v_cvt_pk_bf16_f32 %0, %1, %2" : "=v"(r) : "v"(lo), "v"(hi)); return r; }
typedef float f32x2 __attribute__((ext_vector_type(2)));
typedef unsigned u32x2 __attribute__((ext_vector_type(2)));
constexpr float kLog2e = 1.4426950408889634f;
constexpr float kEps = 1e-6f;
constexpr float QS_SB = 0.125f * kLog2e;
constexpr float QS_MLA = 0.10206207261596577f * kLog2e;
__device__ __forceinline__ u32x2 pack4(f32x4 v) { u32x2 w; w.x = cvt_pk_bf16(v[0], v[1]); w.y = cvt_pk_bf16(v[2], v[3]); return w; }
__device__ __forceinline__ float sigmoid_f(float v) { return __builtin_amdgcn_rcpf(1.0f + __builtin_amdgcn_exp2f(-kLog2e * v)); }
__device__ __forceinline__ f32x4 silu4(f32x4 v) { f32x4 o; o[0] = v[0] * sigmoid_f(v[0]); o[1] = v[1] * sigmoid_f(v[1]); o[2] = v[2] * sigmoid_f(v[2]); o[3] = v[3] * sigmoid_f(v[3]); return o; }
__device__ __forceinline__ f32x4 unpack4(u32x2 w) { f32x4 o; o[0] = __uint_as_float(w.x << 16); o[1] = __uint_as_float(w.x & 0xffff0000u); o[2] = __uint_as_float(w.y << 16); o[3] = __uint_as_float(w.y & 0xffff0000u); return o; }
__device__ __forceinline__ float sumsq4(f32x4 v) { return (v[0] * v[0] + v[1] * v[1]) + (v[2] * v[2] + v[3] * v[3]); }
typedef unsigned u32x4e __attribute__((ext_vector_type(4)));
__device__ __forceinline__ u32x4e pack8(f32x4 a, f32x4 b) { u32x4e w; w.x = cvt_pk_bf16(a[0], a[1]); w.y = cvt_pk_bf16(a[2], a[3]); w.z = cvt_pk_bf16(b[0], b[1]); w.w = cvt_pk_bf16(b[2], b[3]); return w; }
__device__ __forceinline__ f32x4 rope4p(f32x4 v, const float* c, float sg) {
    const f32x4 c0 = *(const f32x4*)(c), c1 = *(const f32x4*)(c + 4);
    f32x4 o;
    o[0] = v[0] * c0[0] + (__shfl_xor(v[0], 32) * sg) * c0[1]; o[1] = v[1] * c0[2] + (__shfl_xor(v[1], 32) * sg) * c0[3];
    o[2] = v[2] * c1[0] + (__shfl_xor(v[2], 32) * sg) * c1[1]; o[3] = v[3] * c1[2] + (__shfl_xor(v[3], 32) * sg) * c1[3];
    return o;
}
__device__ __forceinline__ void rope8(f32x4& v0, f32x4& v1, const float* cs, int fq) {
    const float* c = cs + 16 * (fq & 1); const float sg = (fq < 2) ? -1.0f : 1.0f;
    v0 = rope4p(v0, c, sg); v1 = rope4p(v1, c + 8, sg);
}

struct EpiProj {
    static constexpr bool PERM = true, AFTER_DRAIN = false;
    unsigned char* ws;
    __device__ __forceinline__ void operator()(const f32x4 (&acc)[2][2][4][2], const Unit& u, int wr, int wc, int fr, int fq) const {
        const int pn = u.pn;
        bf16_t* const SBQ = (bf16_t*)(ws + WS_SBQ); bf16_t* const GATE = (bf16_t*)(ws + WS_B); bf16_t* const CQ = (bf16_t*)(ws + WS_CQ); bf16_t* const CKV = (bf16_t*)(ws + WS_CKV); bf16_t* const MK = (bf16_t*)(ws + WS_MK);
        float* const RQSS = (float*)(ws + WS_RQSS); float* const RKVSS = (float*)(ws + WS_RKVSS); const float* const rpre = (const float*)(ws + WS_RPRE); const float* const cs = (const float*)(ws + WS_CS);
        float rsv[2][4];
#pragma unroll
        for (int ai = 0; ai < 2; ++ai)
#pragma unroll
            for (int m = 0; m < 4; ++m) rsv[ai][m] = rpre[u.pm * BM + ai * HALF + wr * 64 + m * 16 + fr];
#pragma unroll
        for (int ai = 0; ai < 2; ++ai)
#pragma unroll
            for (int m = 0; m < 4; ++m) {
                const int row = u.pm * BM + ai * HALF + wr * 64 + m * 16 + fr;
                const float rs = rsv[ai][m];
                const int cw = wc * 32 + fq * 8;
#define PV_(bj, n) (acc[ai][bj][m][n] * rs)
                if (pn < 6) {
                    bf16_t* dst = SBQ + (size_t)(pn >> 1) * (size_t)(16u << 20) + (size_t)row * 512 + (pn & 1) * 256 + cw;
                    const float sc = pn < 2 ? QS_SB * rs : rs;
#pragma unroll
                    for (int bj = 0; bj < 2; ++bj) *(u32x4e*)(dst + bj * HALF) = pack8(acc[ai][bj][m][0] * sc, acc[ai][bj][m][1] * sc);
                } else if (pn < 8) {
                    bf16_t* dst = GATE + (size_t)row * 1024 + (pn - 6) * 256 + cw;
#pragma unroll
                    for (int bj = 0; bj < 2; ++bj) *(u32x4e*)(dst + bj * HALF) = pack8(silu4(PV_(bj, 0)), silu4(PV_(bj, 1)));
                } else if (pn == 8) {
                    bf16_t* dst = CQ + (size_t)row * 256 + cw; float ss = 0.f;
#pragma unroll
                    for (int bj = 0; bj < 2; ++bj) { const f32x4 a = PV_(bj, 0), b = PV_(bj, 1); *(u32x4e*)(dst + bj * HALF) = pack8(a, b); ss += sumsq4(a) + sumsq4(b); }
                    ss += __shfl_xor(ss, 16); ss += __shfl_xor(ss, 32);
                    if (fq == 0) RQSS[(size_t)row * 4 + wc] = ss;
                } else if (pn == 9) {
                    bf16_t* dst = CKV + (size_t)row * 256 + cw;
                    { const f32x4 a = PV_(0, 0), b = PV_(0, 1);
                      *(u32x4e*)dst = pack8(a, b); *(u32x4e*)(dst + HALF) = (u32x4e){0u, 0u, 0u, 0u};
                      float ss = sumsq4(a) + sumsq4(b);
                      ss += __shfl_xor(ss, 16); ss += __shfl_xor(ss, 32);
                      if (fq == 0) RKVSS[(size_t)row * 4 + wc] = ss; }
                    if (wc == 0) {
                        f32x4 x0 = PV_(1, 0), x1 = PV_(1, 1); rope8(x0, x1, cs + (size_t)row * 32, fq);
                        const u32x4e w = pack8(x0, x1);
                        bf16_t* kd = MK + (size_t)row * 768 + 64 + fq * 8;
#pragma unroll
                        for (int h = 0; h < 8; ++h) *(u32x4e*)(kd + h * 96) = w;
                    } else {
                        *(u32x4e*)(GATE + (size_t)row * 1024 + 512 + (wc - 1) * 32 + fq * 8) = pack8(silu4(PV_(1, 0)), silu4(PV_(1, 1)));
                    }
                } else {
                    const int base = 96 + (pn - 10) * 256 + cw;
#pragma unroll
                    for (int bj = 0; bj < 2; ++bj) { const int idx = base + bj * HALF; if (idx < 512) *(u32x4e*)(GATE + (size_t)row * 1024 + 512 + idx) = pack8(silu4(PV_(bj, 0)), silu4(PV_(bj, 1))); }
                }
#undef PV_
            }
    }
};
struct EpiQ {
    static constexpr bool PERM = true, AFTER_DRAIN = false;
    bf16_t* MQ; const float* RQSS; const float* cs;
    __device__ __forceinline__ void operator()(const f32x4 (&acc)[2][2][4][2], const Unit& u, int wr, int wc, int fr, int fq) const {
        float rsv[2][4];
#pragma unroll
        for (int ai = 0; ai < 2; ++ai)
#pragma unroll
            for (int m = 0; m < 4; ++m) { const f32x4 s4 = *(const f32x4*)(RQSS + (size_t)(u.pm * BM + ai * HALF + wr * 64 + m * 16 + fr) * 4);
                rsv[ai][m] = QS_MLA * __builtin_amdgcn_rsqf(((s4[0] + s4[1]) + (s4[2] + s4[3])) * (1.0f / 256.0f) + kEps); }
#pragma unroll
        for (int ai = 0; ai < 2; ++ai)
#pragma unroll
            for (int m = 0; m < 4; ++m) {
                const int row = u.pm * BM + ai * HALF + wr * 64 + m * 16 + fr;
                const float rs = rsv[ai][m];
#pragma unroll
                for (int bj = 0; bj < 2; ++bj) {
                    const int g = u.pn * 8 + bj * 4 + wc;
                    f32x4 x0 = acc[ai][bj][m][0] * rs, x1 = acc[ai][bj][m][1] * rs;
                    if (g % 3 == 2) rope8(x0, x1, cs + (size_t)row * 32, fq);
                    *(u32x4e*)(MQ + (size_t)row * 768 + g * 32 + fq * 8) = pack8(x0, x1);
                }
            }
    }
};
struct EpiKV {
    static constexpr bool PERM = true, AFTER_DRAIN = false;
    bf16_t *MK, *MV; const float* RKVSS;
    __device__ __forceinline__ void operator()(const f32x4 (&acc)[2][2][4][2], const Unit& u, int wr, int wc, int fr, int fq) const {
        float rsv[2][4];
#pragma unroll
        for (int ai = 0; ai < 2; ++ai)
#pragma unroll
            for (int m = 0; m < 4; ++m) { const f32x4 s4 = *(const f32x4*)(RKVSS + (size_t)(u.pm * BM + ai * HALF + wr * 64 + m * 16 + fr) * 4);
                rsv[ai][m] = __builtin_amdgcn_rsqf(((s4[0] + s4[1]) + (s4[2] + s4[3])) * (1.0f / 128.0f) + kEps); }
#pragma unroll
        for (int ai = 0; ai < 2; ++ai)
#pragma unroll
            for (int m = 0; m < 4; ++m) {
                const int row = u.pm * BM + ai * HALF + wr * 64 + m * 16 + fr;
                const float rs = rsv[ai][m];
#pragma unroll
                for (int bj = 0; bj < 2; ++bj) {
                    const int h = u.pn * 2 + bj;
                    bf16_t* dst = (wc < 2) ? (MK + (size_t)row * 768 + h * 96 + wc * 32 + fq * 8) : (MV + (size_t)row * 512 + h * 64 + (wc - 2) * 32 + fq * 8);
                    *(u32x4e*)dst = pack8(acc[ai][bj][m][0] * rs, acc[ai][bj][m][1] * rs);
                }
            }
    }
};
struct EpiStat {
    static constexpr bool PERM = true, AFTER_DRAIN = false;
    bf16_t* OUT; float* SS;
    __device__ __forceinline__ void operator()(const f32x4 (&acc)[2][2][4][2], const Unit& u, int wr, int wc, int fr, int fq) const {
#pragma unroll
        for (int ai = 0; ai < 2; ++ai)
#pragma unroll
            for (int m = 0; m < 4; ++m) {
                const int row = u.pm * BM + ai * HALF + wr * 64 + m * 16 + fr;
                bf16_t* dst = OUT + (size_t)row * 1024 + u.pn * BM + wc * 32 + fq * 8; float ss = 0.f;
#pragma unroll
                for (int bj = 0; bj < 2; ++bj) { const f32x4 v0 = acc[ai][bj][m][0], v1 = acc[ai][bj][m][1];
                    u32x4e w; w.x = cvt_pk_bf16(v0[0], v0[1]); w.y = cvt_pk_bf16(v0[2], v0[3]); w.z = cvt_pk_bf16(v1[0], v1[1]); w.w = cvt_pk_bf16(v1[2], v1[3]);
                    *(u32x4e*)(dst + bj * HALF) = w; ss += sumsq4(v0) + sumsq4(v1); }
                ss += __shfl_xor(ss, 16); ss += __shfl_xor(ss, 32);
                if (fq == 0) SS[(size_t)row * 16 + u.pn * 4 + wc] = ss;
            }
    }
};
struct EpiFinal {
    static constexpr bool PERM = true, AFTER_DRAIN = false;
    const float* x; const bf16_t* Y; const bf16_t* PLE; const float* RY; const float* RP; const float* gpost; const float* gple; const float* bias; float* out;
    __device__ __forceinline__ void operator()(const f32x4 (&acc)[2][2][4][2], const Unit& u, int wr, int wc, int fr, int fq) const {
        const int colb = u.pn * BM + wc * 32 + fq * 8;
#pragma unroll
        for (int ai = 0; ai < 2; ++ai)
#pragma unroll
            for (int mp = 0; mp < 4; mp += 2) {
                f32x4 xv[2][2][2]; u32x4e yw[2][2], pw[2][2]; float ry[2], rp[2];
#pragma unroll
                for (int mm = 0; mm < 2; ++mm) {
                    const int row = u.pm * BM + ai * HALF + wr * 64 + (mp + mm) * 16 + fr;
                    ry[mm] = RY[row]; rp[mm] = RP[row];
#pragma unroll
                    for (int bj = 0; bj < 2; ++bj) { const size_t off = (size_t)row * 1024 + colb + bj * HALF;
                        xv[mm][bj][0] = *(const f32x4*)(x + off); xv[mm][bj][1] = *(const f32x4*)(x + off + 4); yw[mm][bj] = *(const u32x4e*)(Y + off); pw[mm][bj] = *(const u32x4e*)(PLE + off); }
                }
#pragma unroll
                for (int mm = 0; mm < 2; ++mm) {
                    const int row = u.pm * BM + ai * HALF + wr * 64 + (mp + mm) * 16 + fr;
#pragma unroll
                    for (int bj = 0; bj < 2; ++bj) { const int col = colb + bj * HALF; const size_t off = (size_t)row * 1024 + col;
#pragma unroll
                        for (int n = 0; n < 2; ++n) {
                            const f32x4 gp = *(const f32x4*)(gpost + col + 4 * n), gl = *(const f32x4*)(gple + col + 4 * n), bb = *(const f32x4*)(bias + col + 4 * n);
                            const f32x4 yv = unpack4((u32x2){n == 0 ? yw[mm][bj].x : yw[mm][bj].z, n == 0 ? yw[mm][bj].y : yw[mm][bj].w}), pv = unpack4((u32x2){n == 0 ? pw[mm][bj].x : pw[mm][bj].z, n == 0 ? pw[mm][bj].y : pw[mm][bj].w});
                            const f32x4 gt = acc[ai][bj][mp + mm][n] + bb; f32x4 o;
#pragma unroll
                            for (int e = 0; e < 4; ++e) o[e] = (xv[mm][bj][n][e] + yv[e] * ry[mm] * gp[e]) + pv[e] * rp[mm] * gl[e] * sigmoid_f(gt[e]);
                            *(f32x4*)(out + off + 4 * n) = o;
                        }
                    }
                }
            }
    }
};
template <class Epi, class Sched, bool ALIGN_EPI = false, bool SP2 = false>
__device__ __forceinline__ void gemm_phase(PG8_LAS unsigned char* lds, const Gemm g, const Sched& S, const Epi& E) {
    const int tid = threadIdx.x, wid = __builtin_amdgcn_readfirstlane(tid >> 6), lane = tid & 63, wr = wid >> 2, wc = wid & 3, fr = lane & 15, fq = lane >> 4;
    const int K = g.K, nt = K / BK;
    unsigned voffA[2], voffB[2];
#pragma unroll
    for (int i = 0; i < 2; ++i) { int R, C; stage_rc(tid * 16 + i * 8192, R, C); const int Rb = Epi::PERM ? ((R & ~31) + perm32(R & 31)) : R;
        voffA[i] = (unsigned)(R * K + C) * 2u; voffB[i] = (unsigned)(Rb * K + C) * 2u; }
    const size_t kstep = (size_t)(BK * 2);
    const size_t hstep = (size_t)HALF * K * 2;
    const size_t tstep = 2 * hstep;
    const unsigned ldsw = (unsigned)wid * 1024u;
    const int aoff = lds_byte(wr * 64 + fr, fq * 8), boff = lds_byte(wc * 32 + fr, fq * 8);
#define PG8_SA(b, h) (((b) * 2 + (h)) * HTB)
#define PG8_SB(b, h) ((4 + (b) * 2 + (h)) * HTB)
#define PG8_STAGE(bufoff, gbase, voff) do { _Pragma("unroll") for (int _i = 0; _i < 2; ++_i) \
        __builtin_amdgcn_global_load_lds((const unsigned*)((const char*)(gbase) + (voff)[_i]), (PG8_LAS unsigned*)(lds + (bufoff) + ldsw + _i * 8192), 16, 0, 0); } while (0)
#define PG8_LDA(dst, b, h) do { _Pragma("unroll") for (int m = 0; m < 4; ++m) _Pragma("unroll") for (int k = 0; k < 2; ++k) dst[m][k] = *(const PG8_LAS bf16x8*)(lds + PG8_SA(b, h) + aoff + m * 2048 + k * 1024); } while (0)
#define PG8_LDB(dst, b, h) do { _Pragma("unroll") for (int n = 0; n < 2; ++n) _Pragma("unroll") for (int k = 0; k < 2; ++k) dst[n][k] = *(const PG8_LAS bf16x8*)(lds + PG8_SB(b, h) + boff + n * 2048 + k * 1024); } while (0)
#define PG8_MMA(ai, bj, At, Bt) do { __builtin_amdgcn_s_setprio(1); _Pragma("unroll") for (int m = 0; m < 4; ++m) _Pragma("unroll") for (int n = 0; n < 2; ++n) _Pragma("unroll") for (int k = 0; k < 2; ++k) \
        acc[ai][bj][m][n] = __builtin_amdgcn_mfma_f32_16x16x32_bf16(Bt[n][k], At[m][k], acc[ai][bj][m][n], 0, 0, 0); __builtin_amdgcn_s_setprio(0); } while (0)
#define PG8_WAIT_V(n) asm volatile("s_waitcnt vmcnt(" #n ")" ::: "memory")
#define PG8_WAIT_L(n) asm volatile("s_waitcnt lgkmcnt(" #n ")" ::: "memory")
#define PG8_BAR __builtin_amdgcn_s_barrier()
#define PG8_SCHED __builtin_amdgcn_sched_barrier(0)
    Unit cur, nxt; int ui = 0;
    if (!S.next(0, cur)) return;
    f32x4 acc[2][2][4][2];
#pragma unroll
    for (int a = 0; a < 2; ++a)
#pragma unroll
        for (int b = 0; b < 2; ++b)
#pragma unroll
            for (int m = 0; m < 4; ++m)
#pragma unroll
                for (int n = 0; n < 2; ++n) acc[a][b][m][n] = (f32x4){0.f, 0.f, 0.f, 0.f};
    bf16x8 At[4][2], B0[2][2], B1[2][2];
    const char* cA = (const char*)g.A + (size_t)cur.pm * tstep; const char* cB = (const char*)g.Bt + (size_t)cur.pn * tstep;
    S.a_ready(cur);
    if constexpr (SP2) {
        PG8_STAGE(PG8_SB(0, 0), cB, voffB); PG8_STAGE(PG8_SB(0, 1), cB + hstep, voffB); PG8_STAGE(PG8_SA(0, 0), cA, voffA); PG8_STAGE(PG8_SA(0, 1), cA + hstep, voffA);
        if (wr == 1) PG8_BAR;
        PG8_WAIT_V(2); PG8_BAR;
        PG8_STAGE(PG8_SB(1, 0), cB + kstep, voffB); PG8_STAGE(PG8_SA(1, 0), cA + kstep, voffA); PG8_STAGE(PG8_SB(1, 1), cB + hstep + kstep, voffB);
        PG8_WAIT_V(6); PG8_BAR;
    } else {
        PG8_STAGE(PG8_SB(0, 0), cB, voffB); PG8_STAGE(PG8_SA(0, 0), cA, voffA); PG8_STAGE(PG8_SB(0, 1), cB + hstep, voffB); PG8_STAGE(PG8_SA(0, 1), cA + hstep, voffA);
        if (wr == 1) PG8_BAR;
        PG8_WAIT_V(4); PG8_BAR;
        PG8_STAGE(PG8_SB(1, 0), cB + kstep, voffB); PG8_STAGE(PG8_SA(1, 0), cA + kstep, voffA); PG8_STAGE(PG8_SB(1, 1), cB + hstep + kstep, voffB);
        PG8_WAIT_V(6); PG8_BAR;
    }
    for (;;) {
        const bool has_next = S.next(ui + 1, nxt);
        const char* nA = has_next ? (const char*)g.A + (size_t)nxt.pm * tstep : cA; const char* nB = has_next ? (const char*)g.Bt + (size_t)nxt.pn * tstep : cB;
        for (int t = 0; t < nt; t += 2) {
            const bool last = (t == nt - 2);
            const char* a1 = cA + (size_t)(t + 1) * kstep;
            const char* a2 = last ? nA : cA + (size_t)(t + 2) * kstep; const char* b2 = last ? nB : cB + (size_t)(t + 2) * kstep;
            const char* a3 = a2 + kstep; const char* b3 = b2 + kstep;
            if (last && has_next) S.a_ready(nxt);
            if constexpr (SP2) {
            PG8_LDB(B0, 0, 0); PG8_LDB(B1, 0, 1); PG8_SCHED; PG8_LDA(At, 0, 0); PG8_STAGE(PG8_SA(1, 1), a1 + hstep, voffA);
            PG8_WAIT_V(8); PG8_WAIT_L(0); PG8_BAR; PG8_MMA(0, 0, At, B0); PG8_MMA(0, 1, At, B1); PG8_BAR; PG8_SCHED;
            PG8_LDA(At, 0, 1); PG8_STAGE(PG8_SB(0, 0), b2, voffB); PG8_STAGE(PG8_SB(0, 1), b2 + hstep, voffB); PG8_STAGE(PG8_SA(0, 0), a2, voffA);
            PG8_WAIT_V(8); PG8_WAIT_L(0); PG8_BAR; PG8_MMA(1, 0, At, B0); PG8_MMA(1, 1, At, B1); PG8_BAR; PG8_SCHED;
            PG8_LDB(B0, 1, 0); PG8_LDB(B1, 1, 1); PG8_SCHED; PG8_LDA(At, 1, 0); PG8_STAGE(PG8_SA(0, 1), a2 + hstep, voffA);
            PG8_WAIT_V(8); PG8_WAIT_L(0); PG8_BAR; PG8_MMA(0, 0, At, B0); PG8_MMA(0, 1, At, B1); PG8_BAR; PG8_SCHED;
            PG8_LDA(At, 1, 1); PG8_STAGE(PG8_SB(1, 0), b3, voffB); PG8_STAGE(PG8_SB(1, 1), b3 + hstep, voffB); PG8_STAGE(PG8_SA(1, 0), a3, voffA);
            PG8_WAIT_V(8); PG8_WAIT_L(0); PG8_BAR; PG8_MMA(1, 0, At, B0); PG8_MMA(1, 1, At, B1); PG8_BAR; PG8_SCHED;
            } else {
            PG8_LDB(B0, 0, 0); PG8_SCHED; PG8_LDA(At, 0, 0); PG8_STAGE(PG8_SA(1, 1), a1 + hstep, voffA);
            PG8_WAIT_L(8); PG8_BAR; PG8_WAIT_L(0); PG8_MMA(0, 0, At, B0); PG8_BAR; PG8_SCHED;
            PG8_LDB(B1, 0, 1); PG8_STAGE(PG8_SB(0, 0), b2, voffB);
            PG8_BAR; PG8_WAIT_L(0); PG8_MMA(0, 1, At, B1); PG8_BAR;
            PG8_LDA(At, 0, 1); PG8_STAGE(PG8_SA(0, 0), a2, voffA);
            PG8_BAR; PG8_WAIT_L(0); PG8_MMA(1, 0, At, B0); PG8_BAR; PG8_SCHED;
            PG8_STAGE(PG8_SB(0, 1), b2 + hstep, voffB);
            PG8_WAIT_V(6); PG8_BAR; PG8_MMA(1, 1, At, B1); PG8_BAR;
            PG8_LDB(B0, 1, 0); PG8_SCHED; PG8_LDA(At, 1, 0); PG8_STAGE(PG8_SA(0, 1), a2 + hstep, voffA);
            PG8_WAIT_L(8); PG8_BAR; PG8_WAIT_L(0); PG8_MMA(0, 0, At, B0); PG8_BAR; PG8_SCHED;
            PG8_LDB(B1, 1, 1); PG8_STAGE(PG8_SB(1, 0), b3, voffB);
            PG8_BAR; PG8_WAIT_L(0); PG8_MMA(0, 1, At, B1); PG8_BAR;
            PG8_LDA(At, 1, 1); PG8_STAGE(PG8_SA(1, 0), a3, voffA);
            PG8_BAR; PG8_WAIT_L(0); PG8_MMA(1, 0, At, B0); PG8_BAR; PG8_SCHED;
            PG8_STAGE(PG8_SB(1, 1), b3 + hstep, voffB);
            PG8_WAIT_V(6); PG8_BAR; PG8_MMA(1, 1, At, B1); PG8_BAR;
            }
        }
        if constexpr (ALIGN_EPI) { if (wr == 0) PG8_BAR; }
        if constexpr (!Epi::AFTER_DRAIN) { E(acc, cur, wr, wc, fr, fq); S.done(cur); }
        if (!has_next) break;
#pragma unroll
        for (int a = 0; a < 2; ++a)
#pragma unroll
            for (int b = 0; b < 2; ++b)
#pragma unroll
                for (int m = 0; m < 4; ++m)
#pragma unroll
                    for (int n = 0; n < 2; ++n) acc[a][b][m][n] = (f32x4){0.f, 0.f, 0.f, 0.f};
        cur = nxt; cA = nA; cB = nB; ++ui;
        if constexpr (ALIGN_EPI) { if (wr == 1) PG8_BAR; }
    }
    PG8_WAIT_V(0);
    if constexpr (!ALIGN_EPI) { if (wr == 0) PG8_BAR; }
    PG8_BAR;
    if constexpr (Epi::AFTER_DRAIN) { E.fused(acc, cur, wr, wc, fr, fq, lds, wid, lane); S.done(cur); }
#undef PG8_SA
#undef PG8_SB
#undef PG8_STAGE
#undef PG8_LDA
#undef PG8_LDB
#undef PG8_MMA
#undef PG8_WAIT_V
#undef PG8_WAIT_L
#undef PG8_BAR
#undef PG8_SCHED
}
}
namespace att {
using bf16x8 = __attribute__((ext_vector_type(8))) short;
using s16x4 = __attribute__((ext_vector_type(4))) short;
using f32x16 = __attribute__((ext_vector_type(16))) float;
using f32x4 = __attribute__((ext_vector_type(4))) float;
using u32x4 = __attribute__((ext_vector_type(4))) unsigned;
typedef unsigned short bf16_t;
#define ALAS __attribute__((address_space(3)))
constexpr int SEQ = 4096, KSLOT = 16384, VSLOT = 8192, NSLOT = 3;
constexpr int L_K = 0, L_V = NSLOT * KSLOT, L_WS = L_V + NSLOT * VSLOT, L_FLAG = L_WS + 8 * 64 * 4, L_OST = L_FLAG + 256, L_END = L_OST + 8 * 8192;
constexpr float kEps = 1e-6f;
constexpr float SB_DONE = 151.0f;
__device__ __forceinline__ int crow(int r, int hi) { return (r & 3) + 8 * (r >> 2) + 4 * hi; }
__device__ __forceinline__ void glds16(const void* gsrc, unsigned lds_dst) { unsigned keep;
    asm volatile("s_mov_b32 %0, m0\n\ts_mov_b32 m0, %2\n\ts_nop 0\n\tglobal_load_lds_dwordx4 %1, off\n\ts_mov_b32 m0, %0" : "=&s"(keep) : "v"(gsrc), "s"(lds_dst) : "memory"); }
typedef float f32x2_t __attribute__((ext_vector_type(2))); typedef __bf16 bf16x2_t __attribute__((ext_vector_type(2)));
__device__ __forceinline__ unsigned cvtpk(float lo, float hi) { f32x2_t v = {lo, hi}; bf16x2_t b = __builtin_convertvector(v, bf16x2_t); return __builtin_bit_cast(unsigned, b); }
#define A_WAIT_BAR(N) asm volatile("s_waitcnt vmcnt(" #N ") lgkmcnt(0)\n\ts_barrier" ::: "memory")

template <int ND0> __device__ __forceinline__ void qkt(f32x16& p0, f32x16& p1, const ALAS char* Kslot, const bf16x8* qr, int r32, int hi) {
    const ALAS char* kb = Kslot + hi * 1024 + r32 * 16;
    p0 = f32x16{}; p1 = f32x16{};
#pragma unroll
    for (int d0 = 0; d0 < ND0; ++d0) {
        const bf16x8 b0 = *(const ALAS bf16x8*)(kb + d0 * 2048);
        const bf16x8 b1 = *(const ALAS bf16x8*)(kb + d0 * 2048 + 512);
        p0 = __builtin_amdgcn_mfma_f32_32x32x16_bf16(b0, qr[d0], p0, 0, 0, 0);
        p1 = __builtin_amdgcn_mfma_f32_32x32x16_bf16(b1, qr[d0], p1, 0, 0, 0);
    }
}
__device__ __forceinline__ void pv(f32x16* o, int vb, bf16x8 pa0, bf16x8 pa1, bf16x8 pa2, bf16x8 pa3) {
#pragma unroll
    for (int d0 = 0; d0 < 2; ++d0) { s16x4 lo[4], hi[4];
#pragma unroll
        for (int ks = 0; ks < 4; ++ks) {
            asm volatile("ds_read_b64_tr_b16 %0,%1 offset:%c2" : "=&v"(lo[ks]) : "v"(vb), "i"(d0 * 4096 + ks * 1024) : "memory");
            asm volatile("ds_read_b64_tr_b16 %0,%1 offset:%c2" : "=&v"(hi[ks]) : "v"(vb), "i"(d0 * 4096 + ks * 1024 + 512) : "memory"); }
        asm volatile("s_waitcnt lgkmcnt(0)" ::: "memory"); __builtin_amdgcn_sched_barrier(0);
#define A_PK(k) (bf16x8){lo[k][0], lo[k][1], lo[k][2], lo[k][3], hi[k][0], hi[k][1], hi[k][2], hi[k][3]}
        o[d0] = __builtin_amdgcn_mfma_f32_32x32x16_bf16(pa0, A_PK(0), o[d0], 0, 0, 0);
        o[d0] = __builtin_amdgcn_mfma_f32_32x32x16_bf16(pa1, A_PK(1), o[d0], 0, 0, 0);
        o[d0] = __builtin_amdgcn_mfma_f32_32x32x16_bf16(pa2, A_PK(2), o[d0], 0, 0, 0);
        o[d0] = __builtin_amdgcn_mfma_f32_32x32x16_bf16(pa3, A_PK(3), o[d0], 0, 0, 0);
#undef A_PK
    }
}
typedef short v4i16_t __attribute__((ext_vector_type(4)));
__device__ __forceinline__ s16x4 vtr(const ALAS char* p) { return __builtin_bit_cast(s16x4, __builtin_amdgcn_ds_read_tr16_b64_v4i16((ALAS v4i16_t*)p)); }
__device__ __forceinline__ float xhalf_sum(float v) { auto rr = __builtin_amdgcn_permlane32_swap(__float_as_uint(v), __float_as_uint(v), false, false); return __uint_as_float(rr[0]) + __uint_as_float(rr[1]); }
__device__ __forceinline__ float xhalf_max(float v) { auto rr = __builtin_amdgcn_permlane32_swap(__float_as_uint(v), __float_as_uint(v), false, false); return fmaxf(__uint_as_float(rr[0]), __uint_as_float(rr[1])); }

template <bool SBK> __device__ __forceinline__ void attn_unit(int b, int h, int qb, const bf16_t* Q, const bf16_t* K, const bf16_t* V, const bf16_t* gate, const float* gnorm, bf16_t* out, int goff, ALAS char* shm) {
    constexpr int DQK = SBK ? 64 : 96, QP = SBK ? 512 : 768, ND0 = DQK / 16;
    const int tid = threadIdx.x, lane = tid & 63, r32 = lane & 31, hi = lane >> 5; const int wid = __builtin_amdgcn_readfirstlane(tid >> 6);
    const long rowbase = (long)b * SEQ; const int q0 = qb * 256;
    const bf16_t* Qw = Q + (rowbase + q0 + wid * 32) * QP + h * DQK;
    const bf16_t* Kh = K + rowbase * QP + h * DQK; const bf16_t* Vh = V + rowbase * 512 + h * 64;
    const unsigned lds0 = (unsigned)(uintptr_t)shm;
    ALAS float* wsf = (ALAS float*)(shm + L_WS) + wid * 64;
    ALAS unsigned* flags = (ALAS unsigned*)(shm + L_FLAG);
    const bf16_t* ksrc = Kh + (long)lane * QP + wid * 8;
    const bf16_t* ksrc2 = Kh + (long)lane * QP + (8 + (wid & 3)) * 8;
    const bf16_t* vsrc = Vh + (long)(16 * (wid & 3) + (lane >> 2)) * 512 + (wid >> 2) * 32 + (lane & 3) * 8;
    const unsigned kdst = lds0 + L_K + wid * 1024, vdst = lds0 + L_V + wid * 1024;
    const int NT = 4 * qb + 4;
    const int tw = 4 * qb + (wid >> 1);
#define A_TILE(i) (SBK ? (NT - 1 - (i)) : (i))
#define A_DMA(i, s) do { const int t_ = A_TILE(i); glds16(ksrc + (long)t_ * 64 * QP, (unsigned)__builtin_amdgcn_readfirstlane(kdst + (s) * KSLOT)); \
        if (!SBK) glds16(ksrc2 + (long)t_ * 64 * QP, (unsigned)__builtin_amdgcn_readfirstlane(kdst + 8192 + (s) * KSLOT)); \
        glds16(vsrc + (long)t_ * 64 * 512, (unsigned)__builtin_amdgcn_readfirstlane(vdst + (s) * VSLOT)); } while (0)
    A_DMA(0, 0); A_DMA(1, 1);
    bf16x8 qr[ND0];
#pragma unroll
    for (int d0 = 0; d0 < ND0; ++d0) qr[d0] = *(const bf16x8*)(Qw + (long)r32 * QP + d0 * 16 + hi * 8);
    f32x16 o[2]; o[0] = f32x16{}; o[1] = f32x16{};
    float m_run = -INFINITY, l_run = 0.f, carry = 0.f;
    const int vb0 = (int)(lds0 + L_V) + ((lane >> 4) & 1) * 32 + (lane & 3) * 8 + (4 * hi + ((lane & 15) >> 2)) * 64;
    int slot = 0;
    for (int i = 0; i < NT; ++i) {
        if (i + 1 < NT) { if (SBK) { A_WAIT_BAR(2); } else { A_WAIT_BAR(3); } } else { A_WAIT_BAR(0); }
        if (SBK && i > 0) {
            const ALAS unsigned* fl = flags + ((i - 1) & 1) * 8; unsigned all = 1u;
#pragma unroll
            for (int w = 0; w < 8; ++w) all &= fl[w];
            if (all) break;
        }
        if (i + 2 < NT) { const int s2 = (slot >= 1) ? slot - 1 : slot + 2; A_DMA(i + 2, s2); }
        const int t = A_TILE(i);
        if (t <= tw) {
            f32x16 p0, p1;
            qkt<ND0>(p0, p1, shm + L_K + slot * KSLOT, qr, r32, hi);
            if (SBK) {
                if (t == tw) { const int qrel = 32 * (wid & 1) + r32;
#pragma unroll
                    for (int r = 0; r < 16; ++r) { const int kv = crow(r, hi); if (kv >= qrel) p0[r] = -INFINITY; if (kv + 32 >= qrel) p1[r] = -INFINITY; } }
                f32x16 s0, s1;
#pragma unroll
                for (int r = 0; r < 16; ++r) {
                    s0[r] = fmaxf(p0[r], 0.f) + __builtin_amdgcn_logf(1.0f + __builtin_amdgcn_exp2f(-fabsf(p0[r])));
                    s1[r] = fmaxf(p1[r], 0.f) + __builtin_amdgcn_logf(1.0f + __builtin_amdgcn_exp2f(-fabsf(p1[r])));
                }
                float lo_[8], up_[8];
#pragma unroll
                for (int i4 = 0; i4 < 8; ++i4) {
                    const float bs = (i4 < 4) ? ((s0[4 * i4] + s0[4 * i4 + 1]) + (s0[4 * i4 + 2] + s0[4 * i4 + 3])) : ((s1[4 * i4 - 16] + s1[4 * i4 - 15]) + (s1[4 * i4 - 14] + s1[4 * i4 - 13]));
                    auto rr = __builtin_amdgcn_permlane32_swap(__float_as_uint(bs), __float_as_uint(bs), false, false);
                    lo_[i4] = __uint_as_float(rr[0]); up_[i4] = __uint_as_float(rr[1]);
                }
                float run = carry;
#pragma unroll
                for (int i4 = 7; i4 >= 0; --i4) {
                    float c = run + (hi == 0 ? up_[i4] : 0.f);
#pragma unroll
                    for (int e = 3; e >= 0; --e) {
                        if (i4 < 4) { c += s0[4 * i4 + e]; p0[4 * i4 + e] = __builtin_amdgcn_exp2f(p0[4 * i4 + e] - c); }
                        else { c += s1[4 * i4 - 16 + e]; p1[4 * i4 - 16 + e] = __builtin_amdgcn_exp2f(p1[4 * i4 - 16 + e] - c); }
                    }
                    run += lo_[i4] + up_[i4];
                }
                carry = run;
            } else {
                float rm = fmaxf(p0[0], p1[0]);
#pragma unroll
                for (int r = 1; r < 16; ++r) rm = fmaxf(rm, fmaxf(p0[r], p1[r]));
                rm = xhalf_max(rm);
                const float m_new = fmaxf(m_run, rm);
                const float alpha = __builtin_amdgcn_exp2f(m_run - m_new);
                float ls = 0.f;
#pragma unroll
                for (int r = 0; r < 16; ++r) { p0[r] = __builtin_amdgcn_exp2f(p0[r] - m_new); p1[r] = __builtin_amdgcn_exp2f(p1[r] - m_new); ls += p0[r] + p1[r]; }
                l_run = l_run * alpha + ls; m_run = m_new;
                if (!__all(alpha == 1.0f)) {
                    if (hi == 0) wsf[r32] = alpha;
#pragma unroll
                    for (int r = 0; r < 16; ++r) { const float f = wsf[crow(r, hi)]; o[0][r] *= f; o[1][r] *= f; }
                }
            }
            u32x4 pw0, pw1, pw2, pw3;
            pw0 = (u32x4){cvtpk(p0[0], p0[1]), cvtpk(p0[2], p0[3]), cvtpk(p0[4], p0[5]), cvtpk(p0[6], p0[7])};
            pw1 = (u32x4){cvtpk(p0[8], p0[9]), cvtpk(p0[10], p0[11]), cvtpk(p0[12], p0[13]), cvtpk(p0[14], p0[15])};
            pw2 = (u32x4){cvtpk(p1[0], p1[1]), cvtpk(p1[2], p1[3]), cvtpk(p1[4], p1[5]), cvtpk(p1[6], p1[7])};
            pw3 = (u32x4){cvtpk(p1[8], p1[9]), cvtpk(p1[10], p1[11]), cvtpk(p1[12], p1[13]), cvtpk(p1[14], p1[15])};
            pv(o, vb0 + slot * VSLOT, __builtin_bit_cast(bf16x8, pw0), __builtin_bit_cast(bf16x8, pw1), __builtin_bit_cast(bf16x8, pw2), __builtin_bit_cast(bf16x8, pw3));
        }
        if (SBK) { const bool done = (t <= tw) && __all(carry > SB_DONE); if (lane == 0) flags[(i & 1) * 8 + wid] = done ? 1u : 0u; }
        slot = (slot == NSLOT - 1) ? 0 : slot + 1;
    }
    A_WAIT_BAR(0);
    float rli[16];
    if (!SBK) {
        const float lt = xhalf_sum(l_run);
        if (hi == 0) wsf[32 + r32] = lt;
#pragma unroll
        for (int r = 0; r < 16; ++r) rli[r] = __builtin_amdgcn_rcpf(wsf[32 + crow(r, hi)]);
    } else {
#pragma unroll
        for (int r = 0; r < 16; ++r) rli[r] = 1.0f;
    }
    ALAS float* stg = (ALAS float*)(shm + L_OST) + wid * 2048;
#pragma unroll
    for (int r = 0; r < 16; ++r) { const int orow = crow(r, hi);
#pragma unroll
        for (int d0 = 0; d0 < 2; ++d0) stg[orow * 64 + d0 * 32 + r32] = o[d0][r] * rli[r]; }
    const long grow0 = rowbase + q0 + wid * 32;
    u32x4 gvp[4];
#pragma unroll
    for (int i = 0; i < 4; ++i) gvp[i] = *(const u32x4*)(gate + (size_t)(grow0 + i * 8 + (lane >> 3)) * 1024 + goff + h * 64 + (lane & 7) * 8);
#pragma unroll
    for (int i = 0; i < 4; ++i) {
        const int row = i * 8 + (lane >> 3), ch = lane & 7;
        const f32x4 a = *(const ALAS f32x4*)(stg + row * 64 + ch * 8), c = *(const ALAS f32x4*)(stg + row * 64 + ch * 8 + 4);
        float ss = ((a[0] * a[0] + a[1] * a[1]) + (a[2] * a[2] + a[3] * a[3])) + ((c[0] * c[0] + c[1] * c[1]) + (c[2] * c[2] + c[3] * c[3]));
        ss += __shfl_xor(ss, 1); ss += __shfl_xor(ss, 2); ss += __shfl_xor(ss, 4);
        const float rn = 1.0f / sqrtf(ss * (1.0f / 64.0f) + kEps);
        const size_t off = (size_t)(grow0 + row) * 1024 + goff + h * 64 + ch * 8;
        const u32x4 gv = gvp[i];
        const f32x4 g0 = *(const f32x4*)(gnorm + h * 64 + ch * 8), g1 = *(const f32x4*)(gnorm + h * 64 + ch * 8 + 4);
        float v[8];
#pragma unroll
        for (int e = 0; e < 4; ++e) { v[e] = a[e] * rn * g0[e]; v[4 + e] = c[e] * rn * g1[e]; }
        u32x4 w;
#pragma unroll
        for (int e = 0; e < 4; ++e) { const unsigned gw = gv[e]; w[e] = cvtpk(v[2 * e] * __uint_as_float(gw << 16), v[2 * e + 1] * __uint_as_float(gw & 0xffff0000u)); }
        *(u32x4*)(out + off) = w;
    }
    A_WAIT_BAR(0);
#undef A_TILE
#undef A_DMA
}

constexpr int M_K = 0, M_V = NSLOT * KSLOT, M_WS = M_V + 4 * VSLOT, M_END = M_WS + 8 * 64 * 4;
constexpr float MLA_THR = 8.0f;
#define A_BAR_L() asm volatile("s_waitcnt lgkmcnt(0)\n\ts_barrier" ::: "memory")
__device__ __forceinline__ void mla_unit(int b, int h, int qb, const bf16_t* Q, const bf16_t* K, const bf16_t* V, const bf16_t* gate, const float* gnorm, bf16_t* out, int goff, ALAS char* shm) {
    constexpr int QP = 768, ND0 = 6;
    const int tid = threadIdx.x, lane = tid & 63, r32 = lane & 31, hi = lane >> 5; const int wid = __builtin_amdgcn_readfirstlane(tid >> 6);
    const int grp = wid >> 2;
    const long rowbase = (long)b * SEQ; const int q0 = qb * 256;
    const bf16_t* Qw = Q + (rowbase + q0 + wid * 32) * QP + h * 96;
    const bf16_t* Kh = K + rowbase * QP + h * 96; const bf16_t* Vh = V + rowbase * 512 + h * 64;
    const unsigned lds0 = (unsigned)(uintptr_t)shm;
    ALAS float* wsf = (ALAS float*)(shm + M_WS) + wid * 64;
    const bf16_t* ksrc = Kh + (long)lane * QP + wid * 8;
    const bf16_t* ksrc2 = Kh + (long)lane * QP + (8 + (wid & 3)) * 8;
    const bf16_t* vsrc = Vh + (long)(16 * (wid & 3) + (lane >> 2)) * 512 + (wid >> 2) * 32 + (lane & 3) * 8;
    const unsigned kdst = lds0 + M_K + wid * 1024, vdst = lds0 + M_V + wid * 1024;
    const int NT = 4 * qb + 4, tw = 4 * qb + (wid >> 1);
#define M_DMA(t_) do { const int tt_ = (t_); const int ks_ = tt_ % 3, vs_ = tt_ & 3; glds16(ksrc + (long)tt_ * 64 * QP, (unsigned)__builtin_amdgcn_readfirstlane(kdst + ks_ * KSLOT)); \
        glds16(ksrc2 + (long)tt_ * 64 * QP, (unsigned)__builtin_amdgcn_readfirstlane(kdst + 8192 + ks_ * KSLOT)); \
        glds16(vsrc + (long)tt_ * 64 * 512, (unsigned)__builtin_amdgcn_readfirstlane(vdst + vs_ * VSLOT)); } while (0)
    M_DMA(0); M_DMA(1);
    bf16x8 qr[ND0];
#pragma unroll
    for (int d0 = 0; d0 < ND0; ++d0) qr[d0] = *(const bf16x8*)(Qw + (long)r32 * QP + d0 * 16 + hi * 8);
    f32x16 o[2]; o[0] = f32x16{}; o[1] = f32x16{};
    f32x16 negm = f32x16{}; f32x16 p0 = f32x16{}, p1 = f32x16{};
    u32x4 pw0 = {0u, 0u, 0u, 0u}, pw1 = pw0, pw2 = pw0, pw3 = pw0;
    float m_hat = 0.f, l_run = 0.f; bool need = false;
    const int vb0 = (int)(lds0 + M_V) + ((lane >> 4) & 1) * 32 + (lane & 3) * 8 + (4 * hi + ((lane & 15) >> 2)) * 64;
    const int voff = ((lane >> 4) & 1) * 32 + (lane & 3) * 8 + (4 * hi + ((lane & 15) >> 2)) * 64;
#define M_BAR_EVEN(t_) do { if ((t_) + 1 < NT) { A_WAIT_BAR(3); } else { A_WAIT_BAR(0); } if ((t_) + 2 < NT) M_DMA((t_) + 2); } while (0)
#define M_KLD(d0) do { kf_[2 * (d0)] = *(const ALAS bf16x8*)(kb_ + (d0) * 2048); kf_[2 * (d0) + 1] = *(const ALAS bf16x8*)(kb_ + (d0) * 2048 + 512); } while (0)
#define M_QK(d0) do { p0 = __builtin_amdgcn_mfma_f32_32x32x16_bf16(kf_[2 * (d0)], qr[d0], (d0) == 0 ? negm : p0, 0, 0, 0); p1 = __builtin_amdgcn_mfma_f32_32x32x16_bf16(kf_[2 * (d0) + 1], qr[d0], (d0) == 0 ? negm : p1, 0, 0, 0); } while (0)
#define M_STAGE_A(t_) do { const int ta_ = (t_); \
        const ALAS char* vp_ = shm + M_V + ((ta_ - 1) & 3) * VSLOT + voff; const ALAS char* kb_ = shm + M_K + (ta_ % 3) * KSLOT + hi * 1024 + r32 * 16; \
        s16x4 vl_[4], vh_[4]; bf16x8 kf_[12]; \
        _Pragma("unroll") for (int ks = 0; ks < 4; ++ks) { vl_[ks] = vtr(vp_ + ks * 1024); vh_[ks] = vtr(vp_ + ks * 1024 + 512); } \
        M_KLD(0); M_KLD(1); \
        __builtin_amdgcn_sched_barrier(0); \
        if (need) { _Pragma("unroll") for (int r = 0; r < 16; ++r) { const float f = wsf[crow(r, hi)]; o[0][r] *= f; o[1][r] *= f; } } \
        _Pragma("unroll") for (int ks = 0; ks < 4; ++ks) o[0] = __builtin_amdgcn_mfma_f32_32x32x16_bf16(M_PA(ks), M_VF(ks), o[0], 0, 0, 0); \
        __builtin_amdgcn_sched_barrier(0); \
        M_KLD(2); M_KLD(3); \
        __builtin_amdgcn_sched_barrier(0); \
        M_QK(0); M_QK(1); \
        __builtin_amdgcn_sched_barrier(0); \
        _Pragma("unroll") for (int ks = 0; ks < 4; ++ks) { vl_[ks] = vtr(vp_ + 4096 + ks * 1024); vh_[ks] = vtr(vp_ + 4096 + ks * 1024 + 512); } \
        M_KLD(4); M_KLD(5); \
        __builtin_amdgcn_sched_barrier(0); \
        M_QK(2); M_QK(3); M_QK(4); M_QK(5); \
        _Pragma("unroll") for (int ks = 0; ks < 4; ++ks) o[1] = __builtin_amdgcn_mfma_f32_32x32x16_bf16(M_PA(ks), M_VF(ks), o[1], 0, 0, 0); } while (0)
      \
#define M_STAGE_A_SW(t_, PVON, QKON) do { const int ta_ = (t_); \
        if (PVON) { \
            if (need) { _Pragma("unroll") for (int r = 0; r < 16; ++r) { const float f = wsf[crow(r, hi)]; o[0][r] *= f; o[1][r] *= f; } } \
            pv(o, vb0 + ((ta_ - 1) & 3) * VSLOT, __builtin_bit_cast(bf16x8, pw0), __builtin_bit_cast(bf16x8, pw1), __builtin_bit_cast(bf16x8, pw2), __builtin_bit_cast(bf16x8, pw3)); } \
        if (QKON) { const ALAS char* kb = shm + M_K + (ta_ % 3) * KSLOT + hi * 1024 + r32 * 16; \
            _Pragma("unroll") for (int d0 = 0; d0 < ND0; ++d0) { \
                const bf16x8 b0 = *(const ALAS bf16x8*)(kb + d0 * 2048); const bf16x8 b1 = *(const ALAS bf16x8*)(kb + d0 * 2048 + 512); \
                p0 = __builtin_amdgcn_mfma_f32_32x32x16_bf16(b0, qr[d0], d0 == 0 ? negm : p0, 0, 0, 0); \
                p1 = __builtin_amdgcn_mfma_f32_32x32x16_bf16(b1, qr[d0], d0 == 0 ? negm : p1, 0, 0, 0); } } } while (0)
#define M_PA(k) ((k) == 0 ? __builtin_bit_cast(bf16x8, pw0) : (k) == 1 ? __builtin_bit_cast(bf16x8, pw1) : (k) == 2 ? __builtin_bit_cast(bf16x8, pw2) : __builtin_bit_cast(bf16x8, pw3))
#define M_VF(i) (bf16x8){vl_[i][0], vl_[i][1], vl_[i][2], vl_[i][3], vh_[i][0], vh_[i][1], vh_[i][2], vh_[i][3]}
#define M_STAGE_B(t_, ON) do { const int tb_ = (t_); if (ON) { \
        float a0 = fmaxf(fmaxf(p0[0], p0[1]), p1[0]), a1 = fmaxf(fmaxf(p0[2], p0[3]), p1[1]); a0 = fmaxf(fmaxf(a0, p1[2]), p1[3]); \
        _Pragma("unroll") for (int r = 4; r < 16; r += 4) { a0 = fmaxf(fmaxf(a0, p0[r]), p0[r + 1]); a1 = fmaxf(fmaxf(a1, p0[r + 2]), p0[r + 3]); a0 = fmaxf(fmaxf(a0, p1[r]), p1[r + 1]); a1 = fmaxf(fmaxf(a1, p1[r + 2]), p1[r + 3]); } \
        const float rm = xhalf_max(fmaxf(a0, a1)); \
        need = false; \
        if (tb_ == 0 || __any(rm > MLA_THR)) { \
            const float dl = (tb_ == 0) ? rm : fmaxf(rm, 0.f); \
            m_hat += dl; \
            _Pragma("unroll") for (int r = 0; r < 16; ++r) { p0[r] -= dl; p1[r] -= dl; } \
            _Pragma("unroll") for (int r = 0; r < 16; ++r) negm[r] = -m_hat; \
            if (tb_ > 0) { const float f = __builtin_amdgcn_exp2f(-dl); l_run *= f; if (hi == 0) wsf[r32] = f; need = true; } } \
        float ls0 = 0.f, ls1 = 0.f; \
        _Pragma("unroll") for (int r = 0; r < 16; ++r) { p0[r] = __builtin_amdgcn_exp2f(p0[r]); p1[r] = __builtin_amdgcn_exp2f(p1[r]); ls0 += p0[r]; ls1 += p1[r]; } \
        l_run += ls0 + ls1; \
        pw0 = (u32x4){cvtpk(p0[0], p0[1]), cvtpk(p0[2], p0[3]), cvtpk(p0[4], p0[5]), cvtpk(p0[6], p0[7])}; \
        pw1 = (u32x4){cvtpk(p0[8], p0[9]), cvtpk(p0[10], p0[11]), cvtpk(p0[12], p0[13]), cvtpk(p0[14], p0[15])}; \
        pw2 = (u32x4){cvtpk(p1[0], p1[1]), cvtpk(p1[2], p1[3]), cvtpk(p1[4], p1[5]), cvtpk(p1[6], p1[7])}; \
        pw3 = (u32x4){cvtpk(p1[8], p1[9]), cvtpk(p1[10], p1[11]), cvtpk(p1[12], p1[13]), cvtpk(p1[14], p1[15])}; } } while (0)
    const int tmain = NT - 4;
    if (grp == 0) {
        M_BAR_EVEN(0); M_STAGE_A_SW(0, false, true); A_BAR_L(); M_STAGE_B(0, true);
        int t = 1;
        for (; t < tmain; ++t) { M_BAR_EVEN(t); M_STAGE_A(t); A_BAR_L(); M_STAGE_B(t, true); }
        for (; t <= NT; ++t) { M_BAR_EVEN(t); M_STAGE_A_SW(t, (t - 1 <= tw), (t < NT && t <= tw)); A_BAR_L(); M_STAGE_B(t, (t < NT && t <= tw)); }
    } else {
        M_BAR_EVEN(0); A_BAR_L(); M_STAGE_A_SW(0, false, true);
        M_BAR_EVEN(1); M_STAGE_B(0, true); A_BAR_L(); M_STAGE_A_SW(1, true, true);
        int t = 2;
        for (; t < tmain; ++t) { M_BAR_EVEN(t); M_STAGE_B(t - 1, true); A_BAR_L(); M_STAGE_A(t); }
        for (; t <= NT; ++t) { M_BAR_EVEN(t); M_STAGE_B(t - 1, (t - 1 <= tw)); A_BAR_L(); M_STAGE_A_SW(t, (t - 1 <= tw), (t < NT && t <= tw)); }
    }
#undef M_BAR_EVEN
#undef M_STAGE_A
#undef M_STAGE_A_SW
#undef M_STAGE_B
#undef M_PA
#undef M_KLD
#undef M_QK
#undef M_VF
    A_WAIT_BAR(0);
    const float lt = xhalf_sum(l_run);
    if (hi == 0) wsf[32 + r32] = lt;
    float rli[16];
#pragma unroll
    for (int r = 0; r < 16; ++r) rli[r] = __builtin_amdgcn_rcpf(wsf[32 + crow(r, hi)]);
    ALAS float* stg = (ALAS float*)shm + wid * 2048;
#pragma unroll
    for (int r = 0; r < 16; ++r) { const int orow = crow(r, hi);
#pragma unroll
        for (int d0 = 0; d0 < 2; ++d0) stg[orow * 64 + d0 * 32 + r32] = o[d0][r] * rli[r]; }
    const long grow0 = rowbase + q0 + wid * 32;
    u32x4 gvp[4];
#pragma unroll
    for (int i = 0; i < 4; ++i) gvp[i] = *(const u32x4*)(gate + (size_t)(grow0 + i * 8 + (lane >> 3)) * 1024 + goff + h * 64 + (lane & 7) * 8);
#pragma unroll
    for (int i = 0; i < 4; ++i) {
        const int row = i * 8 + (lane >> 3), ch = lane & 7;
        const f32x4 a = *(const ALAS f32x4*)(stg + row * 64 + ch * 8), c = *(const ALAS f32x4*)(stg + row * 64 + ch * 8 + 4);
        float ss = ((a[0] * a[0] + a[1] * a[1]) + (a[2] * a[2] + a[3] * a[3])) + ((c[0] * c[0] + c[1] * c[1]) + (c[2] * c[2] + c[3] * c[3]));
        ss += __shfl_xor(ss, 1); ss += __shfl_xor(ss, 2); ss += __shfl_xor(ss, 4);
        const float rn = 1.0f / sqrtf(ss * (1.0f / 64.0f) + kEps);
        const size_t off = (size_t)(grow0 + row) * 1024 + goff + h * 64 + ch * 8;
        const u32x4 gv = gvp[i];
        const f32x4 g0 = *(const f32x4*)(gnorm + h * 64 + ch * 8), g1 = *(const f32x4*)(gnorm + h * 64 + ch * 8 + 4);
        float v[8];
#pragma unroll
        for (int e = 0; e < 4; ++e) { v[e] = a[e] * rn * g0[e]; v[4 + e] = c[e] * rn * g1[e]; }
        u32x4 w;
#pragma unroll
        for (int e = 0; e < 4; ++e) { const unsigned gw = gv[e]; w[e] = cvtpk(v[2 * e] * __uint_as_float(gw << 16), v[2 * e + 1] * __uint_as_float(gw & 0xffff0000u)); }
        *(u32x4*)(out + off) = w;
    }
    A_WAIT_BAR(0);
#undef M_DMA
}

constexpr int S_RING = 0, S_FLAG = 131072, S_END = 131072 + 256;
__device__ __forceinline__ void sb_unit(int b, int h, int qb, const bf16_t* Q, const bf16_t* K, const bf16_t* V, const bf16_t* gate, const float* gnorm, bf16_t* out, int goff, ALAS char* shm) {
    constexpr int QP = 512;
    const int tid = threadIdx.x, lane = tid & 63, r32 = lane & 31, hi = lane >> 5; const int wid = __builtin_amdgcn_readfirstlane(tid >> 6);
    const int pair = wid >> 1, e2 = wid & 1;
    const long rowbase = (long)b * SEQ; const int q0 = qb * 256;
    const bf16_t* Qw = Q + (rowbase + q0 + wid * 32) * QP + h * 64;
    const bf16_t* Kh = K + rowbase * QP + h * 64; const bf16_t* Vh = V + rowbase * 512 + h * 64;
    const unsigned lds0 = (unsigned)(uintptr_t)shm;
    ALAS unsigned* flags = (ALAS unsigned*)(shm + S_FLAG);
    const int td = 4 * qb + pair;
    const bf16_t* ksrc = Kh + (long)lane * QP + (4 * e2) * 8;
    const bf16_t* vsrc = Vh + (long)(lane >> 2) * 512 + e2 * 32 + (lane & 3) * 8;
    const unsigned ring = lds0 + S_RING + pair * 32768;
    const unsigned kdst = ring + (4 * e2) * 1024, vdst = ring + 8192 + (4 * e2) * 1024;
#define S_DMA(t_, s_) do { const int tt_ = (t_) < 0 ? 0 : (t_); const unsigned so_ = (unsigned)(s_) * 16384u; \
        _Pragma("unroll") for (int c = 0; c < 4; ++c) glds16(ksrc + (long)tt_ * 64 * QP + c * 8, (unsigned)__builtin_amdgcn_readfirstlane(kdst + so_ + c * 1024)); \
        _Pragma("unroll") for (int c = 0; c < 4; ++c) glds16(vsrc + ((long)tt_ * 64 + 16 * c) * 512, (unsigned)__builtin_amdgcn_readfirstlane(vdst + so_ + c * 1024)); } while (0)
    S_DMA(td, 0);
    bf16x8 qr[4];
#pragma unroll
    for (int d0 = 0; d0 < 4; ++d0) qr[d0] = *(const bf16x8*)(Qw + (long)r32 * QP + d0 * 16 + hi * 8);
    f32x16 o[2]; o[0] = f32x16{}; o[1] = f32x16{};
    float carry = 1.0f;
    const int vb0 = (int)ring + 8192 + ((lane >> 4) & 1) * 32 + (lane & 3) * 8 + (4 * hi + ((lane & 15) >> 2)) * 64;
    const int qrel = 32 * e2 + r32;
    const int NI = 4 * qb + 4;
    for (int i = 0; i < NI; ++i) {
        A_WAIT_BAR(0);
        if (i > 0) { const ALAS unsigned* fl = flags + ((i - 1) & 1) * 8; unsigned all = 1u;
#pragma unroll
            for (int w = 0; w < 8; ++w) all &= fl[w];
            if (all) break; }
        const int t = td - i, slot = i & 1;
        if (i + 1 < NI) S_DMA(t - 1, slot ^ 1);
        bool done = true;
        if (t >= 0) {
            f32x16 p0, p1;
            qkt<4>(p0, p1, shm + S_RING + pair * 32768 + slot * 16384, qr, r32, hi);
            if (i == 0) {
#pragma unroll
                for (int r = 0; r < 16; ++r) { const int kv = crow(r, hi); if (kv >= qrel) p0[r] = -INFINITY; if (kv + 32 >= qrel) p1[r] = -INFINITY; } }
            f32x16 u0, u1;
#pragma unroll
            for (int r = 0; r < 16; ++r) { u0[r] = __builtin_amdgcn_rcpf(1.0f + __builtin_amdgcn_exp2f(p0[r])); u1[r] = __builtin_amdgcn_rcpf(1.0f + __builtin_amdgcn_exp2f(p1[r])); }
            float lo_[8], up_[8];
#pragma unroll
            for (int i4 = 0; i4 < 8; ++i4) {
                const float bp = (i4 < 4) ? ((u0[4 * i4] * u0[4 * i4 + 1]) * (u0[4 * i4 + 2] * u0[4 * i4 + 3])) : ((u1[4 * i4 - 16] * u1[4 * i4 - 15]) * (u1[4 * i4 - 14] * u1[4 * i4 - 13]));
                auto rr = __builtin_amdgcn_permlane32_swap(__float_as_uint(bp), __float_as_uint(bp), false, false);
                lo_[i4] = __uint_as_float(rr[0]); up_[i4] = __uint_as_float(rr[1]);
            }
            float run = carry;
#pragma unroll
            for (int i4 = 7; i4 >= 0; --i4) {
                float c = (hi == 0) ? run * up_[i4] : run;
#pragma unroll
                for (int e = 3; e >= 0; --e) {
                    if (i4 < 4) { const float uu = u0[4 * i4 + e]; p0[4 * i4 + e] = (1.0f - uu) * c; c *= uu; }
                    else { const float uu = u1[4 * i4 - 16 + e]; p1[4 * i4 - 16 + e] = (1.0f - uu) * c; c *= uu; }
                }
                run *= lo_[i4] * up_[i4];
            }
            carry = run;
            u32x4 pw0, pw1, pw2, pw3;
            pw0 = (u32x4){cvtpk(p0[0], p0[1]), cvtpk(p0[2], p0[3]), cvtpk(p0[4], p0[5]), cvtpk(p0[6], p0[7])};
            pw1 = (u32x4){cvtpk(p0[8], p0[9]), cvtpk(p0[10], p0[11]), cvtpk(p0[12], p0[13]), cvtpk(p0[14], p0[15])};
            pw2 = (u32x4){cvtpk(p1[0], p1[1]), cvtpk(p1[2], p1[3]), cvtpk(p1[4], p1[5]), cvtpk(p1[6], p1[7])};
            pw3 = (u32x4){cvtpk(p1[8], p1[9]), cvtpk(p1[10], p1[11]), cvtpk(p1[12], p1[13]), cvtpk(p1[14], p1[15])};
            pv(o, vb0 + slot * 16384, __builtin_bit_cast(bf16x8, pw0), __builtin_bit_cast(bf16x8, pw1), __builtin_bit_cast(bf16x8, pw2), __builtin_bit_cast(bf16x8, pw3));
            done = __all(carry < 1.0e-37f) || (t == 0);
        }
        if (lane == 0) flags[(i & 1) * 8 + wid] = done ? 1u : 0u;
    }
    A_WAIT_BAR(0);
    ALAS float* stg = (ALAS float*)shm + wid * 2048;
#pragma unroll
    for (int r = 0; r < 16; ++r) { const int orow = crow(r, hi);
#pragma unroll
        for (int d0 = 0; d0 < 2; ++d0) stg[orow * 64 + d0 * 32 + r32] = o[d0][r]; }
    const long grow0 = rowbase + q0 + wid * 32;
    u32x4 gvp[4];
#pragma unroll
    for (int i = 0; i < 4; ++i) gvp[i] = *(const u32x4*)(gate + (size_t)(grow0 + i * 8 + (lane >> 3)) * 1024 + goff + h * 64 + (lane & 7) * 8);
#pragma unroll
    for (int i = 0; i < 4; ++i) {
        const int row = i * 8 + (lane >> 3), ch = lane & 7;
        const f32x4 a = *(const ALAS f32x4*)(stg + row * 64 + ch * 8), c = *(const ALAS f32x4*)(stg + row * 64 + ch * 8 + 4);
        float ss = ((a[0] * a[0] + a[1] * a[1]) + (a[2] * a[2] + a[3] * a[3])) + ((c[0] * c[0] + c[1] * c[1]) + (c[2] * c[2] + c[3] * c[3]));
        ss += __shfl_xor(ss, 1); ss += __shfl_xor(ss, 2); ss += __shfl_xor(ss, 4);
        const float rn = 1.0f / sqrtf(ss * (1.0f / 64.0f) + kEps);
        const size_t off = (size_t)(grow0 + row) * 1024 + goff + h * 64 + ch * 8;
        const u32x4 gv = gvp[i];
        const f32x4 g0 = *(const f32x4*)(gnorm + h * 64 + ch * 8), g1 = *(const f32x4*)(gnorm + h * 64 + ch * 8 + 4);
        float v[8];
#pragma unroll
        for (int e = 0; e < 4; ++e) { v[e] = a[e] * rn * g0[e]; v[4 + e] = c[e] * rn * g1[e]; }
        u32x4 w;
#pragma unroll
        for (int e = 0; e < 4; ++e) { const unsigned gw = gv[e]; w[e] = cvtpk(v[2 * e] * __uint_as_float(gw << 16), v[2 * e + 1] * __uint_as_float(gw & 0xffff0000u)); }
        *(u32x4*)(out + off) = w;
    }
    A_WAIT_BAR(0);
#undef S_DMA
}
}
#include <hip/hip_cooperative_groups.h>
namespace cg = cooperative_groups;
#ifndef MK_N_LAUNCHES
#define MK_N_LAUNCHES 1
#endif
#ifndef REP_MLA
#define REP_MLA 1
#endif
#ifndef REP_SB
#define REP_SB 1
#endif
#ifndef REP_P1
#define REP_P1 1
#endif
#ifndef REP_MISC
#define REP_MISC 1
#endif
#ifndef REP_SYNC
#define REP_SYNC 0
#endif
#ifndef REP_TAIL
#define REP_TAIL 1
#endif
constexpr int NWAVES = 8;
constexpr int N_PHASES = 7;
constexpr int LDS_BYTES = 147456;
static_assert(WS_SBK - WS_SBQ == 32 * MiB && WS_SBV - WS_SBK == 32 * MiB, "EpiProj addresses SBK/SBV relative to SBQ");
static_assert(att::L_END <= MISC_OFF && pg8::STAGE_BYTES <= MISC_OFF, "control words");
static_assert(att::M_END <= MISC_OFF && att::S_END <= MISC_OFF, "LDS map");
static_assert(att::L_END <= LDS_BYTES && pg8::STAGE_BYTES <= LDS_BYTES, "LDS map");

typedef unsigned short bf16;
typedef unsigned v4u __attribute__((ext_vector_type(4)));
typedef unsigned v2u __attribute__((ext_vector_type(2)));
typedef float f32x4 __attribute__((ext_vector_type(4)));
#define LAS __attribute__((address_space(3)))
__device__ __forceinline__ unsigned f2bf(float f) { unsigned u = __builtin_bit_cast(unsigned, f); return (u + 0x7fffu + ((u >> 16) & 1u)) >> 16; }
__device__ __forceinline__ unsigned pk2(float lo, float hi) { return f2bf(lo) | (f2bf(hi) << 16); }
__device__ __forceinline__ float wave_sum(float v) {
#pragma unroll
    for (int o = 1; o < 64; o <<= 1) v += __shfl_xor(v, o);
    return v;
}
__device__ __forceinline__ void transpose_item(const float* W, int K, int N, bf16* WT, int ldk, const float* gain, LAS float* scr, int item, int lane) {
    const int nblk = N / 32, kb = item / nblk, nb = item % nblk, k0 = 64 * kb, n0 = 32 * nb;
#pragma unroll 8
    for (int i = 0; i < 32; ++i) { const int kk = 2 * i + (lane >> 5); const float gk = gain ? gain[k0 + kk] : 1.0f; scr[kk * 33 + (lane & 31)] = W[(size_t)(k0 + kk) * N + n0 + (lane & 31)] * gk; }
    asm volatile("s_waitcnt lgkmcnt(0)" ::: "memory");
    const int c = lane & 7;
#pragma unroll
    for (int j = 0; j < 4; ++j) { const int n = (lane >> 3) + 8 * j; const LAS float* s = scr + (8 * c) * 33 + n;
        v4u o; o.x = pk2(s[0 * 33], s[1 * 33]); o.y = pk2(s[2 * 33], s[3 * 33]); o.z = pk2(s[4 * 33], s[5 * 33]); o.w = pk2(s[6 * 33], s[7 * 33]);
        *(v4u*)(WT + (size_t)(n0 + n) * ldk + k0 + 8 * c) = o; }
    asm volatile("s_waitcnt lgkmcnt(0)" ::: "memory");
}

#define XB_TMO      128
#define XB_XCNT(j)  (256  + 64 * (j))
#define XB_XSUB(j)  (1280 + 64 * (j))
#define XB_XGEN(j)  (2304 + 64 * (j))
#define XB_TOP      3328
#define XB_TOPGEN   3392
#define XCD_BAR_WORDS 3456
#define XB_SPIN_CAP (1u << 18)

__device__ __forceinline__ unsigned xb_ld(unsigned* p)              { return __hip_atomic_load(p, __ATOMIC_RELAXED, __HIP_MEMORY_SCOPE_AGENT); }
__device__ __forceinline__ unsigned xb_add(unsigned* p, unsigned v) { return __hip_atomic_fetch_add(p, v, __ATOMIC_RELAXED, __HIP_MEMORY_SCOPE_AGENT); }
__device__ __forceinline__ unsigned xb_xcc_id() { return (unsigned)__builtin_amdgcn_s_getreg((3 << 11) | 20) & 0xFu; }
#define XB_SPIN(cond, bar) do { unsigned _sp = 0; while (cond) { __builtin_amdgcn_s_sleep(1); \
    if ((++_sp & 255u) == 0u) { if (xb_ld(&(bar)[XB_TMO])) break; if (_sp > XB_SPIN_CAP) { atomicAdd(&(bar)[XB_TMO], 1u); break; } } } } while (0)

struct XcdBarrier {
    unsigned* bar; unsigned x;
    volatile LAS unsigned* st;
};

__device__ __forceinline__ XcdBarrier xcd_barrier_post(unsigned* bar, volatile LAS unsigned* st) {
    XcdBarrier b; b.bar = bar; b.x = xb_xcc_id(); b.st = st;
    if (threadIdx.x == 0) (void)xb_add(&bar[XB_XCNT(b.x)], 1u);
    return b;
}
__device__ __forceinline__ void xcd_barrier_complete(unsigned* bar, unsigned x, unsigned& nloc, unsigned& nx) {
    const unsigned G = gridDim.x * gridDim.y * gridDim.z;
    unsigned sum, cnt, mine, sp = 0u;
    for (;;) {
        sum = 0u; cnt = 0u; mine = 0u;
#pragma unroll
        for (unsigned j = 0; j < 16; ++j) { const unsigned c = xb_ld(&bar[XB_XCNT(j)]); sum += c; cnt += (c > 0u) ? 1u : 0u; mine = (j == x) ? c : mine; }
        if (sum == G) break;
        __builtin_amdgcn_s_sleep(1);
        if ((++sp & 255u) == 0u) { if (xb_ld(&bar[XB_TMO])) break; if (sp > XB_SPIN_CAP) { atomicAdd(&bar[XB_TMO], 1u); break; } }
    }
    nloc = mine > 0u ? mine : 1u; nx = cnt > 0u ? cnt : 1u;
}

__device__ __forceinline__ void xcd_barrier(const XcdBarrier& b) {
    asm volatile("s_waitcnt vmcnt(0)" ::: "memory");
    __syncthreads();
    if (threadIdx.x == 0) {
        unsigned* bar = b.bar;
        __builtin_amdgcn_s_waitcnt(0);
        unsigned nloc = b.st[0], nx = b.st[1];
        if (nloc == 0u) { xcd_barrier_complete(bar, b.x, nloc, nx); b.st[0] = nloc; b.st[1] = nx; }
        const unsigned old = xb_add(&bar[XB_XSUB(b.x)], 1u);
        const unsigned gen = old / nloc;
        if (old + 1u == (gen + 1u) * nloc) {
            __builtin_amdgcn_fence(__ATOMIC_RELEASE, "agent");
            asm volatile("s_waitcnt vmcnt(0)" ::: "memory");
            const unsigned og = xb_add(&bar[XB_TOP], 1u);
            const unsigned tg = og / nx;
            if (og + 1u == (tg + 1u) * nx) xb_add(&bar[XB_TOPGEN], 1u);
            else XB_SPIN(xb_ld(&bar[XB_TOPGEN]) == tg, bar);
            __builtin_amdgcn_fence(__ATOMIC_ACQUIRE, "agent");
            xb_add(&bar[XB_XGEN(b.x)], 1u);
            asm volatile("s_waitcnt vmcnt(0)" ::: "memory");
        } else {
            XB_SPIN(xb_ld(&bar[XB_XGEN(b.x)]) == gen, bar);
            __builtin_amdgcn_fence(__ATOMIC_ACQUIRE, "agent");
            asm volatile("s_waitcnt vmcnt(0)" ::: "memory");
        }
    }
    __syncthreads();
}

static_assert(XCD_BAR_WORDS * 4 <= (int)CTL_ZERO_BYTES, "barrier words inside the memset");
__device__ __forceinline__ int opq(int v) { asm volatile("" : "+s"(v)); return v; }
struct Args { const float* in[17]; const int* pos; float* out; unsigned char* ws; int ph_lo, ph_hi; };

typedef const Args __attribute__((address_space(4)))* ArgsK;
#define PHASE_PTRS \
    ArgsK ap_ = (ArgsK)__builtin_amdgcn_kernarg_segment_ptr(); asm volatile("" : "+s"(ap_)); unsigned char* ws = ap_->ws; const int* posp = ap_->pos; float* outp = ap_->out; \
    const float* x = ap_->in[0]; const float* pin = ap_->in[1]; \
    const float* g_pre = ap_->in[3]; const float* w_in = ap_->in[4]; const float* g_q = ap_->in[5]; const float* w_uq = ap_->in[6]; const float* g_kv = ap_->in[7]; const float* w_ukv = ap_->in[8]; \
    const float* g_sb = ap_->in[9]; const float* g_mla = ap_->in[10]; const float* w_out = ap_->in[11]; const float* g_post = ap_->in[12]; const float* w_ple = ap_->in[13]; const float* g_ple = ap_->in[14]; \
    const float* w_pg = ap_->in[15]; const float* b_pg = ap_->in[16]; \
    bf16* XB = (bf16*)(ws + WS_A); bf16* MIX = (bf16*)(ws + WS_A); bf16* X1B = (bf16*)(ws + WS_A); \
    bf16* GATE = (bf16*)(ws + WS_B); bf16* YB = (bf16*)(ws + WS_B); bf16* PLEB = (bf16*)(ws + WS_PLE); \
    bf16* SBQ = (bf16*)(ws + WS_SBQ); bf16* SBK = (bf16*)(ws + WS_SBK); bf16* SBV = (bf16*)(ws + WS_SBV); \
    bf16* MQ = (bf16*)(ws + WS_MQ); bf16* MK = (bf16*)(ws + WS_MK); bf16* MV = (bf16*)(ws + WS_MV); \
    bf16* PB = (bf16*)(ws + WS_PB); bf16* CQ = (bf16*)(ws + WS_CQ); bf16* CKV = (bf16*)(ws + WS_CKV); \
    bf16* WIN = (bf16*)(ws + WS_WIN); bf16* WUQ = (bf16*)(ws + WS_WUQ); bf16* WUKV = (bf16*)(ws + WS_WUKV); bf16* WOUT = (bf16*)(ws + WS_WOUT); bf16* WPLE = (bf16*)(ws + WS_WPLE); bf16* WPG = (bf16*)(ws + WS_WPG); \
    float* CS = (float*)(ws + WS_CS); float* RPRE = (float*)(ws + WS_RPRE); float* RQSS = (float*)(ws + WS_RQSS); float* RKVSS = (float*)(ws + WS_RKVSS); \
    float* YSS = (float*)(ws + WS_YSS); float* PSS = (float*)(ws + WS_PSS); float* RY = (float*)(ws + WS_RY); float* RP = (float*)(ws + WS_RP);
__global__ void __launch_bounds__(NWAVES * 64, 2) fwd_kernel(Args args) {
    extern __shared__ __attribute__((aligned(16))) unsigned char lds[];
    const int tid = threadIdx.x, lane = tid & 63, wave = __builtin_amdgcn_readfirstlane(tid >> 6);
    const int G = gridDim.x; const int bx = blockIdx.x; const int vcu = (G % 8 == 0) ? (bx % 8) * (G / 8) + bx / 8 : bx;
    const int lo = args.ph_lo, hi = args.ph_hi;
#define IN(k) (lo <= (k) && (k) < hi)
#define SEAM(k) do { if (IN(k) && IN((k) + 1)) { xcd_barrier(bar); } } while (0)
    if (lo < 0) cg::this_grid().sync();
    volatile LAS unsigned* MISC = (volatile LAS unsigned*)((LAS unsigned char*)lds + MISC_OFF);
    if (tid < 8) MISC[tid] = 0u;
    __syncthreads();
    XcdBarrier bar; bar.bar = (unsigned*)(args.ws + WS_CTL); bar.x = 0; bar.st = nullptr;
    if (hi - lo > 1) bar = xcd_barrier_post((unsigned*)(args.ws + WS_CTL), MISC);
    const int gw = vcu * NWAVES + wave, NGW = G * NWAVES;

    for (int rep0 = 0; rep0 < REP_MISC; ++rep0)
    if (IN(0)) {
        PHASE_PTRS
        LAS float* scr = (LAS float*)((LAS unsigned char*)lds + wave * 16384);
        constexpr int I_IN = 16 * 93, I_UQ = 4 * 24, I_UKV = 2 * 32, I_OUT = 16 * 32, I_PLE = 4 * 32, I_PG = 16 * 32;
        constexpr int NITEMS = I_IN + I_UQ + I_UKV + I_OUT + I_PLE + I_PG;
        for (int it = gw; it < NITEMS; it += NGW) {
            int r = it;
            if (r < I_IN) { transpose_item(w_in, 1024, NIN, WIN, 1024, g_pre, scr, r, lane); continue; } r -= I_IN;
            if (r < I_UQ) { transpose_item(w_uq, 256, 768, WUQ, 256, g_q, scr, r, lane); continue; } r -= I_UQ;
            if (r < I_UKV) { transpose_item(w_ukv, 128, 1024, WUKV, 256, g_kv, scr, r, lane); continue; } r -= I_UKV;
            if (r < I_OUT) { transpose_item(w_out, 1024, 1024, WOUT, 1024, nullptr, scr, r, lane); continue; } r -= I_OUT;
            if (r < I_PLE) { transpose_item(w_ple, 256, 1024, WPLE, 256, nullptr, scr, r, lane); continue; } r -= I_PLE;
            transpose_item(w_pg, 1024, 1024, WPG, 1024, nullptr, scr, r, lane);
        }
        const int gt = vcu * (NWAVES * 64) + tid, NGT = G * NWAVES * 64;
        for (int i = gt; i < (NINP - NIN) * 1024 / 8; i += NGT) *(v4u*)(WIN + (size_t)NIN * 1024 + (size_t)i * 8) = (v4u){0u, 0u, 0u, 0u};
        for (int i = gt; i < 1024 * 128 / 8; i += NGT) { const int n = i / 16, c = i % 16; *(v4u*)(WUKV + (size_t)n * 256 + 128 + c * 8) = (v4u){0u, 0u, 0u, 0u}; }
        for (int i = gt; i < M * 16; i += NGT) {
            const int row = i >> 4, k = i & 15;
            const float freq = exp2f(-(float)k * 0.8304820237218407f);
            const float ang = (float)posp[row] * freq;
            double tt = (double)ang * 0.15915494309189535; tt -= __builtin_rint(tt);
            const float tf = (float)tt;
            CS[(size_t)i * 2] = __builtin_amdgcn_cosf(tf); CS[(size_t)i * 2 + 1] = __builtin_amdgcn_sinf(tf);
        }
        for (int m = gw; m < M; m += 2 * NGW) {
            const int m2 = (m + NGW < M) ? m + NGW : m;
            const f32x4* xr = (const f32x4*)(x + (size_t)m * D) + lane; const f32x4* xr2 = (const f32x4*)(x + (size_t)m2 * D) + lane; f32x4 v[4], w[4]; float s = 0.f, s2 = 0.f;
#pragma unroll
            for (int j = 0; j < 4; ++j) { v[j] = xr[64 * j]; w[j] = xr2[64 * j]; }
#pragma unroll
            for (int j = 0; j < 4; ++j) { s += (v[j][0] * v[j][0] + v[j][1] * v[j][1]) + (v[j][2] * v[j][2] + v[j][3] * v[j][3]); s2 += (w[j][0] * w[j][0] + w[j][1] * w[j][1]) + (w[j][2] * w[j][2] + w[j][3] * w[j][3]); }
            s = wave_sum(s); s2 = wave_sum(s2);
            if (lane == 0) { RPRE[m] = 1.0f / sqrtf(s * (1.0f / D) + 1e-6f); RPRE[m2] = 1.0f / sqrtf(s2 * (1.0f / D) + 1e-6f); }
            v2u* o8 = (v2u*)(XB + (size_t)m * D) + lane; v2u* o82 = (v2u*)(XB + (size_t)m2 * D) + lane;
#pragma unroll
            for (int j = 0; j < 4; ++j) { o8[64 * j] = (v2u){pk2(v[j][0], v[j][1]), pk2(v[j][2], v[j][3])}; o82[64 * j] = (v2u){pk2(w[j][0], w[j][1]), pk2(w[j][2], w[j][3])}; }
        }
        for (int i = gt; i < M * PLE / 4; i += 4 * NGT) {
            f32x4 v[4];
#pragma unroll
            for (int j = 0; j < 4; ++j) { const int ij = (i + j * NGT < M * PLE / 4) ? i + j * NGT : i; v[j] = *((const f32x4*)pin + ij); }
#pragma unroll
            for (int j = 0; j < 4; ++j) { const int ij = (i + j * NGT < M * PLE / 4) ? i + j * NGT : i; *((v2u*)PB + ij) = (v2u){pk2(v[j][0], v[j][1]), pk2(v[j][2], v[j][3])}; }
        }
    }
    SEAM(0);

    if (IN(1)) {
        PHASE_PTRS
        { pg8::Gemm g{XB, WIN, M, NINP, 1024}; pg8::StaticOrder S; S.init(M, NINP, G, bx);
          pg8::EpiProj E{ws};
          pg8::gemm_phase<pg8::EpiProj, pg8::StaticOrder, true, true>((PG8_LAS unsigned char*)lds, g, S, E); }
#if REP_P1 > 1
        { pg8::Gemm g{XB, WIN, M, NINP, 1024}; pg8::StaticOrder S; S.init(M, NINP, G, bx);
          pg8::EpiProj E{ws};
          pg8::gemm_phase<pg8::EpiProj, pg8::StaticOrder, true, true>((PG8_LAS unsigned char*)lds, g, S, E); }
#endif
        { pg8::Gemm g{PB, WPLE, M, 1024, opq(256)}; pg8::StaticOrder S; S.init(M, 1024, G, bx);
          pg8::EpiStat E{PLEB, PSS};
          pg8::gemm_phase<pg8::EpiStat, pg8::StaticOrder, true, true>((PG8_LAS unsigned char*)lds, g, S, E); }
#if REP_MISC > 1
        { pg8::Gemm g{PB, WPLE, M, 1024, opq(256)}; pg8::StaticOrder S; S.init(M, 1024, G, bx);
          pg8::EpiStat E{PLEB, PSS};
          pg8::gemm_phase<pg8::EpiStat, pg8::StaticOrder, true, true>((PG8_LAS unsigned char*)lds, g, S, E); }
#endif
    }
    SEAM(1);

    if (IN(2)) {
        PHASE_PTRS
        { pg8::Gemm g{CQ, WUQ, M, 768, opq(256)}; pg8::StaticOrder S; S.init(M, 768, G, bx);
          pg8::EpiQ E{MQ, RQSS, CS};
          pg8::gemm_phase<pg8::EpiQ, pg8::StaticOrder, true, true>((PG8_LAS unsigned char*)lds, g, S, E); }
        { pg8::Gemm g{CKV, WUKV, M, 1024, opq(256)}; pg8::StaticOrder S; S.init(M, 1024, G, bx);
          pg8::EpiKV E{MK, MV, RKVSS};
          pg8::gemm_phase<pg8::EpiKV, pg8::StaticOrder, true, true>((PG8_LAS unsigned char*)lds, g, S, E); }
#if REP_MISC > 1
        { pg8::Gemm g{CQ, WUQ, M, 768, opq(256)}; pg8::StaticOrder S; S.init(M, 768, G, bx);
          pg8::EpiQ E{MQ, RQSS, CS};
          pg8::gemm_phase<pg8::EpiQ, pg8::StaticOrder, true, true>((PG8_LAS unsigned char*)lds, g, S, E); }
        { pg8::Gemm g{CKV, WUKV, M, 1024, opq(256)}; pg8::StaticOrder S; S.init(M, 1024, G, bx);
          pg8::EpiKV E{MK, MV, RKVSS};
          pg8::gemm_phase<pg8::EpiKV, pg8::StaticOrder, true, true>((PG8_LAS unsigned char*)lds, g, S, E); }
#endif
    }
    SEAM(2);

    if (IN(3)) {
        PHASE_PTRS
        __attribute__((address_space(3))) char* shm = (__attribute__((address_space(3))) char*)lds;
        for (int rep = 0; rep < REP_MLA; ++rep)
        for (int idx = vcu; idx < 1024; idx += G) {
            const int j = idx >> 8, v = idx & 255, bh = v >> 2, s = v & 3;
            const int qb = (j == 0) ? 15 - s : (j == 1) ? s : (j == 2) ? 8 + s : 7 - s;
            att::mla_unit(bh >> 3, bh & 7, qb, MQ, MK, MV, GATE, g_mla, MIX, 512, shm);
        }
        for (int rep = 0; rep < REP_SB; ++rep)
        for (int idx = vcu; idx < 1024; idx += G) {
            const int bh = idx >> 4, qb = idx & 15;
            att::sb_unit(bh >> 3, bh & 7, qb, SBQ, SBK, SBV, GATE, g_sb, MIX, 0, shm);
        }
    }
    SEAM(3);
    for (int rs_ = 0; rs_ < REP_SYNC; ++rs_) xcd_barrier(bar);

    if (IN(4)) {
        PHASE_PTRS
        {
        pg8::Gemm g{MIX, WOUT, M, 1024, 1024}; pg8::StaticOrder S; S.init(M, 1024, G, bx);
        pg8::EpiStat E{YB, YSS};
        pg8::gemm_phase<pg8::EpiStat, pg8::StaticOrder, true, true>((PG8_LAS unsigned char*)lds, g, S, E);
        }
#if REP_TAIL > 1
        {
        pg8::Gemm g{MIX, WOUT, M, 1024, 1024}; pg8::StaticOrder S; S.init(M, 1024, G, bx);
        pg8::EpiStat E{YB, YSS};
        pg8::gemm_phase<pg8::EpiStat, pg8::StaticOrder, true, true>((PG8_LAS unsigned char*)lds, g, S, E);
        }
#endif
    }
    SEAM(4);

    if (IN(5)) {
        PHASE_PTRS
        for (int mm = gw; mm < M; mm += 2 * NGW) {
            const int mr[2] = {mm, (mm + NGW < M) ? mm + NGW : mm};
            f32x4 xv[2][4]; v2u yw[2][4]; float sv[2];
#pragma unroll
            for (int h2 = 0; h2 < 2; ++h2) { const int m = mr[h2];
                sv[h2] = (lane < 16) ? YSS[(size_t)m * 16 + lane] : ((lane < 32) ? PSS[(size_t)m * 16 + lane - 16] : 0.f);
                const f32x4* xr = (const f32x4*)(x + (size_t)m * D) + lane; const v2u* yr = (const v2u*)(YB + (size_t)m * D) + lane;
#pragma unroll
                for (int j = 0; j < 4; ++j) { xv[h2][j] = xr[64 * j]; yw[h2][j] = yr[64 * j]; } }
#pragma unroll
            for (int h2 = 0; h2 < 2; ++h2) { const int m = mr[h2]; float s1 = sv[h2];
                s1 += __shfl_xor(s1, 1); s1 += __shfl_xor(s1, 2); s1 += __shfl_xor(s1, 4); s1 += __shfl_xor(s1, 8);
                const float sy = __shfl(s1, 0), sp = __shfl(s1, 16);
                const float ry = 1.0f / sqrtf(sy * (1.0f / 1024.0f) + 1e-6f), rp = 1.0f / sqrtf(sp * (1.0f / 1024.0f) + 1e-6f);
                if (lane == 0) { RY[m] = ry; RP[m] = rp; }
                const f32x4* gr = (const f32x4*)g_post + lane; v2u* o8 = (v2u*)(X1B + (size_t)m * D) + lane;
#pragma unroll
                for (int j = 0; j < 4; ++j) { const f32x4 xq = xv[h2][j], gv = gr[64 * j]; const v2u yq = yw[h2][j];
                    const float y0 = __uint_as_float(yq.x << 16), y1 = __uint_as_float(yq.x & 0xffff0000u), y2 = __uint_as_float(yq.y << 16), y3 = __uint_as_float(yq.y & 0xffff0000u);
                    o8[64 * j] = (v2u){pk2(xq[0] + y0 * ry * gv[0], xq[1] + y1 * ry * gv[1]), pk2(xq[2] + y2 * ry * gv[2], xq[3] + y3 * ry * gv[3])}; } }
        }
    }
    SEAM(5);

    if (IN(6)) {
        PHASE_PTRS
        {
        pg8::Gemm g{X1B, WPG, M, 1024, 1024}; pg8::StaticOrder S; S.init(M, 1024, G, bx);
        pg8::EpiFinal E{x, YB, PLEB, RY, RP, g_post, g_ple, b_pg, outp};
        pg8::gemm_phase<pg8::EpiFinal, pg8::StaticOrder, true, true>((PG8_LAS unsigned char*)lds, g, S, E);
        }
#if REP_TAIL > 1
        {
        pg8::Gemm g{X1B, WPG, M, 1024, 1024}; pg8::StaticOrder S; S.init(M, 1024, G, bx);
        pg8::EpiFinal E{x, YB, PLEB, RY, RP, g_post, g_ple, b_pg, outp};
        pg8::gemm_phase<pg8::EpiFinal, pg8::StaticOrder, true, true>((PG8_LAS unsigned char*)lds, g, S, E);
        }
#endif
    }
#undef IN
#undef SEAM
}

extern "C" void kernel_launch(void* const* d_in, const int* in_sizes, int n_in, void* d_out, int out_size, void* d_ws, size_t ws_size, hipStream_t stream) {
    static int grid = 0;
    if (grid == 0) {
        if (n_in != 17 || out_size != M * D || ws_size < WS_END) { fprintf(stderr, "kernel_launch: unexpected shapes (n_in %d, out %d, ws %zu); nothing launched\n", n_in, out_size, ws_size); grid = -1; return; }
        int dev = 0, cus = 0, per_cu = 0;
        if (hipGetDevice(&dev) != hipSuccess || hipDeviceGetAttribute(&cus, hipDeviceAttributeMultiprocessorCount, dev) != hipSuccess) { grid = -1; return; }
        if (hipFuncSetAttribute((const void*)fwd_kernel, hipFuncAttributeMaxDynamicSharedMemorySize, LDS_BYTES) != hipSuccess) { fprintf(stderr, "kernel_launch: hipFuncSetAttribute failed\n"); grid = -1; return; }
        if (hipOccupancyMaxActiveBlocksPerMultiprocessor(&per_cu, (const void*)fwd_kernel, NWAVES * 64, LDS_BYTES) != hipSuccess || per_cu < 1) { fprintf(stderr, "kernel_launch: occupancy query says %d blocks per CU\n", per_cu); per_cu = 1; }
        (void)hipGetLastError();
        grid = cus * 1;
    }
    if (grid < 0) return;
    if (hipMemsetAsync((char*)d_ws + WS_CTL, 0, CTL_ZERO_BYTES, stream) != hipSuccess) { fprintf(stderr, "kernel_launch: hipMemsetAsync failed\n"); return; }
    Args a{};
    for (int i = 0; i < 17; ++i) a.in[i] = (const float*)d_in[i];
    a.pos = (const int*)d_in[2]; a.out = (float*)d_out; a.ws = (unsigned char*)d_ws;
#if MK_N_LAUNCHES == 1
    a.ph_lo = 0; a.ph_hi = N_PHASES;
    void* kargs[] = {&a};
    hipError_t e = hipLaunchCooperativeKernel((const void*)fwd_kernel, dim3(grid), dim3(NWAVES * 64), kargs, LDS_BYTES, stream);
    if (e != hipSuccess) fprintf(stderr, "kernel_launch: cooperative launch failed: %s (grid %d)\n", hipGetErrorString(e), grid);
#else
    for (int li = 0; li < N_PHASES; ++li) { a.ph_lo = li; a.ph_hi = li + 1; hipLaunchKernelGGL(fwd_kernel, dim3(grid), dim3(NWAVES * 64), LDS_BYTES, stream, a); }
#endif
}
```

```cpp
#include <hip/hip_runtime.h>
#include <cstdio>
#include <cstdint>
#include <cmath>
constexpr int M = 32768, D = 1024, SEQ = 4096, NIN = 2976, NINP = 3072, PLE = 256;
constexpr size_t MiB = 1u << 20;
constexpr size_t WS_A = 0;
constexpr size_t WS_B = 64 * MiB;
constexpr size_t WS_PLE = 128 * MiB;
constexpr size_t WS_SBQ = 192 * MiB, WS_SBK = 224 * MiB, WS_SBV = 256 * MiB;
constexpr size_t WS_MQ = 288 * MiB, WS_MK = 336 * MiB, WS_MV = 384 * MiB;
constexpr size_t WS_PB = 416 * MiB, WS_CQ = 432 * MiB, WS_CKV = 448 * MiB;
constexpr size_t WS_WIN = 464 * MiB;
constexpr size_t WS_WUQ = 470 * MiB;
constexpr size_t WS_WUKV = 471 * MiB;
constexpr size_t WS_WOUT = 472 * MiB;
constexpr size_t WS_WPLE = 474 * MiB;
constexpr size_t WS_WPG = 475 * MiB;
constexpr size_t WS_CS = 477 * MiB;
constexpr size_t WS_RPRE = 481 * MiB;
constexpr size_t WS_RQSS = 482 * MiB;
constexpr size_t WS_RKVSS = 483 * MiB;
constexpr size_t WS_YSS = 484 * MiB;
constexpr size_t WS_PSS = 486 * MiB;
constexpr size_t WS_RY = 488 * MiB, WS_RP = 489 * MiB;
constexpr size_t WS_CTL = 490 * MiB, CTL_ZERO_BYTES = 16384;
constexpr size_t WS_END = 491 * MiB;
constexpr int MISC_OFF = 147456 - 256;
namespace pg8 {
#define PG8_LAS __attribute__((address_space(3)))
typedef unsigned short bf16_t;
typedef short bf16x8 __attribute__((ext_vector_type(8)));
typedef float f32x4 __attribute__((ext_vector_type(4)));
typedef unsigned u32x4 __attribute__((ext_vector_type(4)));
constexpr int BM = 256, BK = 64, HALF = 128, HTB = HALF * BK * 2  , STAGE_BYTES = 8 * HTB, NXCD = 8, WGM = 8;

__host__ __device__ __forceinline__ int lds_byte(int r, int c) { const int st = (r >> 4) * 2 + (c >> 5), rr = r & 15, cc = c & 31, ob = rr * 64 + cc * 2; return st * 1024 + (ob ^ (((ob >> 9) & 1) << 5)); }
__host__ __device__ __forceinline__ void stage_rc(int b, int& R, int& C) { const int st = b / 1024, sb = b % 1024, swz = sb ^ (((sb >> 9) & 1) << 5); R = (st >> 1) * 16 + swz / 64; C = (st & 1) * 32 + (swz % 64) / 2; }
__host__ __device__ __forceinline__ int perm32(int rho) { const int n = rho >> 4, i = rho & 15; return 8 * (i >> 2) + 4 * n + (i & 3); }

struct Unit { int pm, pn; };
struct Gemm { const bf16_t* A; const bf16_t* Bt; int M, N, K; };

struct StaticOrder {
    int nM, nN, nwg, G, c;
    __host__ __device__ void init(int M, int N, int G_, int c_) { nM = M / BM; nN = N / BM; nwg = nM * nN; G = G_; c = c_; }
    __host__ __device__ bool next(int i, Unit& u) const {
        const long L = (long)i * G + c; if (L >= nwg) return false;
        int wgid = (int)L; { const int q = nwg / NXCD, r = nwg % NXCD, xcd = wgid % NXCD, off = wgid / NXCD; wgid = (xcd < r ? xcd * (q + 1) : r * (q + 1) + (xcd - r) * q) + off; }
        const int nig = WGM * nN, gid = wgid / nig, fm = gid * WGM, gsz = (nM - fm) < WGM ? (nM - fm) : WGM;
        u.pm = fm + ((wgid % nig) % gsz); u.pn = (wgid % nig) / gsz; return true;
    }
    __device__ __forceinline__ void a_ready(const Unit&) const {}
    __device__ __forceinline__ void done(const Unit&) const {}
};

__device__ __forceinline__ unsigned cvt_pk_bf16(float lo, float hi) { unsigned r; asm volatile("v_cvt_pk_bf16_f32 %0, %1, %2" : "=v"(r) : "v"(lo), "v"(hi)); return r; }
typedef float f32x2 __attribute__((ext_vector_type(2)));
typedef unsigned u32x2 __attribute__((ext_vector_type(2)));
constexpr float kLog2e = 1.4426950408889634f;
constexpr float kEps = 1e-6f;
constexpr float QS_SB = 0.125f * kLog2e;
constexpr float QS_MLA = 0.10206207261596577f * kLog2e;
__device__ __forceinline__ u32x2 pack4(f32x4 v) { u32x2 w; w.x = cvt_pk_bf16(v[0], v[1]); w.y = cvt_pk_bf16(v[2], v[3]); return w; }
__device__ __forceinline__ float sigmoid_f(float v) { return __builtin_amdgcn_rcpf(1.0f + __builtin_amdgcn_exp2f(-kLog2e * v)); }
__device__ __forceinline__ f32x4 silu4(f32x4 v) { f32x4 o; o[0] = v[0] * sigmoid_f(v[0]); o[1] = v[1] * sigmoid_f(v[1]); o[2] = v[2] * sigmoid_f(v[2]); o[3] = v[3] * sigmoid_f(v[3]); return o; }
__device__ __forceinline__ f32x4 unpack4(u32x2 w) { f32x4 o; o[0] = __uint_as_float(w.x << 16); o[1] = __uint_as_float(w.x & 0xffff0000u); o[2] = __uint_as_float(w.y << 16); o[3] = __uint_as_float(w.y & 0xffff0000u); return o; }
__device__ __forceinline__ float sumsq4(f32x4 v) { return (v[0] * v[0] + v[1] * v[1]) + (v[2] * v[2] + v[3] * v[3]); }
typedef unsigned u32x4e __attribute__((ext_vector_type(4)));
__device__ __forceinline__ u32x4e pack8(f32x4 a, f32x4 b) { u32x4e w; w.x = cvt_pk_bf16(a[0], a[1]); w.y = cvt_pk_bf16(a[2], a[3]); w.z = cvt_pk_bf16(b[0], b[1]); w.w = cvt_pk_bf16(b[2], b[3]); return w; }
__device__ __forceinline__ f32x4 rope4p(f32x4 v, const float* c, float sg) {
    const f32x4 c0 = *(const f32x4*)(c), c1 = *(const f32x4*)(c + 4);
    f32x4 o;
    o[0] = v[0] * c0[0] + (__shfl_xor(v[0], 32) * sg) * c0[1]; o[1] = v[1] * c0[2] + (__shfl_xor(v[1], 32) * sg) * c0[3];
    o[2] = v[2] * c1[0] + (__shfl_xor(v[2], 32) * sg) * c1[1]; o[3] = v[3] * c1[2] + (__shfl_xor(v[3], 32) * sg) * c1[3];
    return o;
}
__device__ __forceinline__ void rope8(f32x4& v0, f32x4& v1, const float* cs, int fq) {
    const float* c = cs + 16 * (fq & 1); const float sg = (fq < 2) ? -1.0f : 1.0f;
    v0 = rope4p(v0, c, sg); v1 = rope4p(v1, c + 8, sg);
}

struct EpiProj {
    static constexpr bool PERM = true, AFTER_DRAIN = false;
    unsigned char* ws;
    __device__ __forceinline__ void operator()(const f32x4 (&acc)[2][2][4][2], const Unit& u, int wr, int wc, int fr, int fq) const {
        const int pn = u.pn;
        bf16_t* const SBQ = (bf16_t*)(ws + WS_SBQ); bf16_t* const GATE = (bf16_t*)(ws + WS_B); bf16_t* const CQ = (bf16_t*)(ws + WS_CQ); bf16_t* const CKV = (bf16_t*)(ws + WS_CKV); bf16_t* const MK = (bf16_t*)(ws + WS_MK);
        float* const RQSS = (float*)(ws + WS_RQSS); float* const RKVSS = (float*)(ws + WS_RKVSS); const float* const rpre = (const float*)(ws + WS_RPRE); const float* const cs = (const float*)(ws + WS_CS);
        float rsv[2][4];
#pragma unroll
        for (int ai = 0; ai < 2; ++ai)
#pragma unroll
            for (int m = 0; m < 4; ++m) rsv[ai][m] = rpre[u.pm * BM + ai * HALF + wr * 64 + m * 16 + fr];
#pragma unroll
        for (int ai = 0; ai < 2; ++ai)
#pragma unroll
            for (int m = 0; m < 4; ++m) {
                const int row = u.pm * BM + ai * HALF + wr * 64 + m * 16 + fr;
                const float rs = rsv[ai][m];
                const int cw = wc * 32 + fq * 8;
#define PV_(bj, n) (acc[ai][bj][m][n] * rs)
                if (pn < 6) {
                    bf16_t* dst = SBQ + (size_t)(pn >> 1) * (size_t)(16u << 20) + (size_t)row * 512 + (pn & 1) * 256 + cw;
                    const float sc = pn < 2 ? QS_SB * rs : rs;
#pragma unroll
                    for (int bj = 0; bj < 2; ++bj) *(u32x4e*)(dst + bj * HALF) = pack8(acc[ai][bj][m][0] * sc, acc[ai][bj][m][1] * sc);
                } else if (pn < 8) {
                    bf16_t* dst = GATE + (size_t)row * 1024 + (pn - 6) * 256 + cw;
#pragma unroll
                    for (int bj = 0; bj < 2; ++bj) *(u32x4e*)(dst + bj * HALF) = pack8(silu4(PV_(bj, 0)), silu4(PV_(bj, 1)));
                } else if (pn == 8) {
                    bf16_t* dst = CQ + (size_t)row * 256 + cw; float ss = 0.f;
#pragma unroll
                    for (int bj = 0; bj < 2; ++bj) { const f32x4 a = PV_(bj, 0), b = PV_(bj, 1); *(u32x4e*)(dst + bj * HALF) = pack8(a, b); ss += sumsq4(a) + sumsq4(b); }
                    ss += __shfl_xor(ss, 16); ss += __shfl_xor(ss, 32);
                    if (fq == 0) RQSS[(size_t)row * 4 + wc] = ss;
                } else if (pn == 9) {
                    bf16_t* dst = CKV + (size_t)row * 256 + cw;
                    { const f32x4 a = PV_(0, 0), b = PV_(0, 1);
                      *(u32x4e*)dst = pack8(a, b); *(u32x4e*)(dst + HALF) = (u32x4e){0u, 0u, 0u, 0u};
                      float ss = sumsq4(a) + sumsq4(b);
                      ss += __shfl_xor(ss, 16); ss += __shfl_xor(ss, 32);
                      if (fq == 0) RKVSS[(size_t)row * 4 + wc] = ss; }
                    if (wc == 0) {
                        f32x4 x0 = PV_(1, 0), x1 = PV_(1, 1); rope8(x0, x1, cs + (size_t)row * 32, fq);
                        const u32x4e w = pack8(x0, x1);
                        bf16_t* kd = MK + (size_t)row * 768 + 64 + fq * 8;
#pragma unroll
                        for (int h = 0; h < 8; ++h) *(u32x4e*)(kd + h * 96) = w;
                    } else {
                        *(u32x4e*)(GATE + (size_t)row * 1024 + 512 + (wc - 1) * 32 + fq * 8) = pack8(silu4(PV_(1, 0)), silu4(PV_(1, 1)));
                    }
                } else {
                    const int base = 96 + (pn - 10) * 256 + cw;
#pragma unroll
                    for (int bj = 0; bj < 2; ++bj) { const int idx = base + bj * HALF; if (idx < 512) *(u32x4e*)(GATE + (size_t)row * 1024 + 512 + idx) = pack8(silu4(PV_(bj, 0)), silu4(PV_(bj, 1))); }
                }
#undef PV_
            }
    }
};
struct EpiQ {
    static constexpr bool PERM = true, AFTER_DRAIN = false;
    bf16_t* MQ; const float* RQSS; const float* cs;
    __device__ __forceinline__ void operator()(const f32x4 (&acc)[2][2][4][2], const Unit& u, int wr, int wc, int fr, int fq) const {
        float rsv[2][4];
#pragma unroll
        for (int ai = 0; ai < 2; ++ai)
#pragma unroll
            for (int m = 0; m < 4; ++m) { const f32x4 s4 = *(const f32x4*)(RQSS + (size_t)(u.pm * BM + ai * HALF + wr * 64 + m * 16 + fr) * 4);
                rsv[ai][m] = QS_MLA * __builtin_amdgcn_rsqf(((s4[0] + s4[1]) + (s4[2] + s4[3])) * (1.0f / 256.0f) + kEps); }
#pragma unroll
        for (int ai = 0; ai < 2; ++ai)
#pragma unroll
            for (int m = 0; m < 4; ++m) {
                const int row = u.pm * BM + ai * HALF + wr * 64 + m * 16 + fr;
                const float rs = rsv[ai][m];
#pragma unroll
                for (int bj = 0; bj < 2; ++bj) {
                    const int g = u.pn * 8 + bj * 4 + wc;
                    f32x4 x0 = acc[ai][bj][m][0] * rs, x1 = acc[ai][bj][m][1] * rs;
                    if (g % 3 == 2) rope8(x0, x1, cs + (size_t)row * 32, fq);
                    *(u32x4e*)(MQ + (size_t)row * 768 + g * 32 + fq * 8) = pack8(x0, x1);
                }
            }
    }
};
struct EpiKV {
    static constexpr bool PERM = true, AFTER_DRAIN = false;
    bf16_t *MK, *MV; const float* RKVSS;
    __device__ __forceinline__ void operator()(const f32x4 (&acc)[2][2][4][2], const Unit& u, int wr, int wc, int fr, int fq) const {
        float rsv[2][4];
#pragma unroll
        for (int ai = 0; ai < 2; ++ai)
#pragma unroll
            for (int m = 0; m < 4; ++m) { const f32x4 s4 = *(const f32x4*)(RKVSS + (size_t)(u.pm * BM + ai * HALF + wr * 64 + m * 16 + fr) * 4);
                rsv[ai][m] = __builtin_amdgcn_rsqf(((s4[0] + s4[1]) + (s4[2] + s4[3])) * (1.0f / 128.0f) + kEps); }
#pragma unroll
        for (int ai = 0; ai < 2; ++ai)
#pragma unroll
            for (int m = 0; m < 4; ++m) {
                const int row = u.pm * BM + ai * HALF + wr * 64 + m * 16 + fr;
                const float rs = rsv[ai][m];
#pragma unroll
                for (int bj = 0; bj < 2; ++bj) {
                    const int h = u.pn * 2 + bj;
                    bf16_t* dst = (wc < 2) ? (MK + (size_t)row * 768 + h * 96 + wc * 32 + fq * 8) : (MV + (size_t)row * 512 + h * 64 + (wc - 2) * 32 + fq * 8);
                    *(u32x4e*)dst = pack8(acc[ai][bj][m][0] * rs, acc[ai][bj][m][1] * rs);
                }
            }
    }
};
struct EpiStat {
    static constexpr bool PERM = true, AFTER_DRAIN = false;
    bf16_t* OUT; float* SS;
    __device__ __forceinline__ void operator()(const f32x4 (&acc)[2][2][4][2], const Unit& u, int wr, int wc, int fr, int fq) const {
#pragma unroll
        for (int ai = 0; ai < 2; ++ai)
#pragma unroll
            for (int m = 0; m < 4; ++m) {
                const int row = u.pm * BM + ai * HALF + wr * 64 + m * 16 + fr;
                bf16_t* dst = OUT + (size_t)row * 1024 + u.pn * BM + wc * 32 + fq * 8; float ss = 0.f;
#pragma unroll
                for (int bj = 0; bj < 2; ++bj) { const f32x4 v0 = acc[ai][bj][m][0], v1 = acc[ai][bj][m][1];
                    u32x4e w; w.x = cvt_pk_bf16(v0[0], v0[1]); w.y = cvt_pk_bf16(v0[2], v0[3]); w.z = cvt_pk_bf16(v1[0], v1[1]); w.w = cvt_pk_bf16(v1[2], v1[3]);
                    *(u32x4e*)(dst + bj * HALF) = w; ss += sumsq4(v0) + sumsq4(v1); }
                ss += __shfl_xor(ss, 16); ss += __shfl_xor(ss, 32);
                if (fq == 0) SS[(size_t)row * 16 + u.pn * 4 + wc] = ss;
            }
    }
};
struct EpiFinal {
    static constexpr bool PERM = true, AFTER_DRAIN = false;
    const float* x; const bf16_t* Y; const bf16_t* PLE; const float* RY; const float* RP; const float* gpost; const float* gple; const float* bias; float* out;
    __device__ __forceinline__ void operator()(const f32x4 (&acc)[2][2][4][2], const Unit& u, int wr, int wc, int fr, int fq) const {
        const int colb = u.pn * BM + wc * 32 + fq * 8;
#pragma unroll
        for (int ai = 0; ai < 2; ++ai)
#pragma unroll
            for (int mp = 0; mp < 4; mp += 2) {
                f32x4 xv[2][2][2]; u32x4e yw[2][2], pw[2][2]; float ry[2], rp[2];
#pragma unroll
                for (int mm = 0; mm < 2; ++mm) {
                    const int row = u.pm * BM + ai * HALF + wr * 64 + (mp + mm) * 16 + fr;
                    ry[mm] = RY[row]; rp[mm] = RP[row];
#pragma unroll
                    for (int bj = 0; bj < 2; ++bj) { const size_t off = (size_t)row * 1024 + colb + bj * HALF;
                        xv[mm][bj][0] = *(const f32x4*)(x + off); xv[mm][bj][1] = *(const f32x4*)(x + off + 4); yw[mm][bj] = *(const u32x4e*)(Y + off); pw[mm][bj] = *(const u32x4e*)(PLE + off); }
                }
#pragma unroll
                for (int mm = 0; mm < 2; ++mm) {
                    const int row = u.pm * BM + ai * HALF + wr * 64 + (mp + mm) * 16 + fr;
#pragma unroll
                    for (int bj = 0; bj < 2; ++bj) { const int col = colb + bj * HALF; const size_t off = (size_t)row * 1024 + col;
#pragma unroll
                        for (int n = 0; n < 2; ++n) {
                            const f32x4 gp = *(const f32x4*)(gpost + col + 4 * n), gl = *(const f32x4*)(gple + col + 4 * n), bb = *(const f32x4*)(bias + col + 4 * n);
                            const f32x4 yv = unpack4((u32x2){n == 0 ? yw[mm][bj].x : yw[mm][bj].z, n == 0 ? yw[mm][bj].y : yw[mm][bj].w}), pv = unpack4((u32x2){n == 0 ? pw[mm][bj].x : pw[mm][bj].z, n == 0 ? pw[mm][bj].y : pw[mm][bj].w});
                            const f32x4 gt = acc[ai][bj][mp + mm][n] + bb; f32x4 o;
#pragma unroll
                            for (int e = 0; e < 4; ++e) o[e] = (xv[mm][bj][n][e] + yv[e] * ry[mm] * gp[e]) + pv[e] * rp[mm] * gl[e] * sigmoid_f(gt[e]);
                            *(f32x4*)(out + off + 4 * n) = o;
                        }
                    }
                }
            }
    }
};
template <class Epi, class Sched, bool ALIGN_EPI = false, bool SP2 = false>
__device__ __forceinline__ void gemm_phase(PG8_LAS unsigned char* lds, const Gemm g, const Sched& S, const Epi& E) {
    const int tid = threadIdx.x, wid = __builtin_amdgcn_readfirstlane(tid >> 6), lane = tid & 63, wr = wid >> 2, wc = wid & 3, fr = lane & 15, fq = lane >> 4;
    const int K = g.K, nt = K / BK;
    unsigned voffA[2], voffB[2];
#pragma unroll
    for (int i = 0; i < 2; ++i) { int R, C; stage_rc(tid * 16 + i * 8192, R, C); const int Rb = Epi::PERM ? ((R & ~31) + perm32(R & 31)) : R;
        voffA[i] = (unsigned)(R * K + C) * 2u; voffB[i] = (unsigned)(Rb * K + C) * 2u; }
    const size_t kstep = (size_t)(BK * 2);
    const size_t hstep = (size_t)HALF * K * 2;
    const size_t tstep = 2 * hstep;
    const unsigned ldsw = (unsigned)wid * 1024u;
    const int aoff = lds_byte(wr * 64 + fr, fq * 8), boff = lds_byte(wc * 32 + fr, fq * 8);
#define PG8_SA(b, h) (((b) * 2 + (h)) * HTB)
#define PG8_SB(b, h) ((4 + (b) * 2 + (h)) * HTB)
#define PG8_STAGE(bufoff, gbase, voff) do { _Pragma("unroll") for (int _i = 0; _i < 2; ++_i) \
        __builtin_amdgcn_global_load_lds((const unsigned*)((const char*)(gbase) + (voff)[_i]), (PG8_LAS unsigned*)(lds + (bufoff) + ldsw + _i * 8192), 16, 0, 0); } while (0)
#define PG8_LDA(dst, b, h) do { _Pragma("unroll") for (int m = 0; m < 4; ++m) _Pragma("unroll") for (int k = 0; k < 2; ++k) dst[m][k] = *(const PG8_LAS bf16x8*)(lds + PG8_SA(b, h) + aoff + m * 2048 + k * 1024); } while (0)
#define PG8_LDB(dst, b, h) do { _Pragma("unroll") for (int n = 0; n < 2; ++n) _Pragma("unroll") for (int k = 0; k < 2; ++k) dst[n][k] = *(const PG8_LAS bf16x8*)(lds + PG8_SB(b, h) + boff + n * 2048 + k * 1024); } while (0)
#define PG8_MMA(ai, bj, At, Bt) do { __builtin_amdgcn_s_setprio(1); _Pragma("unroll") for (int m = 0; m < 4; ++m) _Pragma("unroll") for (int n = 0; n < 2; ++n) _Pragma("unroll") for (int k = 0; k < 2; ++k) \
        acc[ai][bj][m][n] = __builtin_amdgcn_mfma_f32_16x16x32_bf16(Bt[n][k], At[m][k], acc[ai][bj][m][n], 0, 0, 0); __builtin_amdgcn_s_setprio(0); } while (0)
#define PG8_WAIT_V(n) asm volatile("s_waitcnt vmcnt(" #n ")" ::: "memory")
#define PG8_WAIT_L(n) asm volatile("s_waitcnt lgkmcnt(" #n ")" ::: "memory")
#define PG8_BAR __builtin_amdgcn_s_barrier()
#define PG8_SCHED __builtin_amdgcn_sched_barrier(0)
    Unit cur, nxt; int ui = 0;
    if (!S.next(0, cur)) return;
    f32x4 acc[2][2][4][2];
#pragma unroll
    for (int a = 0; a < 2; ++a)
#pragma unroll
        for (int b = 0; b < 2; ++b)
#pragma unroll
            for (int m = 0; m < 4; ++m)
#pragma unroll
                for (int n = 0; n < 2; ++n) acc[a][b][m][n] = (f32x4){0.f, 0.f, 0.f, 0.f};
    bf16x8 At[4][2], B0[2][2], B1[2][2];
    const char* cA = (const char*)g.A + (size_t)cur.pm * tstep; const char* cB = (const char*)g.Bt + (size_t)cur.pn * tstep;
    S.a_ready(cur);
    if constexpr (SP2) {
        PG8_STAGE(PG8_SB(0, 0), cB, voffB); PG8_STAGE(PG8_SB(0, 1), cB + hstep, voffB); PG8_STAGE(PG8_SA(0, 0), cA, voffA); PG8_STAGE(PG8_SA(0, 1), cA + hstep, voffA);
        if (wr == 1) PG8_BAR;
        PG8_WAIT_V(2); PG8_BAR;
        PG8_STAGE(PG8_SB(1, 0), cB + kstep, voffB); PG8_STAGE(PG8_SA(1, 0), cA + kstep, voffA); PG8_STAGE(PG8_SB(1, 1), cB + hstep + kstep, voffB);
        PG8_WAIT_V(6); PG8_BAR;
    } else {
        PG8_STAGE(PG8_SB(0, 0), cB, voffB); PG8_STAGE(PG8_SA(0, 0), cA, voffA); PG8_STAGE(PG8_SB(0, 1), cB + hstep, voffB); PG8_STAGE(PG8_SA(0, 1), cA + hstep, voffA);
        if (wr == 1) PG8_BAR;
        PG8_WAIT_V(4); PG8_BAR;
        PG8_STAGE(PG8_SB(1, 0), cB + kstep, voffB); PG8_STAGE(PG8_SA(1, 0), cA + kstep, voffA); PG8_STAGE(PG8_SB(1, 1), cB + hstep + kstep, voffB);
        PG8_WAIT_V(6); PG8_BAR;
    }
    for (;;) {
        const bool has_next = S.next(ui + 1, nxt);
        const char* nA = has_next ? (const char*)g.A + (size_t)nxt.pm * tstep : cA; const char* nB = has_next ? (const char*)g.Bt + (size_t)nxt.pn * tstep : cB;
        for (int t = 0; t < nt; t += 2) {
            const bool last = (t == nt - 2);
            const char* a1 = cA + (size_t)(t + 1) * kstep;
            const char* a2 = last ? nA : cA + (size_t)(t + 2) * kstep; const char* b2 = last ? nB : cB + (size_t)(t + 2) * kstep;
            const char* a3 = a2 + kstep; const char* b3 = b2 + kstep;
            if (last && has_next) S.a_ready(nxt);
            if constexpr (SP2) {
            PG8_LDB(B0, 0, 0); PG8_LDB(B1, 0, 1); PG8_SCHED; PG8_LDA(At, 0, 0); PG8_STAGE(PG8_SA(1, 1), a1 + hstep, voffA);
            PG8_WAIT_V(8); PG8_WAIT_L(0); PG8_BAR; PG8_MMA(0, 0, At, B0); PG8_MMA(0, 1, At, B1); PG8_BAR; PG8_SCHED;
            PG8_LDA(At, 0, 1); PG8_STAGE(PG8_SB(0, 0), b2, voffB); PG8_STAGE(PG8_SB(0, 1), b2 + hstep, voffB); PG8_STAGE(PG8_SA(0, 0), a2, voffA);
            PG8_WAIT_V(8); PG8_WAIT_L(0); PG8_BAR; PG8_MMA(1, 0, At, B0); PG8_MMA(1, 1, At, B1); PG8_BAR; PG8_SCHED;
            PG8_LDB(B0, 1, 0); PG8_LDB(B1, 1, 1); PG8_SCHED; PG8_LDA(At, 1, 0); PG8_STAGE(PG8_SA(0, 1), a2 + hstep, voffA);
            PG8_WAIT_V(8); PG8_WAIT_L(0); PG8_BAR; PG8_MMA(0, 0, At, B0); PG8_MMA(0, 1, At, B1); PG8_BAR; PG8_SCHED;
            PG8_LDA(At, 1, 1); PG8_STAGE(PG8_SB(1, 0), b3, voffB); PG8_STAGE(PG8_SB(1, 1), b3 + hstep, voffB); PG8_STAGE(PG8_SA(1, 0), a3, voffA);
            PG8_WAIT_V(8); PG8_WAIT_L(0); PG8_BAR; PG8_MMA(1, 0, At, B0); PG8_MMA(1, 1, At, B1); PG8_BAR; PG8_SCHED;
            } else {
            PG8_LDB(B0, 0, 0); PG8_SCHED; PG8_LDA(At, 0, 0); PG8_STAGE(PG8_SA(1, 1), a1 + hstep, voffA);
            PG8_WAIT_L(8); PG8_BAR; PG8_WAIT_L(0); PG8_MMA(0, 0, At, B0); PG8_BAR; PG8_SCHED;
            PG8_LDB(B1, 0, 1); PG8_STAGE(PG8_SB(0, 0), b2, voffB);
            PG8_BAR; PG8_WAIT_L(0); PG8_MMA(0, 1, At, B1); PG8_BAR;
            PG8_LDA(At, 0, 1); PG8_STAGE(PG8_SA(0, 0), a2, voffA);
            PG8_BAR; PG8_WAIT_L(0); PG8_MMA(1, 0, At, B0); PG8_BAR; PG8_SCHED;
            PG8_STAGE(PG8_SB(0, 1), b2 + hstep, voffB);
            PG8_WAIT_V(6); PG8_BAR; PG8_MMA(1, 1, At, B1); PG8_BAR;
            PG8_LDB(B0, 1, 0); PG8_SCHED; PG8_LDA(At, 1, 0); PG8_STAGE(PG8_SA(0, 1), a2 + hstep, voffA);
            PG8_WAIT_L(8); PG8_BAR; PG8_WAIT_L(0); PG8_MMA(0, 0, At, B0); PG8_BAR; PG8_SCHED;
            PG8_LDB(B1, 1, 1); PG8_STAGE(PG8_SB(1, 0), b3, voffB);
            PG8_BAR; PG8_WAIT_L(0); PG8_MMA(0, 1, At, B1); PG8_BAR;
            PG8_LDA(At, 1, 1); PG8_STAGE(PG8_SA(1, 0), a3, voffA);
            PG8_BAR; PG8_WAIT_L(0); PG8_MMA(1, 0, At, B0); PG8_BAR; PG8_SCHED;
            PG8_STAGE(PG8_SB(1, 1), b3 + hstep, voffB);
            PG8_WAIT_V(6); PG8_BAR; PG8_MMA(1, 1, At, B1); PG8_BAR;
            }
        }
        if constexpr (ALIGN_EPI) { if (wr == 0) PG8_BAR; }
        if constexpr (!Epi::AFTER_DRAIN) { E(acc, cur, wr, wc, fr, fq); S.done(cur); }
        if (!has_next) break;
#pragma unroll
        for (int a = 0; a < 2; ++a)
#pragma unroll
            for (int b = 0; b < 2; ++b)
#pragma unroll
                for (int m = 0; m < 4; ++m)
#pragma unroll
                    for (int n = 0; n < 2; ++n) acc[a][b][m][n] = (f32x4){0.f, 0.f, 0.f, 0.f};
        cur = nxt; cA = nA; cB = nB; ++ui;
        if constexpr (ALIGN_EPI) { if (wr == 1) PG8_BAR; }
    }
    PG8_WAIT_V(0);
    if constexpr (!ALIGN_EPI) { if (wr == 0) PG8_BAR; }
    PG8_BAR;
    if constexpr (Epi::AFTER_DRAIN) { E.fused(acc, cur, wr, wc, fr, fq, lds, wid, lane); S.done(cur); }
#undef PG8_SA
#undef PG8_SB
#undef PG8_STAGE
#undef PG8_LDA
#undef PG8_LDB
#undef PG8_MMA
#undef PG8_WAIT_V
#undef PG8_WAIT_L
#undef PG8_BAR
#undef PG8_SCHED
}
}
namespace att {
using bf16x8 = __attribute__((ext_vector_type(8))) short;
using s16x4 = __attribute__((ext_vector_type(4))) short;
using f32x16 = __attribute__((ext_vector_type(16))) float;
using f32x4 = __attribute__((ext_vector_type(4))) float;
using u32x4 = __attribute__((ext_vector_type(4))) unsigned;
typedef unsigned short bf16_t;
#define ALAS __attribute__((address_space(3)))
constexpr int SEQ = 4096, KSLOT = 16384, VSLOT = 8192, NSLOT = 3;
constexpr int L_K = 0, L_V = NSLOT * KSLOT, L_WS = L_V + NSLOT * VSLOT, L_FLAG = L_WS + 8 * 64 * 4, L_OST = L_FLAG + 256, L_END = L_OST + 8 * 8192;
constexpr float kEps = 1e-6f;
constexpr float SB_DONE = 151.0f;
__device__ __forceinline__ int crow(int r, int hi) { return (r & 3) + 8 * (r >> 2) + 4 * hi; }
__device__ __forceinline__ void glds16(const void* gsrc, unsigned lds_dst) { unsigned keep;
    asm volatile("s_mov_b32 %0, m0\n\ts_mov_b32 m0, %2\n\ts_nop 0\n\tglobal_load_lds_dwordx4 %1, off\n\ts_mov_b32 m0, %0" : "=&s"(keep) : "v"(gsrc), "s"(lds_dst) : "memory"); }
typedef float f32x2_t __attribute__((ext_vector_type(2))); typedef __bf16 bf16x2_t __attribute__((ext_vector_type(2)));
__device__ __forceinline__ unsigned cvtpk(float lo, float hi) { f32x2_t v = {lo, hi}; bf16x2_t b = __builtin_convertvector(v, bf16x2_t); return __builtin_bit_cast(unsigned, b); }
#define A_WAIT_BAR(N) asm volatile("s_waitcnt vmcnt(" #N ") lgkmcnt(0)\n\ts_barrier" ::: "memory")

template <int ND0> __device__ __forceinline__ void qkt(f32x16& p0, f32x16& p1, const ALAS char* Kslot, const bf16x8* qr, int r32, int hi) {
    const ALAS char* kb = Kslot + hi * 1024 + r32 * 16;
    p0 = f32x16{}; p1 = f32x16{};
#pragma unroll
    for (int d0 = 0; d0 < ND0; ++d0) {
        const bf16x8 b0 = *(const ALAS bf16x8*)(kb + d0 * 2048);
        const bf16x8 b1 = *(const ALAS bf16x8*)(kb + d0 * 2048 + 512);
        p0 = __builtin_amdgcn_mfma_f32_32x32x16_bf16(b0, qr[d0], p0, 0, 0, 0);
        p1 = __builtin_amdgcn_mfma_f32_32x32x16_bf16(b1, qr[d0], p1, 0, 0, 0);
    }
}
__device__ __forceinline__ void pv(f32x16* o, int vb, bf16x8 pa0, bf16x8 pa1, bf16x8 pa2, bf16x8 pa3) {
#pragma unroll
    for (int d0 = 0; d0 < 2; ++d0) { s16x4 lo[4], hi[4];
#pragma unroll
        for (int ks = 0; ks < 4; ++ks) {
            asm volatile("ds_read_b64_tr_b16 %0,%1 offset:%c2" : "=&v"(lo[ks]) : "v"(vb), "i"(d0 * 4096 + ks * 1024) : "memory");
            asm volatile("ds_read_b64_tr_b16 %0,%1 offset:%c2" : "=&v"(hi[ks]) : "v"(vb), "i"(d0 * 4096 + ks * 1024 + 512) : "memory"); }
        asm volatile("s_waitcnt lgkmcnt(0)" ::: "memory"); __builtin_amdgcn_sched_barrier(0);
#define A_PK(k) (bf16x8){lo[k][0], lo[k][1], lo[k][2], lo[k][3], hi[k][0], hi[k][1], hi[k][2], hi[k][3]}
        o[d0] = __builtin_amdgcn_mfma_f32_32x32x16_bf16(pa0, A_PK(0), o[d0], 0, 0, 0);
        o[d0] = __builtin_amdgcn_mfma_f32_32x32x16_bf16(pa1, A_PK(1), o[d0], 0, 0, 0);
        o[d0] = __builtin_amdgcn_mfma_f32_32x32x16_bf16(pa2, A_PK(2), o[d0], 0, 0, 0);
        o[d0] = __builtin_amdgcn_mfma_f32_32x32x16_bf16(pa3, A_PK(3), o[d0], 0, 0, 0);
#undef A_PK
    }
}
typedef short v4i16_t __attribute__((ext_vector_type(4)));
__device__ __forceinline__ s16x4 vtr(const ALAS char* p) { return __builtin_bit_cast(s16x4, __builtin_amdgcn_ds_read_tr16_b64_v4i16((ALAS v4i16_t*)p)); }
__device__ __forceinline__ float xhalf_sum(float v) { auto rr = __builtin_amdgcn_permlane32_swap(__float_as_uint(v), __float_as_uint(v), false, false); return __uint_as_float(rr[0]) + __uint_as_float(rr[1]); }
__device__ __forceinline__ float xhalf_max(float v) { auto rr = __builtin_amdgcn_permlane32_swap(__float_as_uint(v), __float_as_uint(v), false, false); return fmaxf(__uint_as_float(rr[0]), __uint_as_float(rr[1])); }

template <bool SBK> __device__ __forceinline__ void attn_unit(int b, int h, int qb, const bf16_t* Q, const bf16_t* K, const bf16_t* V, const bf16_t* gate, const float* gnorm, bf16_t* out, int goff, ALAS char* shm) {
    constexpr int DQK = SBK ? 64 : 96, QP = SBK ? 512 : 768, ND0 = DQK / 16;
    const int tid = threadIdx.x, lane = tid & 63, r32 = lane & 31, hi = lane >> 5; const int wid = __builtin_amdgcn_readfirstlane(tid >> 6);
    const long rowbase = (long)b * SEQ; const int q0 = qb * 256;
    const bf16_t* Qw = Q + (rowbase + q0 + wid * 32) * QP + h * DQK;
    const bf16_t* Kh = K + rowbase * QP + h * DQK; const bf16_t* Vh = V + rowbase * 512 + h * 64;
    const unsigned lds0 = (unsigned)(uintptr_t)shm;
    ALAS float* wsf = (ALAS float*)(shm + L_WS) + wid * 64;
    ALAS unsigned* flags = (ALAS unsigned*)(shm + L_FLAG);
    const bf16_t* ksrc = Kh + (long)lane * QP + wid * 8;
    const bf16_t* ksrc2 = Kh + (long)lane * QP + (8 + (wid & 3)) * 8;
    const bf16_t* vsrc = Vh + (long)(16 * (wid & 3) + (lane >> 2)) * 512 + (wid >> 2) * 32 + (lane & 3) * 8;
    const unsigned kdst = lds0 + L_K + wid * 1024, vdst = lds0 + L_V + wid * 1024;
    const int NT = 4 * qb + 4;
    const int tw = 4 * qb + (wid >> 1);
#define A_TILE(i) (SBK ? (NT - 1 - (i)) : (i))
#define A_DMA(i, s) do { const int t_ = A_TILE(i); glds16(ksrc + (long)t_ * 64 * QP, (unsigned)__builtin_amdgcn_readfirstlane(kdst + (s) * KSLOT)); \
        if (!SBK) glds16(ksrc2 + (long)t_ * 64 * QP, (unsigned)__builtin_amdgcn_readfirstlane(kdst + 8192 + (s) * KSLOT)); \
        glds16(vsrc + (long)t_ * 64 * 512, (unsigned)__builtin_amdgcn_readfirstlane(vdst + (s) * VSLOT)); } while (0)
    A_DMA(0, 0); A_DMA(1, 1);
    bf16x8 qr[ND0];
#pragma unroll
    for (int d0 = 0; d0 < ND0; ++d0) qr[d0] = *(const bf16x8*)(Qw + (long)r32 * QP + d0 * 16 + hi * 8);
    f32x16 o[2]; o[0] = f32x16{}; o[1] = f32x16{};
    float m_run = -INFINITY, l_run = 0.f, carry = 0.f;
    const int vb0 = (int)(lds0 + L_V) + ((lane >> 4) & 1) * 32 + (lane & 3) * 8 + (4 * hi + ((lane & 15) >> 2)) * 64;
    int slot = 0;
    for (int i = 0; i < NT; ++i) {
        if (i + 1 < NT) { if (SBK) { A_WAIT_BAR(2); } else { A_WAIT_BAR(3); } } else { A_WAIT_BAR(0); }
        if (SBK && i > 0) {
            const ALAS unsigned* fl = flags + ((i - 1) & 1) * 8; unsigned all = 1u;
#pragma unroll
            for (int w = 0; w < 8; ++w) all &= fl[w];
            if (all) break;
        }
        if (i + 2 < NT) { const int s2 = (slot >= 1) ? slot - 1 : slot + 2; A_DMA(i + 2, s2); }
        const int t = A_TILE(i);
        if (t <= tw) {
            f32x16 p0, p1;
            qkt<ND0>(p0, p1, shm + L_K + slot * KSLOT, qr, r32, hi);
            if (SBK) {
                if (t == tw) { const int qrel = 32 * (wid & 1) + r32;
#pragma unroll
                    for (int r = 0; r < 16; ++r) { const int kv = crow(r, hi); if (kv >= qrel) p0[r] = -INFINITY; if (kv + 32 >= qrel) p1[r] = -INFINITY; } }
                f32x16 s0, s1;
#pragma unroll
                for (int r = 0; r < 16; ++r) {
                    s0[r] = fmaxf(p0[r], 0.f) + __builtin_amdgcn_logf(1.0f + __builtin_amdgcn_exp2f(-fabsf(p0[r])));
                    s1[r] = fmaxf(p1[r], 0.f) + __builtin_amdgcn_logf(1.0f + __builtin_amdgcn_exp2f(-fabsf(p1[r])));
                }
                float lo_[8], up_[8];
#pragma unroll
                for (int i4 = 0; i4 < 8; ++i4) {
                    const float bs = (i4 < 4) ? ((s0[4 * i4] + s0[4 * i4 + 1]) + (s0[4 * i4 + 2] + s0[4 * i4 + 3])) : ((s1[4 * i4 - 16] + s1[4 * i4 - 15]) + (s1[4 * i4 - 14] + s1[4 * i4 - 13]));
                    auto rr = __builtin_amdgcn_permlane32_swap(__float_as_uint(bs), __float_as_uint(bs), false, false);
                    lo_[i4] = __uint_as_float(rr[0]); up_[i4] = __uint_as_float(rr[1]);
                }
                float run = carry;
#pragma unroll
                for (int i4 = 7; i4 >= 0; --i4) {
                    float c = run + (hi == 0 ? up_[i4] : 0.f);
#pragma unroll
                    for (int e = 3; e >= 0; --e) {
                        if (i4 < 4) { c += s0[4 * i4 + e]; p0[4 * i4 + e] = __builtin_amdgcn_exp2f(p0[4 * i4 + e] - c); }
                        else { c += s1[4 * i4 - 16 + e]; p1[4 * i4 - 16 + e] = __builtin_amdgcn_exp2f(p1[4 * i4 - 16 + e] - c); }
                    }
                    run += lo_[i4] + up_[i4];
                }
                carry = run;
            } else {
                float rm = fmaxf(p0[0], p1[0]);
#pragma unroll
                for (int r = 1; r < 16; ++r) rm = fmaxf(rm, fmaxf(p0[r], p1[r]));
                rm = xhalf_max(rm);
                const float m_new = fmaxf(m_run, rm);
                const float alpha = __builtin_amdgcn_exp2f(m_run - m_new);
                float ls = 0.f;
#pragma unroll
                for (int r = 0; r < 16; ++r) { p0[r] = __builtin_amdgcn_exp2f(p0[r] - m_new); p1[r] = __builtin_amdgcn_exp2f(p1[r] - m_new); ls += p0[r] + p1[r]; }
                l_run = l_run * alpha + ls; m_run = m_new;
                if (!__all(alpha == 1.0f)) {
                    if (hi == 0) wsf[r32] = alpha;
#pragma unroll
                    for (int r = 0; r < 16; ++r) { const float f = wsf[crow(r, hi)]; o[0][r] *= f; o[1][r] *= f; }
                }
            }
            u32x4 pw0, pw1, pw2, pw3;
            pw0 = (u32x4){cvtpk(p0[0], p0[1]), cvtpk(p0[2], p0[3]), cvtpk(p0[4], p0[5]), cvtpk(p0[6], p0[7])};
            pw1 = (u32x4){cvtpk(p0[8], p0[9]), cvtpk(p0[10], p0[11]), cvtpk(p0[12], p0[13]), cvtpk(p0[14], p0[15])};
            pw2 = (u32x4){cvtpk(p1[0], p1[1]), cvtpk(p1[2], p1[3]), cvtpk(p1[4], p1[5]), cvtpk(p1[6], p1[7])};
            pw3 = (u32x4){cvtpk(p1[8], p1[9]), cvtpk(p1[10], p1[11]), cvtpk(p1[12], p1[13]), cvtpk(p1[14], p1[15])};
            pv(o, vb0 + slot * VSLOT, __builtin_bit_cast(bf16x8, pw0), __builtin_bit_cast(bf16x8, pw1), __builtin_bit_cast(bf16x8, pw2), __builtin_bit_cast(bf16x8, pw3));
        }
        if (SBK) { const bool done = (t <= tw) && __all(carry > SB_DONE); if (lane == 0) flags[(i & 1) * 8 + wid] = done ? 1u : 0u; }
        slot = (slot == NSLOT - 1) ? 0 : slot + 1;
    }
    A_WAIT_BAR(0);
    float rli[16];
    if (!SBK) {
        const float lt = xhalf_sum(l_run);
        if (hi == 0) wsf[32 + r32] = lt;
#pragma unroll
        for (int r = 0; r < 16; ++r) rli[r] = __builtin_amdgcn_rcpf(wsf[32 + crow(r, hi)]);
    } else {
#pragma unroll
        for (int r = 0; r < 16; ++r) rli[r] = 1.0f;
    }
    ALAS float* stg = (ALAS float*)(shm + L_OST) + wid * 2048;
#pragma unroll
    for (int r = 0; r < 16; ++r) { const int orow = crow(r, hi);
#pragma unroll
        for (int d0 = 0; d0 < 2; ++d0) stg[orow * 64 + d0 * 32 + r32] = o[d0][r] * rli[r]; }
    const long grow0 = rowbase + q0 + wid * 32;
    u32x4 gvp[4];
#pragma unroll
    for (int i = 0; i < 4; ++i) gvp[i] = *(const u32x4*)(gate + (size_t)(grow0 + i * 8 + (lane >> 3)) * 1024 + goff + h * 64 + (lane & 7) * 8);
#pragma unroll
    for (int i = 0; i < 4; ++i) {
        const int row = i * 8 + (lane >> 3), ch = lane & 7;
        const f32x4 a = *(const ALAS f32x4*)(stg + row * 64 + ch * 8), c = *(const ALAS f32x4*)(stg + row * 64 + ch * 8 + 4);
        float ss = ((a[0] * a[0] + a[1] * a[1]) + (a[2] * a[2] + a[3] * a[3])) + ((c[0] * c[0] + c[1] * c[1]) + (c[2] * c[2] + c[3] * c[3]));
        ss += __shfl_xor(ss, 1); ss += __shfl_xor(ss, 2); ss += __shfl_xor(ss, 4);
        const float rn = 1.0f / sqrtf(ss * (1.0f / 64.0f) + kEps);
        const size_t off = (size_t)(grow0 + row) * 1024 + goff + h * 64 + ch * 8;
        const u32x4 gv = gvp[i];
        const f32x4 g0 = *(const f32x4*)(gnorm + h * 64 + ch * 8), g1 = *(const f32x4*)(gnorm + h * 64 + ch * 8 + 4);
        float v[8];
#pragma unroll
        for (int e = 0; e < 4; ++e) { v[e] = a[e] * rn * g0[e]; v[4 + e] = c[e] * rn * g1[e]; }
        u32x4 w;
#pragma unroll
        for (int e = 0; e < 4; ++e) { const unsigned gw = gv[e]; w[e] = cvtpk(v[2 * e] * __uint_as_float(gw << 16), v[2 * e + 1] * __uint_as_float(gw & 0xffff0000u)); }
        *(u32x4*)(out + off) = w;
    }
    A_WAIT_BAR(0);
#undef A_TILE
#undef A_DMA
}

constexpr int M_K = 0, M_V = NSLOT * KSLOT, M_WS = M_V + 4 * VSLOT, M_END = M_WS + 8 * 64 * 4;
constexpr float MLA_THR = 8.0f;
#define A_BAR_L() asm volatile("s_waitcnt lgkmcnt(0)\n\ts_barrier" ::: "memory")
__device__ __forceinline__ void mla_unit(int b, int h, int qb, const bf16_t* Q, const bf16_t* K, const bf16_t* V, const bf16_t* gate, const float* gnorm, bf16_t* out, int goff, ALAS char* shm) {
    constexpr int QP = 768, ND0 = 6;
    const int tid = threadIdx.x, lane = tid & 63, r32 = lane & 31, hi = lane >> 5; const int wid = __builtin_amdgcn_readfirstlane(tid >> 6);
    const int grp = wid >> 2;
    const long rowbase = (long)b * SEQ; const int q0 = qb * 256;
    const bf16_t* Qw = Q + (rowbase + q0 + wid * 32) * QP + h * 96;
    const bf16_t* Kh = K + rowbase * QP + h * 96; const bf16_t* Vh = V + rowbase * 512 + h * 64;
    const unsigned lds0 = (unsigned)(uintptr_t)shm;
    ALAS float* wsf = (ALAS float*)(shm + M_WS) + wid * 64;
    const bf16_t* ksrc = Kh + (long)lane * QP + wid * 8;
    const bf16_t* ksrc2 = Kh + (long)lane * QP + (8 + (wid & 3)) * 8;
    const bf16_t* vsrc = Vh + (long)(16 * (wid & 3) + (lane >> 2)) * 512 + (wid >> 2) * 32 + (lane & 3) * 8;
    const unsigned kdst = lds0 + M_K + wid * 1024, vdst = lds0 + M_V + wid * 1024;
    const int NT = 4 * qb + 4, tw = 4 * qb + (wid >> 1);
#define M_DMA(t_) do { const int tt_ = (t_); const int ks_ = tt_ % 3, vs_ = tt_ & 3; glds16(ksrc + (long)tt_ * 64 * QP, (unsigned)__builtin_amdgcn_readfirstlane(kdst + ks_ * KSLOT)); \
        glds16(ksrc2 + (long)tt_ * 64 * QP, (unsigned)__builtin_amdgcn_readfirstlane(kdst + 8192 + ks_ * KSLOT)); \
        glds16(vsrc + (long)tt_ * 64 * 512, (unsigned)__builtin_amdgcn_readfirstlane(vdst + vs_ * VSLOT)); } while (0)
    M_DMA(0); M_DMA(1);
    bf16x8 qr[ND0];
#pragma unroll
    for (int d0 = 0; d0 < ND0; ++d0) qr[d0] = *(const bf16x8*)(Qw + (long)r32 * QP + d0 * 16 + hi * 8);
    f32x16 o[2]; o[0] = f32x16{}; o[1] = f32x16{};
    f32x16 negm = f32x16{}; f32x16 p0 = f32x16{}, p1 = f32x16{};
    u32x4 pw0 = {0u, 0u, 0u, 0u}, pw1 = pw0, pw2 = pw0, pw3 = pw0;
    float m_hat = 0.f, l_run = 0.f; bool need = false;
    const int vb0 = (int)(lds0 + M_V) + ((lane >> 4) & 1) * 32 + (lane & 3) * 8 + (4 * hi + ((lane & 15) >> 2)) * 64;
    const int voff = ((lane >> 4) & 1) * 32 + (lane & 3) * 8 + (4 * hi + ((lane & 15) >> 2)) * 64;
#define M_BAR_EVEN(t_) do { if ((t_) + 1 < NT) { A_WAIT_BAR(3); } else { A_WAIT_BAR(0); } if ((t_) + 2 < NT) M_DMA((t_) + 2); } while (0)
#define M_KLD(d0) do { kf_[2 * (d0)] = *(const ALAS bf16x8*)(kb_ + (d0) * 2048); kf_[2 * (d0) + 1] = *(const ALAS bf16x8*)(kb_ + (d0) * 2048 + 512); } while (0)
#define M_QK(d0) do { p0 = __builtin_amdgcn_mfma_f32_32x32x16_bf16(kf_[2 * (d0)], qr[d0], (d0) == 0 ? negm : p0, 0, 0, 0); p1 = __builtin_amdgcn_mfma_f32_32x32x16_bf16(kf_[2 * (d0) + 1], qr[d0], (d0) == 0 ? negm : p1, 0, 0, 0); } while (0)
#define M_STAGE_A(t_) do { const int ta_ = (t_); \
        const ALAS char* vp_ = shm + M_V + ((ta_ - 1) & 3) * VSLOT + voff; const ALAS char* kb_ = shm + M_K + (ta_ % 3) * KSLOT + hi * 1024 + r32 * 16; \
        s16x4 vl_[4], vh_[4]; bf16x8 kf_[12]; \
        _Pragma("unroll") for (int ks = 0; ks < 4; ++ks) { vl_[ks] = vtr(vp_ + ks * 1024); vh_[ks] = vtr(vp_ + ks * 1024 + 512); } \
        M_KLD(0); M_KLD(1); \
        __builtin_amdgcn_sched_barrier(0); \
        if (need) { _Pragma("unroll") for (int r = 0; r < 16; ++r) { const float f = wsf[crow(r, hi)]; o[0][r] *= f; o[1][r] *= f; } } \
        _Pragma("unroll") for (int ks = 0; ks < 4; ++ks) o[0] = __builtin_amdgcn_mfma_f32_32x32x16_bf16(M_PA(ks), M_VF(ks), o[0], 0, 0, 0); \
        __builtin_amdgcn_sched_barrier(0); \
        M_KLD(2); M_KLD(3); \
        __builtin_amdgcn_sched_barrier(0); \
        M_QK(0); M_QK(1); \
        __builtin_amdgcn_sched_barrier(0); \
        _Pragma("unroll") for (int ks = 0; ks < 4; ++ks) { vl_[ks] = vtr(vp_ + 4096 + ks * 1024); vh_[ks] = vtr(vp_ + 4096 + ks * 1024 + 512); } \
        M_KLD(4); M_KLD(5); \
        __builtin_amdgcn_sched_barrier(0); \
        M_QK(2); M_QK(3); M_QK(4); M_QK(5); \
        _Pragma("unroll") for (int ks = 0; ks < 4; ++ks) o[1] = __builtin_amdgcn_mfma_f32_32x32x16_bf16(M_PA(ks), M_VF(ks), o[1], 0, 0, 0); } while (0)
      \
#define M_STAGE_A_SW(t_, PVON, QKON) do { const int ta_ = (t_); \
        if (PVON) { \
            if (need) { _Pragma("unroll") for (int r = 0; r < 16; ++r) { const float f = wsf[crow(r, hi)]; o[0][r] *= f; o[1][r] *= f; } } \
            pv(o, vb0 + ((ta_ - 1) & 3) * VSLOT, __builtin_bit_cast(bf16x8, pw0), __builtin_bit_cast(bf16x8, pw1), __builtin_bit_cast(bf16x8, pw2), __builtin_bit_cast(bf16x8, pw3)); } \
        if (QKON) { const ALAS char* kb = shm + M_K + (ta_ % 3) * KSLOT + hi * 1024 + r32 * 16; \
            _Pragma("unroll") for (int d0 = 0; d0 < ND0; ++d0) { \
                const bf16x8 b0 = *(const ALAS bf16x8*)(kb + d0 * 2048); const bf16x8 b1 = *(const ALAS bf16x8*)(kb + d0 * 2048 + 512); \
                p0 = __builtin_amdgcn_mfma_f32_32x32x16_bf16(b0, qr[d0], d0 == 0 ? negm : p0, 0, 0, 0); \
                p1 = __builtin_amdgcn_mfma_f32_32x32x16_bf16(b1, qr[d0], d0 == 0 ? negm : p1, 0, 0, 0); } } } while (0)
#define M_PA(k) ((k) == 0 ? __builtin_bit_cast(bf16x8, pw0) : (k) == 1 ? __builtin_bit_cast(bf16x8, pw1) : (k) == 2 ? __builtin_bit_cast(bf16x8, pw2) : __builtin_bit_cast(bf16x8, pw3))
#define M_VF(i) (bf16x8){vl_[i][0], vl_[i][1], vl_[i][2], vl_[i][3], vh_[i][0], vh_[i][1], vh_[i][2], vh_[i][3]}
#define M_STAGE_B(t_, ON) do { const int tb_ = (t_); if (ON) { __builtin_amdgcn_s_setprio(1); \
        float a0 = fmaxf(fmaxf(p0[0], p0[1]), p1[0]), a1 = fmaxf(fmaxf(p0[2], p0[3]), p1[1]); a0 = fmaxf(fmaxf(a0, p1[2]), p1[3]); \
        _Pragma("unroll") for (int r = 4; r < 16; r += 4) { a0 = fmaxf(fmaxf(a0, p0[r]), p0[r + 1]); a1 = fmaxf(fmaxf(a1, p0[r + 2]), p0[r + 3]); a0 = fmaxf(fmaxf(a0, p1[r]), p1[r + 1]); a1 = fmaxf(fmaxf(a1, p1[r + 2]), p1[r + 3]); } \
        const float rm = xhalf_max(fmaxf(a0, a1)); \
        need = false; \
        if (tb_ == 0 || __any(rm > MLA_THR)) { \
            const float dl = (tb_ == 0) ? rm : fmaxf(rm, 0.f); \
            m_hat += dl; \
            _Pragma("unroll") for (int r = 0; r < 16; ++r) { p0[r] -= dl; p1[r] -= dl; } \
            _Pragma("unroll") for (int r = 0; r < 16; ++r) negm[r] = -m_hat; \
            if (tb_ > 0) { const float f = __builtin_amdgcn_exp2f(-dl); l_run *= f; if (hi == 0) wsf[r32] = f; need = true; } } \
        float ls0 = 0.f, ls1 = 0.f; \
        _Pragma("unroll") for (int r = 0; r < 16; ++r) { p0[r] = __builtin_amdgcn_exp2f(p0[r]); p1[r] = __builtin_amdgcn_exp2f(p1[r]); ls0 += p0[r]; ls1 += p1[r]; } \
        l_run += ls0 + ls1; \
        pw0 = (u32x4){cvtpk(p0[0], p0[1]), cvtpk(p0[2], p0[3]), cvtpk(p0[4], p0[5]), cvtpk(p0[6], p0[7])}; \
        pw1 = (u32x4){cvtpk(p0[8], p0[9]), cvtpk(p0[10], p0[11]), cvtpk(p0[12], p0[13]), cvtpk(p0[14], p0[15])}; \
        pw2 = (u32x4){cvtpk(p1[0], p1[1]), cvtpk(p1[2], p1[3]), cvtpk(p1[4], p1[5]), cvtpk(p1[6], p1[7])}; \
        pw3 = (u32x4){cvtpk(p1[8], p1[9]), cvtpk(p1[10], p1[11]), cvtpk(p1[12], p1[13]), cvtpk(p1[14], p1[15])}; __builtin_amdgcn_s_setprio(0); } } while (0)
    const int tmain = NT - 4;
    if (grp == 0) {
        M_BAR_EVEN(0); M_STAGE_A_SW(0, false, true); A_BAR_L(); M_STAGE_B(0, true);
        int t = 1;
        for (; t < tmain; ++t) { M_BAR_EVEN(t); M_STAGE_A(t); A_BAR_L(); M_STAGE_B(t, true); }
        for (; t <= NT; ++t) { M_BAR_EVEN(t); M_STAGE_A_SW(t, (t - 1 <= tw), (t < NT && t <= tw)); A_BAR_L(); M_STAGE_B(t, (t < NT && t <= tw)); }
    } else {
        M_BAR_EVEN(0); A_BAR_L(); M_STAGE_A_SW(0, false, true);
        M_BAR_EVEN(1); M_STAGE_B(0, true); A_BAR_L(); M_STAGE_A_SW(1, true, true);
        int t = 2;
        for (; t < tmain; ++t) { M_BAR_EVEN(t); M_STAGE_B(t - 1, true); A_BAR_L(); M_STAGE_A(t); }
        for (; t <= NT; ++t) { M_BAR_EVEN(t); M_STAGE_B(t - 1, (t - 1 <= tw)); A_BAR_L(); M_STAGE_A_SW(t, (t - 1 <= tw), (t < NT && t <= tw)); }
    }
#undef M_BAR_EVEN
#undef M_STAGE_A
#undef M_STAGE_A_SW
#undef M_STAGE_B
#undef M_PA
#undef M_KLD
#undef M_QK
#undef M_VF
    A_WAIT_BAR(0);
    const float lt = xhalf_sum(l_run);
    if (hi == 0) wsf[32 + r32] = lt;
    float rli[16];
#pragma unroll
    for (int r = 0; r < 16; ++r) rli[r] = __builtin_amdgcn_rcpf(wsf[32 + crow(r, hi)]);
    ALAS float* stg = (ALAS float*)shm + wid * 2048;
#pragma unroll
    for (int r = 0; r < 16; ++r) { const int orow = crow(r, hi);
#pragma unroll
        for (int d0 = 0; d0 < 2; ++d0) stg[orow * 64 + d0 * 32 + r32] = o[d0][r] * rli[r]; }
    const long grow0 = rowbase + q0 + wid * 32;
    u32x4 gvp[4];
#pragma unroll
    for (int i = 0; i < 4; ++i) gvp[i] = *(const u32x4*)(gate + (size_t)(grow0 + i * 8 + (lane >> 3)) * 1024 + goff + h * 64 + (lane & 7) * 8);
#pragma unroll
    for (int i = 0; i < 4; ++i) {
        const int row = i * 8 + (lane >> 3), ch = lane & 7;
        const f32x4 a = *(const ALAS f32x4*)(stg + row * 64 + ch * 8), c = *(const ALAS f32x4*)(stg + row * 64 + ch * 8 + 4);
        float ss = ((a[0] * a[0] + a[1] * a[1]) + (a[2] * a[2] + a[3] * a[3])) + ((c[0] * c[0] + c[1] * c[1]) + (c[2] * c[2] + c[3] * c[3]));
        ss += __shfl_xor(ss, 1); ss += __shfl_xor(ss, 2); ss += __shfl_xor(ss, 4);
        const float rn = 1.0f / sqrtf(ss * (1.0f / 64.0f) + kEps);
        const size_t off = (size_t)(grow0 + row) * 1024 + goff + h * 64 + ch * 8;
        const u32x4 gv = gvp[i];
        const f32x4 g0 = *(const f32x4*)(gnorm + h * 64 + ch * 8), g1 = *(const f32x4*)(gnorm + h * 64 + ch * 8 + 4);
        float v[8];
#pragma unroll
        for (int e = 0; e < 4; ++e) { v[e] = a[e] * rn * g0[e]; v[4 + e] = c[e] * rn * g1[e]; }
        u32x4 w;
#pragma unroll
        for (int e = 0; e < 4; ++e) { const unsigned gw = gv[e]; w[e] = cvtpk(v[2 * e] * __uint_as_float(gw << 16), v[2 * e + 1] * __uint_as_float(gw & 0xffff0000u)); }
        *(u32x4*)(out + off) = w;
    }
    A_WAIT_BAR(0);
#undef M_DMA
}

constexpr int S_RING = 0, S_FLAG = 131072, S_END = 131072 + 256;
__device__ __forceinline__ void sb_unit(int b, int h, int qb, const bf16_t* Q, const bf16_t* K, const bf16_t* V, const bf16_t* gate, const float* gnorm, bf16_t* out, int goff, ALAS char* shm) {
    constexpr int QP = 512;
    const int tid = threadIdx.x, lane = tid & 63, r32 = lane & 31, hi = lane >> 5; const int wid = __builtin_amdgcn_readfirstlane(tid >> 6);
    const int pair = wid >> 1, e2 = wid & 1;
    const long rowbase = (long)b * SEQ; const int q0 = qb * 256;
    const bf16_t* Qw = Q + (rowbase + q0 + wid * 32) * QP + h * 64;
    const bf16_t* Kh = K + rowbase * QP + h * 64; const bf16_t* Vh = V + rowbase * 512 + h * 64;
    const unsigned lds0 = (unsigned)(uintptr_t)shm;
    ALAS unsigned* flags = (ALAS unsigned*)(shm + S_FLAG);
    const int td = 4 * qb + pair;
    const bf16_t* ksrc = Kh + (long)lane * QP + (4 * e2) * 8;
    const bf16_t* vsrc = Vh + (long)(lane >> 2) * 512 + e2 * 32 + (lane & 3) * 8;
    const unsigned ring = lds0 + S_RING + pair * 32768;
    const unsigned kdst = ring + (4 * e2) * 1024, vdst = ring + 8192 + (4 * e2) * 1024;
#define S_DMA(t_, s_) do { const int tt_ = (t_) < 0 ? 0 : (t_); const unsigned so_ = (unsigned)(s_) * 16384u; \
        _Pragma("unroll") for (int c = 0; c < 4; ++c) glds16(ksrc + (long)tt_ * 64 * QP + c * 8, (unsigned)__builtin_amdgcn_readfirstlane(kdst + so_ + c * 1024)); \
        _Pragma("unroll") for (int c = 0; c < 4; ++c) glds16(vsrc + ((long)tt_ * 64 + 16 * c) * 512, (unsigned)__builtin_amdgcn_readfirstlane(vdst + so_ + c * 1024)); } while (0)
    S_DMA(td, 0);
    bf16x8 qr[4];
#pragma unroll
    for (int d0 = 0; d0 < 4; ++d0) qr[d0] = *(const bf16x8*)(Qw + (long)r32 * QP + d0 * 16 + hi * 8);
    f32x16 o[2]; o[0] = f32x16{}; o[1] = f32x16{};
    float carry = 1.0f;
    const int vb0 = (int)ring + 8192 + ((lane >> 4) & 1) * 32 + (lane & 3) * 8 + (4 * hi + ((lane & 15) >> 2)) * 64;
    const int qrel = 32 * e2 + r32;
    const int NI = 4 * qb + 4;
    for (int i = 0; i < NI; ++i) {
        A_WAIT_BAR(0);
        if (i > 0) { const ALAS unsigned* fl = flags + ((i - 1) & 1) * 8; unsigned all = 1u;
#pragma unroll
            for (int w = 0; w < 8; ++w) all &= fl[w];
            if (all) break; }
        const int t = td - i, slot = i & 1;
        if (i + 1 < NI) S_DMA(t - 1, slot ^ 1);
        bool done = true;
        if (t >= 0) {
            f32x16 p0, p1;
            qkt<4>(p0, p1, shm + S_RING + pair * 32768 + slot * 16384, qr, r32, hi);
            if (i == 0) {
#pragma unroll
                for (int r = 0; r < 16; ++r) { const int kv = crow(r, hi); if (kv >= qrel) p0[r] = -INFINITY; if (kv + 32 >= qrel) p1[r] = -INFINITY; } }
            f32x16 u0, u1;
#pragma unroll
            for (int r = 0; r < 16; ++r) { u0[r] = __builtin_amdgcn_rcpf(1.0f + __builtin_amdgcn_exp2f(p0[r])); u1[r] = __builtin_amdgcn_rcpf(1.0f + __builtin_amdgcn_exp2f(p1[r])); }
            float lo_[8], up_[8];
#pragma unroll
            for (int i4 = 0; i4 < 8; ++i4) {
                const float bp = (i4 < 4) ? ((u0[4 * i4] * u0[4 * i4 + 1]) * (u0[4 * i4 + 2] * u0[4 * i4 + 3])) : ((u1[4 * i4 - 16] * u1[4 * i4 - 15]) * (u1[4 * i4 - 14] * u1[4 * i4 - 13]));
                auto rr = __builtin_amdgcn_permlane32_swap(__float_as_uint(bp), __float_as_uint(bp), false, false);
                lo_[i4] = __uint_as_float(rr[0]); up_[i4] = __uint_as_float(rr[1]);
            }
            float run = carry;
#pragma unroll
            for (int i4 = 7; i4 >= 0; --i4) {
                float c = (hi == 0) ? run * up_[i4] : run;
#pragma unroll
                for (int e = 3; e >= 0; --e) {
                    if (i4 < 4) { const float uu = u0[4 * i4 + e]; p0[4 * i4 + e] = (1.0f - uu) * c; c *= uu; }
                    else { const float uu = u1[4 * i4 - 16 + e]; p1[4 * i4 - 16 + e] = (1.0f - uu) * c; c *= uu; }
                }
                run *= lo_[i4] * up_[i4];
            }
            carry = run;
            u32x4 pw0, pw1, pw2, pw3;
            pw0 = (u32x4){cvtpk(p0[0], p0[1]), cvtpk(p0[2], p0[3]), cvtpk(p0[4], p0[5]), cvtpk(p0[6], p0[7])};
            pw1 = (u32x4){cvtpk(p0[8], p0[9]), cvtpk(p0[10], p0[11]), cvtpk(p0[12], p0[13]), cvtpk(p0[14], p0[15])};
            pw2 = (u32x4){cvtpk(p1[0], p1[1]), cvtpk(p1[2], p1[3]), cvtpk(p1[4], p1[5]), cvtpk(p1[6], p1[7])};
            pw3 = (u32x4){cvtpk(p1[8], p1[9]), cvtpk(p1[10], p1[11]), cvtpk(p1[12], p1[13]), cvtpk(p1[14], p1[15])};
            pv(o, vb0 + slot * 16384, __builtin_bit_cast(bf16x8, pw0), __builtin_bit_cast(bf16x8, pw1), __builtin_bit_cast(bf16x8, pw2), __builtin_bit_cast(bf16x8, pw3));
            done = __all(carry < 1.0e-37f) || (t == 0);
        }
        if (lane == 0) flags[(i & 1) * 8 + wid] = done ? 1u : 0u;
    }
    A_WAIT_BAR(0);
    ALAS float* stg = (ALAS float*)shm + wid * 2048;
#pragma unroll
    for (int r = 0; r < 16; ++r) { const int orow = crow(r, hi);
#pragma unroll
        for (int d0 = 0; d0 < 2; ++d0) stg[orow * 64 + d0 * 32 + r32] = o[d0][r]; }
    const long grow0 = rowbase + q0 + wid * 32;
    u32x4 gvp[4];
#pragma unroll
    for (int i = 0; i < 4; ++i) gvp[i] = *(const u32x4*)(gate + (size_t)(grow0 + i * 8 + (lane >> 3)) * 1024 + goff + h * 64 + (lane & 7) * 8);
#pragma unroll
    for (int i = 0; i < 4; ++i) {
        const int row = i * 8 + (lane >> 3), ch = lane & 7;
        const f32x4 a = *(const ALAS f32x4*)(stg + row * 64 + ch * 8), c = *(const ALAS f32x4*)(stg + row * 64 + ch * 8 + 4);
        float ss = ((a[0] * a[0] + a[1] * a[1]) + (a[2] * a[2] + a[3] * a[3])) + ((c[0] * c[0] + c[1] * c[1]) + (c[2] * c[2] + c[3] * c[3]));
        ss += __shfl_xor(ss, 1); ss += __shfl_xor(ss, 2); ss += __shfl_xor(ss, 4);
        const float rn = 1.0f / sqrtf(ss * (1.0f / 64.0f) + kEps);
        const size_t off = (size_t)(grow0 + row) * 1024 + goff + h * 64 + ch * 8;
        const u32x4 gv = gvp[i];
        const f32x4 g0 = *(const f32x4*)(gnorm + h * 64 + ch * 8), g1 = *(const f32x4*)(gnorm + h * 64 + ch * 8 + 4);
        float v[8];
#pragma unroll
        for (int e = 0; e < 4; ++e) { v[e] = a[e] * rn * g0[e]; v[4 + e] = c[e] * rn * g1[e]; }
        u32x4 w;
#pragma unroll
        for (int e = 0; e < 4; ++e) { const unsigned gw = gv[e]; w[e] = cvtpk(v[2 * e] * __uint_as_float(gw << 16), v[2 * e + 1] * __uint_as_float(gw & 0xffff0000u)); }
        *(u32x4*)(out + off) = w;
    }
    A_WAIT_BAR(0);
#undef S_DMA
}
}
#include <hip/hip_cooperative_groups.h>
namespace cg = cooperative_groups;
#ifndef MK_N_LAUNCHES
#define MK_N_LAUNCHES 1
#endif
#ifndef REP_MLA
#define REP_MLA 1
#endif
#ifndef REP_SB
#define REP_SB 1
#endif
#ifndef REP_P1
#define REP_P1 1
#endif
#ifndef REP_MISC
#define REP_MISC 1
#endif
#ifndef REP_SYNC
#define REP_SYNC 0
#endif
#ifndef REP_TAIL
#define REP_TAIL 1
#endif
constexpr int NWAVES = 8;
constexpr int N_PHASES = 7;
constexpr int LDS_BYTES = 147456;
static_assert(WS_SBK - WS_SBQ == 32 * MiB && WS_SBV - WS_SBK == 32 * MiB, "EpiProj addresses SBK/SBV relative to SBQ");
static_assert(att::L_END <= MISC_OFF && pg8::STAGE_BYTES <= MISC_OFF, "control words");
static_assert(att::M_END <= MISC_OFF && att::S_END <= MISC_OFF, "LDS map");
static_assert(att::L_END <= LDS_BYTES && pg8::STAGE_BYTES <= LDS_BYTES, "LDS map");

typedef unsigned short bf16;
typedef unsigned v4u __attribute__((ext_vector_type(4)));
typedef unsigned v2u __attribute__((ext_vector_type(2)));
typedef float f32x4 __attribute__((ext_vector_type(4)));
#define LAS __attribute__((address_space(3)))
__device__ __forceinline__ unsigned f2bf(float f) { unsigned u = __builtin_bit_cast(unsigned, f); return (u + 0x7fffu + ((u >> 16) & 1u)) >> 16; }
__device__ __forceinline__ unsigned pk2(float lo, float hi) { return f2bf(lo) | (f2bf(hi) << 16); }
__device__ __forceinline__ float wave_sum(float v) {
#pragma unroll
    for (int o = 1; o < 64; o <<= 1) v += __shfl_xor(v, o);
    return v;
}
__device__ __forceinline__ void transpose_item(const float* W, int K, int N, bf16* WT, int ldk, const float* gain, LAS float* scr, int item, int lane) {
    const int nblk = N / 32, kb = item / nblk, nb = item % nblk, k0 = 64 * kb, n0 = 32 * nb;
#pragma unroll 8
    for (int i = 0; i < 32; ++i) { const int kk = 2 * i + (lane >> 5); const float gk = gain ? gain[k0 + kk] : 1.0f; scr[kk * 33 + (lane & 31)] = W[(size_t)(k0 + kk) * N + n0 + (lane & 31)] * gk; }
    asm volatile("s_waitcnt lgkmcnt(0)" ::: "memory");
    const int c = lane & 7;
#pragma unroll
    for (int j = 0; j < 4; ++j) { const int n = (lane >> 3) + 8 * j; const LAS float* s = scr + (8 * c) * 33 + n;
        v4u o; o.x = pk2(s[0 * 33], s[1 * 33]); o.y = pk2(s[2 * 33], s[3 * 33]); o.z = pk2(s[4 * 33], s[5 * 33]); o.w = pk2(s[6 * 33], s[7 * 33]);
        *(v4u*)(WT + (size_t)(n0 + n) * ldk + k0 + 8 * c) = o; }
    asm volatile("s_waitcnt lgkmcnt(0)" ::: "memory");
}

#define XB_TMO      128
#define XB_XCNT(j)  (256  + 64 * (j))
#define XB_XSUB(j)  (1280 + 64 * (j))
#define XB_XGEN(j)  (2304 + 64 * (j))
#define XB_TOP      3328
#define XB_TOPGEN   3392
#define XCD_BAR_WORDS 3456
#define XB_SPIN_CAP (1u << 18)

__device__ __forceinline__ unsigned xb_ld(unsigned* p)              { return __hip_atomic_load(p, __ATOMIC_RELAXED, __HIP_MEMORY_SCOPE_AGENT); }
__device__ __forceinline__ unsigned xb_add(unsigned* p, unsigned v) { return __hip_atomic_fetch_add(p, v, __ATOMIC_RELAXED, __HIP_MEMORY_SCOPE_AGENT); }
__device__ __forceinline__ unsigned xb_xcc_id() { return (unsigned)__builtin_amdgcn_s_getreg((3 << 11) | 20) & 0xFu; }
#define XB_SPIN(cond, bar) do { unsigned _sp = 0; while (cond) { __builtin_amdgcn_s_sleep(1); \
    if ((++_sp & 255u) == 0u) { if (xb_ld(&(bar)[XB_TMO])) break; if (_sp > XB_SPIN_CAP) { atomicAdd(&(bar)[XB_TMO], 1u); break; } } } } while (0)

struct XcdBarrier {
    unsigned* bar; unsigned x;
    volatile LAS unsigned* st;
};

__device__ __forceinline__ XcdBarrier xcd_barrier_post(unsigned* bar, volatile LAS unsigned* st) {
    XcdBarrier b; b.bar = bar; b.x = xb_xcc_id(); b.st = st;
    if (threadIdx.x == 0) (void)xb_add(&bar[XB_XCNT(b.x)], 1u);
    return b;
}
__device__ __forceinline__ void xcd_barrier_complete(unsigned* bar, unsigned x, unsigned& nloc, unsigned& nx) {
    const unsigned G = gridDim.x * gridDim.y * gridDim.z;
    unsigned sum, cnt, mine, sp = 0u;
    for (;;) {
        sum = 0u; cnt = 0u; mine = 0u;
#pragma unroll
        for (unsigned j = 0; j < 16; ++j) { const unsigned c = xb_ld(&bar[XB_XCNT(j)]); sum += c; cnt += (c > 0u) ? 1u : 0u; mine = (j == x) ? c : mine; }
        if (sum == G) break;
        __builtin_amdgcn_s_sleep(1);
        if ((++sp & 255u) == 0u) { if (xb_ld(&bar[XB_TMO])) break; if (sp > XB_SPIN_CAP) { atomicAdd(&bar[XB_TMO], 1u); break; } }
    }
    nloc = mine > 0u ? mine : 1u; nx = cnt > 0u ? cnt : 1u;
}

__device__ __forceinline__ void xcd_barrier(const XcdBarrier& b) {
    asm volatile("s_waitcnt vmcnt(0)" ::: "memory");
    __syncthreads();
    if (threadIdx.x == 0) {
        unsigned* bar = b.bar;
        __builtin_amdgcn_s_waitcnt(0);
        unsigned nloc = b.st[0], nx = b.st[1];
        if (nloc == 0u) { xcd_barrier_complete(bar, b.x, nloc, nx); b.st[0] = nloc; b.st[1] = nx; }
        const unsigned old = xb_add(&bar[XB_XSUB(b.x)], 1u);
        const unsigned gen = old / nloc;
        if (old + 1u == (gen + 1u) * nloc) {
            __builtin_amdgcn_fence(__ATOMIC_RELEASE, "agent");
            asm volatile("s_waitcnt vmcnt(0)" ::: "memory");
            const unsigned og = xb_add(&bar[XB_TOP], 1u);
            const unsigned tg = og / nx;
            if (og + 1u == (tg + 1u) * nx) xb_add(&bar[XB_TOPGEN], 1u);
            else XB_SPIN(xb_ld(&bar[XB_TOPGEN]) == tg, bar);
            __builtin_amdgcn_fence(__ATOMIC_ACQUIRE, "agent");
            xb_add(&bar[XB_XGEN(b.x)], 1u);
            asm volatile("s_waitcnt vmcnt(0)" ::: "memory");
        } else {
            XB_SPIN(xb_ld(&bar[XB_XGEN(b.x)]) == gen, bar);
            __builtin_amdgcn_fence(__ATOMIC_ACQUIRE, "agent");
            asm volatile("s_waitcnt vmcnt(0)" ::: "memory");
        }
    }
    __syncthreads();
}

static_assert(XCD_BAR_WORDS * 4 <= (int)CTL_ZERO_BYTES, "barrier words inside the memset");
__device__ __forceinline__ int opq(int v) { asm volatile("" : "+s"(v)); return v; }
struct Args { const float* in[17]; const int* pos; float* out; unsigned char* ws; int ph_lo, ph_hi; };

typedef const Args __attribute__((address_space(4)))* ArgsK;
#define PHASE_PTRS \
    ArgsK ap_ = (ArgsK)__builtin_amdgcn_kernarg_segment_ptr(); asm volatile("" : "+s"(ap_)); unsigned char* ws = ap_->ws; const int* posp = ap_->pos; float* outp = ap_->out; \
    const float* x = ap_->in[0]; const float* pin = ap_->in[1]; \
    const float* g_pre = ap_->in[3]; const float* w_in = ap_->in[4]; const float* g_q = ap_->in[5]; const float* w_uq = ap_->in[6]; const float* g_kv = ap_->in[7]; const float* w_ukv = ap_->in[8]; \
    const float* g_sb = ap_->in[9]; const float* g_mla = ap_->in[10]; const float* w_out = ap_->in[11]; const float* g_post = ap_->in[12]; const float* w_ple = ap_->in[13]; const float* g_ple = ap_->in[14]; \
    const float* w_pg = ap_->in[15]; const float* b_pg = ap_->in[16]; \
    bf16* XB = (bf16*)(ws + WS_A); bf16* MIX = (bf16*)(ws + WS_A); bf16* X1B = (bf16*)(ws + WS_A); \
    bf16* GATE = (bf16*)(ws + WS_B); bf16* YB = (bf16*)(ws + WS_B); bf16* PLEB = (bf16*)(ws + WS_PLE); \
    bf16* SBQ = (bf16*)(ws + WS_SBQ); bf16* SBK = (bf16*)(ws + WS_SBK); bf16* SBV = (bf16*)(ws + WS_SBV); \
    bf16* MQ = (bf16*)(ws + WS_MQ); bf16* MK = (bf16*)(ws + WS_MK); bf16* MV = (bf16*)(ws + WS_MV); \
    bf16* PB = (bf16*)(ws + WS_PB); bf16* CQ = (bf16*)(ws + WS_CQ); bf16* CKV = (bf16*)(ws + WS_CKV); \
    bf16* WIN = (bf16*)(ws + WS_WIN); bf16* WUQ = (bf16*)(ws + WS_WUQ); bf16* WUKV = (bf16*)(ws + WS_WUKV); bf16* WOUT = (bf16*)(ws + WS_WOUT); bf16* WPLE = (bf16*)(ws + WS_WPLE); bf16* WPG = (bf16*)(ws + WS_WPG); \
    float* CS = (float*)(ws + WS_CS); float* RPRE = (float*)(ws + WS_RPRE); float* RQSS = (float*)(ws + WS_RQSS); float* RKVSS = (float*)(ws + WS_RKVSS); \
    float* YSS = (float*)(ws + WS_YSS); float* PSS = (float*)(ws + WS_PSS); float* RY = (float*)(ws + WS_RY); float* RP = (float*)(ws + WS_RP);
__global__ void __launch_bounds__(NWAVES * 64, 2) fwd_kernel(Args args) {
    extern __shared__ __attribute__((aligned(16))) unsigned char lds[];
    const int tid = threadIdx.x, lane = tid & 63, wave = __builtin_amdgcn_readfirstlane(tid >> 6);
    const int G = gridDim.x; const int bx = blockIdx.x; const int vcu = (G % 8 == 0) ? (bx % 8) * (G / 8) + bx / 8 : bx;
    const int lo = args.ph_lo, hi = args.ph_hi;
#define IN(k) (lo <= (k) && (k) < hi)
#define SEAM(k) do { if (IN(k) && IN((k) + 1)) { xcd_barrier(bar); } } while (0)
    if (lo < 0) cg::this_grid().sync();
    volatile LAS unsigned* MISC = (volatile LAS unsigned*)((LAS unsigned char*)lds + MISC_OFF);
    if (tid < 8) MISC[tid] = 0u;
    __syncthreads();
    XcdBarrier bar; bar.bar = (unsigned*)(args.ws + WS_CTL); bar.x = 0; bar.st = nullptr;
    if (hi - lo > 1) bar = xcd_barrier_post((unsigned*)(args.ws + WS_CTL), MISC);
    const int gw = vcu * NWAVES + wave, NGW = G * NWAVES;

    for (int rep0 = 0; rep0 < REP_MISC; ++rep0)
    if (IN(0)) {
        PHASE_PTRS
        LAS float* scr = (LAS float*)((LAS unsigned char*)lds + wave * 16384);
        constexpr int I_IN = 16 * 93, I_UQ = 4 * 24, I_UKV = 2 * 32, I_OUT = 16 * 32, I_PLE = 4 * 32, I_PG = 16 * 32;
        constexpr int NITEMS = I_IN + I_UQ + I_UKV + I_OUT + I_PLE + I_PG;
        for (int it = gw; it < NITEMS; it += NGW) {
            int r = it;
            if (r < I_IN) { transpose_item(w_in, 1024, NIN, WIN, 1024, g_pre, scr, r, lane); continue; } r -= I_IN;
            if (r < I_UQ) { transpose_item(w_uq, 256, 768, WUQ, 256, g_q, scr, r, lane); continue; } r -= I_UQ;
            if (r < I_UKV) { transpose_item(w_ukv, 128, 1024, WUKV, 256, g_kv, scr, r, lane); continue; } r -= I_UKV;
            if (r < I_OUT) { transpose_item(w_out, 1024, 1024, WOUT, 1024, nullptr, scr, r, lane); continue; } r -= I_OUT;
            if (r < I_PLE) { transpose_item(w_ple, 256, 1024, WPLE, 256, nullptr, scr, r, lane); continue; } r -= I_PLE;
            transpose_item(w_pg, 1024, 1024, WPG, 1024, nullptr, scr, r, lane);
        }
        const int gt = vcu * (NWAVES * 64) + tid, NGT = G * NWAVES * 64;
        for (int i = gt; i < (NINP - NIN) * 1024 / 8; i += NGT) *(v4u*)(WIN + (size_t)NIN * 1024 + (size_t)i * 8) = (v4u){0u, 0u, 0u, 0u};
        for (int i = gt; i < 1024 * 128 / 8; i += NGT) { const int n = i / 16, c = i % 16; *(v4u*)(WUKV + (size_t)n * 256 + 128 + c * 8) = (v4u){0u, 0u, 0u, 0u}; }
        for (int i = gt; i < M * 16; i += NGT) {
            const int row = i >> 4, k = i & 15;
            const float freq = exp2f(-(float)k * 0.8304820237218407f);
            const float ang = (float)posp[row] * freq;
            double tt = (double)ang * 0.15915494309189535; tt -= __builtin_rint(tt);
            const float tf = (float)tt;
            CS[(size_t)i * 2] = __builtin_amdgcn_cosf(tf); CS[(size_t)i * 2 + 1] = __builtin_amdgcn_sinf(tf);
        }
        for (int m = gw; m < M; m += 2 * NGW) {
            const int m2 = (m + NGW < M) ? m + NGW : m;
            const f32x4* xr = (const f32x4*)(x + (size_t)m * D) + lane; const f32x4* xr2 = (const f32x4*)(x + (size_t)m2 * D) + lane; f32x4 v[4], w[4]; float s = 0.f, s2 = 0.f;
#pragma unroll
            for (int j = 0; j < 4; ++j) { v[j] = xr[64 * j]; w[j] = xr2[64 * j]; }
#pragma unroll
            for (int j = 0; j < 4; ++j) { s += (v[j][0] * v[j][0] + v[j][1] * v[j][1]) + (v[j][2] * v[j][2] + v[j][3] * v[j][3]); s2 += (w[j][0] * w[j][0] + w[j][1] * w[j][1]) + (w[j][2] * w[j][2] + w[j][3] * w[j][3]); }
            s = wave_sum(s); s2 = wave_sum(s2);
            if (lane == 0) { RPRE[m] = 1.0f / sqrtf(s * (1.0f / D) + 1e-6f); RPRE[m2] = 1.0f / sqrtf(s2 * (1.0f / D) + 1e-6f); }
            v2u* o8 = (v2u*)(XB + (size_t)m * D) + lane; v2u* o82 = (v2u*)(XB + (size_t)m2 * D) + lane;
#pragma unroll
            for (int j = 0; j < 4; ++j) { o8[64 * j] = (v2u){pk2(v[j][0], v[j][1]), pk2(v[j][2], v[j][3])}; o82[64 * j] = (v2u){pk2(w[j][0], w[j][1]), pk2(w[j][2], w[j][3])}; }
        }
        for (int i = gt; i < M * PLE / 4; i += 4 * NGT) {
            f32x4 v[4];
#pragma unroll
            for (int j = 0; j < 4; ++j) { const int ij = (i + j * NGT < M * PLE / 4) ? i + j * NGT : i; v[j] = *((const f32x4*)pin + ij); }
#pragma unroll
            for (int j = 0; j < 4; ++j) { const int ij = (i + j * NGT < M * PLE / 4) ? i + j * NGT : i; *((v2u*)PB + ij) = (v2u){pk2(v[j][0], v[j][1]), pk2(v[j][2], v[j][3])}; }
        }
    }
    SEAM(0);

    if (IN(1)) {
        PHASE_PTRS
        { pg8::Gemm g{XB, WIN, M, NINP, 1024}; pg8::StaticOrder S; S.init(M, NINP, G, bx);
          pg8::EpiProj E{ws};
          pg8::gemm_phase<pg8::EpiProj, pg8::StaticOrder, true, true>((PG8_LAS unsigned char*)lds, g, S, E); }
#if REP_P1 > 1
        { pg8::Gemm g{XB, WIN, M, NINP, 1024}; pg8::StaticOrder S; S.init(M, NINP, G, bx);
          pg8::EpiProj E{ws};
          pg8::gemm_phase<pg8::EpiProj, pg8::StaticOrder, true, true>((PG8_LAS unsigned char*)lds, g, S, E); }
#endif
        { pg8::Gemm g{PB, WPLE, M, 1024, opq(256)}; pg8::StaticOrder S; S.init(M, 1024, G, bx);
          pg8::EpiStat E{PLEB, PSS};
          pg8::gemm_phase<pg8::EpiStat, pg8::StaticOrder, true, true>((PG8_LAS unsigned char*)lds, g, S, E); }
#if REP_MISC > 1
        { pg8::Gemm g{PB, WPLE, M, 1024, opq(256)}; pg8::StaticOrder S; S.init(M, 1024, G, bx);
          pg8::EpiStat E{PLEB, PSS};
          pg8::gemm_phase<pg8::EpiStat, pg8::StaticOrder, true, true>((PG8_LAS unsigned char*)lds, g, S, E); }
#endif
    }
    SEAM(1);

    if (IN(2)) {
        PHASE_PTRS
        { pg8::Gemm g{CQ, WUQ, M, 768, opq(256)}; pg8::StaticOrder S; S.init(M, 768, G, bx);
          pg8::EpiQ E{MQ, RQSS, CS};
          pg8::gemm_phase<pg8::EpiQ, pg8::StaticOrder, true, true>((PG8_LAS unsigned char*)lds, g, S, E); }
        { pg8::Gemm g{CKV, WUKV, M, 1024, opq(256)}; pg8::StaticOrder S; S.init(M, 1024, G, bx);
          pg8::EpiKV E{MK, MV, RKVSS};
          pg8::gemm_phase<pg8::EpiKV, pg8::StaticOrder, true, true>((PG8_LAS unsigned char*)lds, g, S, E); }
#if REP_MISC > 1
        { pg8::Gemm g{CQ, WUQ, M, 768, opq(256)}; pg8::StaticOrder S; S.init(M, 768, G, bx);
          pg8::EpiQ E{MQ, RQSS, CS};
          pg8::gemm_phase<pg8::EpiQ, pg8::StaticOrder, true, true>((PG8_LAS unsigned char*)lds, g, S, E); }
        { pg8::Gemm g{CKV, WUKV, M, 1024, opq(256)}; pg8::StaticOrder S; S.init(M, 1024, G, bx);
          pg8::EpiKV E{MK, MV, RKVSS};
          pg8::gemm_phase<pg8::EpiKV, pg8::StaticOrder, true, true>((PG8_LAS unsigned char*)lds, g, S, E); }
#endif
    }
    SEAM(2);

    if (IN(3)) {
        PHASE_PTRS
        __attribute__((address_space(3))) char* shm = (__attribute__((address_space(3))) char*)lds;
        for (int rep = 0; rep < REP_MLA; ++rep)
        for (int idx = vcu; idx < 1024; idx += G) {
            const int j = idx >> 8, v = idx & 255, bh = v >> 2, s = v & 3;
            const int qb = (j == 0) ? 15 - s : (j == 1) ? s : (j == 2) ? 8 + s : 7 - s;
            att::mla_unit(bh >> 3, bh & 7, qb, MQ, MK, MV, GATE, g_mla, MIX, 512, shm);
        }
        for (int rep = 0; rep < REP_SB; ++rep)
        for (int idx = vcu; idx < 1024; idx += G) {
            const int bh = idx >> 4, qb = idx & 15;
            att::sb_unit(bh >> 3, bh & 7, qb, SBQ, SBK, SBV, GATE, g_sb, MIX, 0, shm);
        }
    }
    SEAM(3);
    for (int rs_ = 0; rs_ < REP_SYNC; ++rs_) xcd_barrier(bar);

    if (IN(4)) {
        PHASE_PTRS
        {
        pg8::Gemm g{MIX, WOUT, M, 1024, 1024}; pg8::StaticOrder S; S.init(M, 1024, G, bx);
        pg8::EpiStat E{YB, YSS};
        pg8::gemm_phase<pg8::EpiStat, pg8::StaticOrder, true, true>((PG8_LAS unsigned char*)lds, g, S, E);
        }
#if REP_TAIL > 1
        {
        pg8::Gemm g{MIX, WOUT, M, 1024, 1024}; pg8::StaticOrder S; S.init(M, 1024, G, bx);
        pg8::EpiStat E{YB, YSS};
        pg8::gemm_phase<pg8::EpiStat, pg8::StaticOrder, true, true>((PG8_LAS unsigned char*)lds, g, S, E);
        }
#endif
    }
    SEAM(4);

    if (IN(5)) {
        PHASE_PTRS
        for (int mm = gw; mm < M; mm += 2 * NGW) {
            const int mr[2] = {mm, (mm + NGW < M) ? mm + NGW : mm};
            f32x4 xv[2][4]; v2u yw[2][4]; float sv[2];
#pragma unroll
            for (int h2 = 0; h2 < 2; ++h2) { const int m = mr[h2];
                sv[h2] = (lane < 16) ? YSS[(size_t)m * 16 + lane] : ((lane < 32) ? PSS[(size_t)m * 16 + lane - 16] : 0.f);
                const f32x4* xr = (const f32x4*)(x + (size_t)m * D) + lane; const v2u* yr = (const v2u*)(YB + (size_t)m * D) + lane;
#pragma unroll
                for (int j = 0; j < 4; ++j) { xv[h2][j] = xr[64 * j]; yw[h2][j] = yr[64 * j]; } }
#pragma unroll
            for (int h2 = 0; h2 < 2; ++h2) { const int m = mr[h2]; float s1 = sv[h2];
                s1 += __shfl_xor(s1, 1); s1 += __shfl_xor(s1, 2); s1 += __shfl_xor(s1, 4); s1 += __shfl_xor(s1, 8);
                const float sy = __shfl(s1, 0), sp = __shfl(s1, 16);
                const float ry = 1.0f / sqrtf(sy * (1.0f / 1024.0f) + 1e-6f), rp = 1.0f / sqrtf(sp * (1.0f / 1024.0f) + 1e-6f);
                if (lane == 0) { RY[m] = ry; RP[m] = rp; }
                const f32x4* gr = (const f32x4*)g_post + lane; v2u* o8 = (v2u*)(X1B + (size_t)m * D) + lane;
#pragma unroll
                for (int j = 0; j < 4; ++j) { const f32x4 xq = xv[h2][j], gv = gr[64 * j]; const v2u yq = yw[h2][j];
                    const float y0 = __uint_as_float(yq.x << 16), y1 = __uint_as_float(yq.x & 0xffff0000u), y2 = __uint_as_float(yq.y << 16), y3 = __uint_as_float(yq.y & 0xffff0000u);
                    o8[64 * j] = (v2u){pk2(xq[0] + y0 * ry * gv[0], xq[1] + y1 * ry * gv[1]), pk2(xq[2] + y2 * ry * gv[2], xq[3] + y3 * ry * gv[3])}; } }
        }
    }
    SEAM(5);

    if (IN(6)) {
        PHASE_PTRS
        {
        pg8::Gemm g{X1B, WPG, M, 1024, 1024}; pg8::StaticOrder S; S.init(M, 1024, G, bx);
        pg8::EpiFinal E{x, YB, PLEB, RY, RP, g_post, g_ple, b_pg, outp};
        pg8::gemm_phase<pg8::EpiFinal, pg8::StaticOrder, true, true>((PG8_LAS unsigned char*)lds, g, S, E);
        }
#if REP_TAIL > 1
        {
        pg8::Gemm g{X1B, WPG, M, 1024, 1024}; pg8::StaticOrder S; S.init(M, 1024, G, bx);
        pg8::EpiFinal E{x, YB, PLEB, RY, RP, g_post, g_ple, b_pg, outp};
        pg8::gemm_phase<pg8::EpiFinal, pg8::StaticOrder, true, true>((PG8_LAS unsigned char*)lds, g, S, E);
        }
#endif
    }
#undef IN
#undef SEAM
}

extern "C" void kernel_launch(void* const* d_in, const int* in_sizes, int n_in, void* d_out, int out_size, void* d_ws, size_t ws_size, hipStream_t stream) {
    static int grid = 0;
    if (grid == 0) {
        if (n_in != 17 || out_size != M * D || ws_size < WS_END) { fprintf(stderr, "kernel_launch: unexpected shapes (n_in %d, out %d, ws %zu); nothing launched\n", n_in, out_size, ws_size); grid = -1; return; }
        int dev = 0, cus = 0, per_cu = 0;
        if (hipGetDevice(&dev) != hipSuccess || hipDeviceGetAttribute(&cus, hipDeviceAttributeMultiprocessorCount, dev) != hipSuccess) { grid = -1; return; }
        if (hipFuncSetAttribute((const void*)fwd_kernel, hipFuncAttributeMaxDynamicSharedMemorySize, LDS_BYTES) != hipSuccess) { fprintf(stderr, "kernel_launch: hipFuncSetAttribute failed\n"); grid = -1; return; }
        if (hipOccupancyMaxActiveBlocksPerMultiprocessor(&per_cu, (const void*)fwd_kernel, NWAVES * 64, LDS_BYTES) != hipSuccess || per_cu < 1) { fprintf(stderr, "kernel_launch: occupancy query says %d blocks per CU\n", per_cu); per_cu = 1; }
        (void)hipGetLastError();
        grid = cus * 1;
    }
    if (grid < 0) return;
    if (hipMemsetAsync((char*)d_ws + WS_CTL, 0, CTL_ZERO_BYTES, stream) != hipSuccess) { fprintf(stderr, "kernel_launch: hipMemsetAsync failed\n"); return; }
    Args a{};
    for (int i = 0; i < 17; ++i) a.in[i] = (const float*)d_in[i];
    a.pos = (const int*)d_in[2]; a.out = (float*)d_out; a.ws = (unsigned char*)d_ws;
#if MK_N_LAUNCHES == 1
    a.ph_lo = 0; a.ph_hi = N_PHASES;
    void* kargs[] = {&a};
    hipError_t e = hipLaunchCooperativeKernel((const void*)fwd_kernel, dim3(grid), dim3(NWAVES * 64), kargs, LDS_BYTES, stream);
    if (e != hipSuccess) fprintf(stderr, "kernel_launch: cooperative launch failed: %s (grid %d)\n", hipGetErrorString(e), grid);
#else
    for (int li = 0; li < N_PHASES; ++li) { a.ph_lo = li; a.ph_hi = li + 1; hipLaunchKernelGGL(fwd_kernel, dim3(grid), dim3(NWAVES * 64), LDS_BYTES, stream, a); }
#endif
}
```
